# Optimizing an MI355X kernel written in HIP

```python
import jax, jax.numpy as jnp
from jax import lax
import numpy as np

D_MODEL = 2048
BATCH = 1
SEQ = 8192
DEPTH = 2
DEC_BATCH = 128
DEC_SEQ = 1
PAST_LEN = 2048
PAGE_SIZE = 128

N_MIXERS = 2
N_A_LAYERS = (DEPTH + N_MIXERS - 1) // N_MIXERS
N_B_LAYERS = DEPTH // N_MIXERS
A_HEADS = 16
A_DK = 128
A_DV = D_MODEL // A_HEADS
A_FDIM = A_HEADS * A_DK
A_IN_DIM = 2 * A_FDIM + 2 * D_MODEL
A_CHUNK = 64
B_HEADS = 16
B_KV_HEADS = 4
B_HEAD_DIM = D_MODEL // B_HEADS
B_GROUP = B_HEADS // B_KV_HEADS
B_QD = B_HEADS * B_HEAD_DIM
B_KVD = B_KV_HEADS * B_HEAD_DIM
IDX_HEADS = 16
IDX_DIM = 128
IDX_QD = IDX_HEADS * IDX_DIM
B_IN_DIM = B_QD + 2 * B_KVD + IDX_QD + IDX_DIM + IDX_HEADS
TOPK_MAX = 256
Q_BLOCK = 128
REL_BUCKETS = 32
REL_MAX_DIST = 128
D_FF = -(-8 * D_MODEL // (3 * 256)) * 256
EPS = 1e-6

kernel_name = 'hgrn2_dsa_hybrid_decode_step'


def _rmsnorm(x, g):
    xf = x.astype(jnp.float32)
    y = xf * lax.rsqrt(jnp.mean(xf * xf, axis=-1, keepdims=True) + EPS)
    return (y * g.astype(jnp.float32)).astype(x.dtype)


def _ffn(x, g, w_gu, w_down):
    h = _rmsnorm(x, g)
    gate, up = jnp.split(h @ w_gu, 2, axis=-1)
    return x + (jax.nn.silu(gate) * up) @ w_down


def _hgrn2_recurrence(q, k, v, logf, s0):
    B, T, H, DK = q.shape
    DV = v.shape[-1]
    C = min(A_CHUNK, T)
    nc = -(-T // C)
    pad = nc * C - T

    def chunks(a):
        a = jnp.pad(a.astype(jnp.float32), ((0, 0), (0, pad), (0, 0), (0, 0)))
        return a.reshape(B, nc, C, H, a.shape[-1]).transpose(1, 0, 3, 2, 4)

    causal = jnp.tril(jnp.ones((C, C), dtype=bool))

    def step(S, xs):
        qc, kc, vc, gc = xs
        G = jnp.cumsum(gc, axis=2)
        o_inter = jnp.einsum('bhtk,bhkv->bhtv', qc * jnp.exp(G), S)
        diff = G[:, :, :, None, :] - G[:, :, None, :, :]
        decay = jnp.exp(jnp.where(causal[:, :, None], diff, -jnp.inf))
        A = jnp.einsum('bhtk,bhsk,bhtsk->bhts', qc, kc, decay)
        o = o_inter + jnp.einsum('bhts,bhsv->bhtv', A, vc)
        G_end = G[:, :, -1, :]
        S = jnp.exp(G_end)[..., None] * S + jnp.einsum(
            'bhsk,bhsv->bhkv', kc * jnp.exp(G_end[:, :, None, :] - G), vc)
        return S, o

    S, o = lax.scan(step, s0.astype(jnp.float32), (chunks(q), chunks(k), chunks(v), chunks(logf)))
    o = o.transpose(1, 0, 3, 2, 4).reshape(B, nc * C, H, DV)[:, :T]
    return o, S


def _hgrn2_mixer(x, s0, g_in, w_in, w_out, g_out, lb):
    B, T, _ = x.shape
    h = _rmsnorm(x, g_in)
    q, f, i, g = jnp.split(h @ w_in, [A_FDIM, 2 * A_FDIM, 2 * A_FDIM + D_MODEL], axis=-1)
    q = jax.nn.silu(q).reshape(B, T, A_HEADS, A_DK)
    f = f.astype(jnp.float32)
    forget = lb + (1.0 - lb) * jax.nn.sigmoid(f)
    logf = jnp.log(forget).reshape(B, T, A_HEADS, A_DK)
    k = ((1.0 - lb) * jax.nn.sigmoid(-f)).reshape(B, T, A_HEADS, A_DK)
    v = i.reshape(B, T, A_HEADS, A_DV)
    o, S = _hgrn2_recurrence(q, k, v, logf, s0)
    o = _rmsnorm(o, g_out) * jax.nn.silu(g.astype(jnp.float32)).reshape(B, T, A_HEADS, A_DV)
    y = o.reshape(B, T, D_MODEL).astype(x.dtype) @ w_out
    return x + y, S.astype(x.dtype)


def _t5_bucket(rel):
    n = jnp.maximum(rel, 0)
    max_exact = REL_BUCKETS // 2
    nf = jnp.maximum(n, 1).astype(jnp.float32)
    large = max_exact + (jnp.log(nf / max_exact) / np.log(REL_MAX_DIST / max_exact).astype(np.float32)
                         * (REL_BUCKETS - max_exact)).astype(jnp.int32)
    large = jnp.minimum(large, REL_BUCKETS - 1)
    return jnp.where(n < max_exact, n, large)


def _dsa_project(h, w_in, q_norm, k_norm, kidx_norm):
    B, T, _ = h.shape
    offs = [B_QD, B_QD + B_KVD, B_QD + 2 * B_KVD, B_QD + 2 * B_KVD + IDX_QD,
            B_QD + 2 * B_KVD + IDX_QD + IDX_DIM]
    q, k, v, qi, ki, wi = jnp.split(h @ w_in, offs, axis=-1)
    q = _rmsnorm(q.reshape(B, T, B_HEADS, B_HEAD_DIM), q_norm)
    k = _rmsnorm(k.reshape(B, T, B_KV_HEADS, B_HEAD_DIM), k_norm)
    v = v.reshape(B, T, B_KV_HEADS, B_HEAD_DIM)
    qi = qi.reshape(B, T, IDX_HEADS, IDX_DIM)
    ki = _rmsnorm(ki, kidx_norm)
    wi = wi * (IDX_HEADS ** -0.5 * IDX_DIM ** -0.5)
    return q, k, v, qi, ki, wi


def _indexer_topk(qi, wi, ki, q_pos, topk):
    L = ki.shape[1]
    s = jnp.einsum('bqhd,bld->bqhl', qi, ki).astype(jnp.float32)
    s = jnp.einsum('bqhl,bqh->bql', jax.nn.relu(s), wi.astype(jnp.float32))
    visible = jnp.arange(L, dtype=jnp.int32)[None, :] <= q_pos[:, None]
    s = jnp.where(visible[None], s, -jnp.inf)
    return lax.top_k(s, topk)[1]


def _sparse_attend(q, k_sel, v_sel, key_pos, q_pos, rel_bias):
    B, Tq, H, Dh = q.shape
    K = key_pos.shape[-1]
    qg = q.reshape(B, Tq, B_KV_HEADS, B_GROUP, Dh)
    logits = jnp.einsum('bqhgd,bqkhd->bqhgk', qg, k_sel).astype(jnp.float32) * (Dh ** -0.5)
    rel = q_pos[None, :, None] - key_pos
    bias = rel_bias[_t5_bucket(rel)].reshape(B, Tq, K, B_KV_HEADS, B_GROUP).transpose(0, 1, 3, 4, 2)
    logits = logits + bias.astype(jnp.float32)
    logits = jnp.where((rel >= 0)[:, :, None, None, :], logits, -jnp.inf)
    p = jax.nn.softmax(logits, axis=-1)
    o = jnp.einsum('bqhgk,bqkhd->bqhgd', p.astype(v_sel.dtype), v_sel)
    return o.reshape(B, Tq, H * Dh)


def _take_rows(rows, idx):
    return jax.vmap(lambda r, i: r[i])(rows, idx)


def _dsa_prompt(x, g_in, w_in, w_out, q_norm, k_norm, kidx_norm, rel_bias):
    B, T, _ = x.shape
    h = _rmsnorm(x, g_in)
    q, k, v, qi, ki, wi = _dsa_project(h, w_in, q_norm, k_norm, kidx_norm)
    topk = min(TOPK_MAX, T // 4)
    QB = min(Q_BLOCK, T)
    nb = T // QB

    def blocks(a):
        return jnp.moveaxis(a.reshape(B, nb, QB, *a.shape[2:]), 1, 0)

    def attend_block(xs):
        qb, qib, wib, start = xs
        q_pos = start + jnp.arange(QB, dtype=jnp.int32)
        sel = _indexer_topk(qib, wib, ki, q_pos, topk)
        return _sparse_attend(qb, _take_rows(k, sel), _take_rows(v, sel), sel, q_pos, rel_bias)

    starts = jnp.arange(nb, dtype=jnp.int32) * QB
    o = lax.map(attend_block, (blocks(q), blocks(qi), blocks(wi), starts))
    o = jnp.moveaxis(o, 0, 1).reshape(B, T, D_MODEL)
    return x + o @ w_out, k, v, ki


def _dsa_sample(x, cache_k, cache_v, cache_kidx, page_table, g_in, w_in, w_out,
                q_norm, k_norm, kidx_norm, rel_bias):
    B, T, _ = x.shape
    h = _rmsnorm(x, g_in)
    q, k, v, qi, ki, wi = _dsa_project(h, w_in, q_norm, k_norm, kidx_norm)
    L = PAST_LEN + T
    topk = min(TOPK_MAX, L // 4)
    q_pos = PAST_LEN + jnp.arange(T, dtype=jnp.int32)
    ki_past = cache_kidx[page_table].reshape(B, PAST_LEN, IDX_DIM)
    ki_all = jnp.concatenate([ki_past, ki.astype(ki_past.dtype)], axis=1)
    sel = _indexer_topk(qi, wi, ki_all, q_pos, topk)
    in_past = sel < PAST_LEN
    sp = jnp.minimum(sel, PAST_LEN - 1)
    phys = _take_rows(page_table, sp // PAGE_SIZE) * PAGE_SIZE + sp % PAGE_SIZE
    sn = jnp.clip(sel - PAST_LEN, 0, T - 1)

    def gather(pool, new):
        from_pool = pool.reshape(-1, *pool.shape[2:])[phys]
        return jnp.where(in_past[..., None, None], from_pool, _take_rows(new, sn).astype(from_pool.dtype))

    o = _sparse_attend(q, gather(cache_k, k), gather(cache_v, v), sel, q_pos, rel_bias)
    return x + o @ w_out, k, v, ki


def setup_inputs(seed: int = 0) -> dict:
    key = jax.random.key(seed)
    ks = jax.random.split(key, 24)
    n_pages = PAST_LEN // PAGE_SIZE
    n_used = DEC_BATCH * n_pages
    n_pool = n_used + max(1, n_used // 4)

    def nrm(k, shape, scale=1.0):
        return jax.random.normal(k, shape, jnp.float32) * scale

    def gain(k, shape):
        return 1.0 + 0.02 * jax.random.normal(k, shape, jnp.float32)

    page_table = jax.random.permutation(ks[6], n_pool)[:n_used].reshape(DEC_BATCH, n_pages).astype(jnp.int32)
    return {
        'x_prompt': nrm(ks[0], (BATCH, SEQ, D_MODEL)),
        'x_sample': nrm(ks[1], (DEC_BATCH, DEC_SEQ, D_MODEL)),
        'state_hgrn': nrm(ks[2], (N_A_LAYERS, DEC_BATCH, A_HEADS, A_DK, A_DV), 0.5),
        'cache_k': nrm(ks[3], (N_B_LAYERS, n_pool, PAGE_SIZE, B_KV_HEADS, B_HEAD_DIM)),
        'cache_v': nrm(ks[4], (N_B_LAYERS, n_pool, PAGE_SIZE, B_KV_HEADS, B_HEAD_DIM)),
        'cache_kidx': nrm(ks[5], (N_B_LAYERS, n_pool, PAGE_SIZE, IDX_DIM)),
        'page_table': page_table,
        'norm_mix': gain(ks[7], (DEPTH, D_MODEL)),
        'norm_ffn': gain(ks[8], (DEPTH, D_MODEL)),
        'lb_logits': nrm(ks[9], (DEPTH + 1, A_FDIM), 0.5),
        'a_w_in': nrm(ks[10], (N_A_LAYERS, D_MODEL, A_IN_DIM), D_MODEL ** -0.5),
        'a_w_out': nrm(ks[11], (N_A_LAYERS, D_MODEL, D_MODEL), D_MODEL ** -0.5),
        'a_gnorm': gain(ks[12], (N_A_LAYERS, A_DV)),
        'b_w_in': nrm(ks[13], (N_B_LAYERS, D_MODEL, B_IN_DIM), D_MODEL ** -0.5),
        'b_w_out': nrm(ks[14], (N_B_LAYERS, D_MODEL, D_MODEL), D_MODEL ** -0.5),
        'b_q_norm': gain(ks[15], (N_B_LAYERS, B_HEAD_DIM)),
        'b_k_norm': gain(ks[16], (N_B_LAYERS, B_HEAD_DIM)),
        'b_kidx_norm': gain(ks[17], (N_B_LAYERS, IDX_DIM)),
        'rel_bias': nrm(ks[18], (REL_BUCKETS, B_HEADS), 0.1),
        'ffn_w_gu': nrm(ks[19], (DEPTH, D_MODEL, 2 * D_FF), D_MODEL ** -0.5),
        'ffn_w_down': nrm(ks[20], (DEPTH, D_FF, D_MODEL), D_FF ** -0.5),
    }


def reference(x_prompt, x_sample, state_hgrn, cache_k, cache_v, cache_kidx, page_table,
              norm_mix, norm_ffn, lb_logits, a_w_in, a_w_out, a_gnorm,
              b_w_in, b_w_out, b_q_norm, b_k_norm, b_kidx_norm, rel_bias,
              ffn_w_gu, ffn_w_down):
    lb_all = jnp.cumsum(jax.nn.softmax(lb_logits.astype(jnp.float32), axis=0), axis=0)
    yp, ys = x_prompt, x_sample
    hs_p, hs_s, kp, vp, kip, ksm, vsm, kism = [], [], [], [], [], [], [], []
    for i in range(DEPTH):
        j = i // N_MIXERS
        if i % N_MIXERS == 0:
            s0 = jnp.zeros((yp.shape[0], A_HEADS, A_DK, A_DV), yp.dtype)
            yp, sp_ = _hgrn2_mixer(yp, s0, norm_mix[i], a_w_in[j], a_w_out[j], a_gnorm[j], lb_all[i])
            ys, ss_ = _hgrn2_mixer(ys, state_hgrn[j], norm_mix[i], a_w_in[j], a_w_out[j], a_gnorm[j], lb_all[i])
            hs_p.append(sp_)
            hs_s.append(ss_)
        else:
            yp, k_, v_, ki_ = _dsa_prompt(yp, norm_mix[i], b_w_in[j], b_w_out[j],
                                          b_q_norm[j], b_k_norm[j], b_kidx_norm[j], rel_bias)
            ys, k2, v2, ki2 = _dsa_sample(ys, cache_k[j], cache_v[j], cache_kidx[j], page_table,
                                          norm_mix[i], b_w_in[j], b_w_out[j],
                                          b_q_norm[j], b_k_norm[j], b_kidx_norm[j], rel_bias)
            kp.append(k_)
            vp.append(v_)
            kip.append(ki_)
            ksm.append(k2)
            vsm.append(v2)
            kism.append(ki2)
        yp = _ffn(yp, norm_ffn[i], ffn_w_gu[i], ffn_w_down[i])
        ys = _ffn(ys, norm_ffn[i], ffn_w_gu[i], ffn_w_down[i])
    state_hgrn_prompt = jnp.stack(hs_p)
    state_hgrn_sample = jnp.stack(hs_s)
    k_prompt = jnp.stack(kp)
    v_prompt = jnp.stack(vp)
    kidx_prompt = jnp.stack(kip)
    k_sample = jnp.stack(ksm)
    v_sample = jnp.stack(vsm)
    kidx_sample = jnp.stack(kism)
    return (yp, ys, state_hgrn_prompt, state_hgrn_sample, k_prompt, v_prompt, kidx_prompt, k_sample, v_sample, kidx_sample)
```

```cpp
#include <hip/hip_runtime.h>
#include <cstdio>
#include <cstdint>
namespace pg8 {
#define PG8_LAS __attribute__((address_space(3)))
typedef unsigned short bf16_t;
typedef short bf16x8 __attribute__((ext_vector_type(8)));
typedef float f32x4 __attribute__((ext_vector_type(4)));
typedef unsigned u32x4 __attribute__((ext_vector_type(4)));
constexpr int BM = 256, BK = 64, HALF = 128, HTB = HALF * BK * 2  , STAGE_BYTES = 8 * HTB, NXCD = 8, WGM = 8;

__host__ __device__ __forceinline__ int lds_byte(int r, int c) { const int st = (r >> 4) * 2 + (c >> 5), rr = r & 15, cc = c & 31, ob = rr * 64 + cc * 2; return st * 1024 + (ob ^ (((ob >> 9) & 1) << 5)); }
__host__ __device__ __forceinline__ void stage_rc(int b, int& R, int& C) { const int st = b / 1024, sb = b % 1024, swz = sb ^ (((sb >> 9) & 1) << 5); R = (st >> 1) * 16 + swz / 64; C = (st & 1) * 32 + (swz % 64) / 2; }
__host__ __device__ __forceinline__ int perm32(int rho) { const int n = rho >> 4, i = rho & 15; return 8 * (i >> 2) + 4 * n + (i & 3); }

struct Unit { int pm, pn; };
struct Gemm { const bf16_t* A; const bf16_t* Bt; int M, N, K; };

struct StaticOrder {
    int nM, nN, nwg, G, c;
    __host__ __device__ void init(int M, int N, int G_, int c_) { nM = M / BM; nN = N / BM; nwg = nM * nN; G = G_; c = c_; }
    __host__ __device__ bool next(int i, Unit& u) const {
        const long L = (long)i * G + c; if (L >= nwg) return false;
        int wgid = (int)L; { const int q = nwg / NXCD, r = nwg % NXCD, xcd = wgid % NXCD, off = wgid / NXCD; wgid = (xcd < r ? xcd * (q + 1) : r * (q + 1) + (xcd - r) * q) + off; }
        const int nig = WGM * nN, gid = wgid / nig, fm = gid * WGM, gsz = (nM - fm) < WGM ? (nM - fm) : WGM;
        u.pm = fm + ((wgid % nig) % gsz); u.pn = (wgid % nig) / gsz; return true;
    }
    __device__ __forceinline__ void a_ready(const Unit&) const {}
    __device__ __forceinline__ void done(const Unit&) const {}
};

__device__ __forceinline__ unsigned cvt_pk_bf16(float lo, float hi) { unsigned r; asm volatile("v_cvt_pk_bf16_f32 %0, %1, %2" : "=v"(r) : "v"(lo), "v"(hi)); return r; }
template <class Epi, class Sched, bool ALIGN_EPI = false, bool SP2 = false>
__device__ __forceinline__ void gemm_phase(PG8_LAS unsigned char* lds, const Gemm g, const Sched& S, const Epi& E, const int wid  ) {
    int lane; asm volatile("v_mbcnt_lo_u32_b32 %0, -1, 0\n\tv_mbcnt_hi_u32_b32 %0, -1, %0" : "=v"(lane));
    const int tid = wid * 64 + lane, wr = wid >> 2, wc = wid & 3, fr = lane & 15, fq = lane >> 4;
    const int K = g.K, nt = K / BK;
    unsigned voffA[2], voffB[2];
#pragma unroll
    for (int i = 0; i < 2; ++i) { int R, C; stage_rc(tid * 16 + i * 8192, R, C); const int Rb = Epi::PERM ? ((R & ~31) + perm32(R & 31)) : R;
        voffA[i] = (unsigned)(R * K + C) * 2u; voffB[i] = (unsigned)(Rb * K + C) * 2u; }
    const size_t kstep = (size_t)(BK * 2);
    const size_t hstep = (size_t)HALF * K * 2;
    const size_t tstep = 2 * hstep;
    const unsigned ldsw = (unsigned)wid * 1024u;
    const int aoff = lds_byte(wr * 64 + fr, fq * 8), boff = lds_byte(wc * 32 + fr, fq * 8);
#define PG8_SA(b, h) (((b) * 2 + (h)) * HTB)
#define PG8_SB(b, h) ((4 + (b) * 2 + (h)) * HTB)
#define PG8_STAGE(bufoff, gbase, voff) do { _Pragma("unroll") for (int _i = 0; _i < 2; ++_i) \
        __builtin_amdgcn_global_load_lds((const unsigned*)((const char*)(gbase) + (voff)[_i]), (PG8_LAS unsigned*)(lds + (bufoff) + ldsw + _i * 8192), 16, 0, 0); } while (0)
#define PG8_LDA(dst, b, h) do { _Pragma("unroll") for (int m = 0; m < 4; ++m) _Pragma("unroll") for (int k = 0; k < 2; ++k) dst[m][k] = *(const PG8_LAS bf16x8*)(lds + PG8_SA(b, h) + aoff + m * 2048 + k * 1024); } while (0)
#define PG8_LDB(dst, b, h) do { _Pragma("unroll") for (int n = 0; n < 2; ++n) _Pragma("unroll") for (int k = 0; k < 2; ++k) dst[n][k] = *(const PG8_LAS bf16x8*)(lds + PG8_SB(b, h) + boff + n * 2048 + k * 1024); } while (0)
#define PG8_MMA(ai, bj, At, Bt) do { __builtin_amdgcn_s_setprio(1); _Pragma("unroll") for (int m = 0; m < 4; ++m) _Pragma("unroll") for (int n = 0; n < 2; ++n) _Pragma("unroll") for (int k = 0; k < 2; ++k) \
        acc[ai][bj][m][n] = __builtin_amdgcn_mfma_f32_16x16x32_bf16(Bt[n][k], At[m][k], acc[ai][bj][m][n], 0, 0, 0); __builtin_amdgcn_s_setprio(0); } while (0)
#define PG8_WAIT_V(n) asm volatile("s_waitcnt vmcnt(" #n ")" ::: "memory")
#define PG8_WAIT_L(n) asm volatile("s_waitcnt lgkmcnt(" #n ")" ::: "memory")
#define PG8_BAR __builtin_amdgcn_s_barrier()
#define PG8_SCHED __builtin_amdgcn_sched_barrier(0)
    Unit cur, nxt; int ui = 0;
    if (!S.next(0, cur)) return;
    f32x4 acc[2][2][4][2];
#pragma unroll
    for (int a = 0; a < 2; ++a)
#pragma unroll
        for (int b = 0; b < 2; ++b)
#pragma unroll
            for (int m = 0; m < 4; ++m)
#pragma unroll
                for (int n = 0; n < 2; ++n) acc[a][b][m][n] = (f32x4){0.f, 0.f, 0.f, 0.f};
    bf16x8 At[4][2], B0[2][2], B1[2][2];
    const char* cA = (const char*)g.A + (size_t)cur.pm * tstep; const char* cB = (const char*)g.Bt + (size_t)cur.pn * tstep;
    S.a_ready(cur);
    if constexpr (SP2) {
        PG8_STAGE(PG8_SB(0, 0), cB, voffB); PG8_STAGE(PG8_SB(0, 1), cB + hstep, voffB); PG8_STAGE(PG8_SA(0, 0), cA, voffA); PG8_STAGE(PG8_SA(0, 1), cA + hstep, voffA);
        if (wr == 1) PG8_BAR;
        PG8_WAIT_V(2); PG8_BAR;
        PG8_STAGE(PG8_SB(1, 0), cB + kstep, voffB); PG8_STAGE(PG8_SA(1, 0), cA + kstep, voffA); PG8_STAGE(PG8_SB(1, 1), cB + hstep + kstep, voffB);
        PG8_WAIT_V(6); PG8_BAR;
    } else {
        PG8_STAGE(PG8_SB(0, 0), cB, voffB); PG8_STAGE(PG8_SA(0, 0), cA, voffA); PG8_STAGE(PG8_SB(0, 1), cB + hstep, voffB); PG8_STAGE(PG8_SA(0, 1), cA + hstep, voffA);
        if (wr == 1) PG8_BAR;
        PG8_WAIT_V(4); PG8_BAR;
        PG8_STAGE(PG8_SB(1, 0), cB + kstep, voffB); PG8_STAGE(PG8_SA(1, 0), cA + kstep, voffA); PG8_STAGE(PG8_SB(1, 1), cB + hstep + kstep, voffB);
        PG8_WAIT_V(6); PG8_BAR;
    }
    for (;;) {
        const bool has_next = S.next(ui + 1, nxt);
        const char* nA = has_next ? (const char*)g.A + (size_t)nxt.pm * tstep : cA; const char* nB = has_next ? (const char*)g.Bt + (size_t)nxt.pn * tstep : cB;
        for (int t = 0; t < nt; t += 2) {
            const bool last = (t == nt - 2);
            const char* a1 = cA + (size_t)(t + 1) * kstep;
            const char* a2 = last ? nA : cA + (size_t)(t + 2) * kstep; const char* b2 = last ? nB : cB + (size_t)(t + 2) * kstep;
            const char* a3 = a2 + kstep; const char* b3 = b2 + kstep;
            if (last && has_next) S.a_ready(nxt);
            if constexpr (SP2) {
            PG8_LDB(B0, 0, 0); PG8_LDB(B1, 0, 1); PG8_SCHED; PG8_LDA(At, 0, 0); PG8_STAGE(PG8_SA(1, 1), a1 + hstep, voffA);
            PG8_WAIT_V(8); PG8_WAIT_L(0); PG8_BAR; PG8_MMA(0, 0, At, B0); PG8_MMA(0, 1, At, B1); PG8_BAR; PG8_SCHED;
            PG8_LDA(At, 0, 1); PG8_STAGE(PG8_SB(0, 0), b2, voffB); PG8_STAGE(PG8_SB(0, 1), b2 + hstep, voffB); PG8_STAGE(PG8_SA(0, 0), a2, voffA);
            PG8_WAIT_V(8); PG8_WAIT_L(0); PG8_BAR; PG8_MMA(1, 0, At, B0); PG8_MMA(1, 1, At, B1); PG8_BAR; PG8_SCHED;
            PG8_LDB(B0, 1, 0); PG8_LDB(B1, 1, 1); PG8_SCHED; PG8_LDA(At, 1, 0); PG8_STAGE(PG8_SA(0, 1), a2 + hstep, voffA);
            PG8_WAIT_V(8); PG8_WAIT_L(0); PG8_BAR; PG8_MMA(0, 0, At, B0); PG8_MMA(0, 1, At, B1); PG8_BAR; PG8_SCHED;
            PG8_LDA(At, 1, 1); PG8_STAGE(PG8_SB(1, 0), b3, voffB); PG8_STAGE(PG8_SB(1, 1), b3 + hstep, voffB); PG8_STAGE(PG8_SA(1, 0), a3, voffA);
            PG8_WAIT_V(8); PG8_WAIT_L(0); PG8_BAR; PG8_MMA(1, 0, At, B0); PG8_MMA(1, 1, At, B1); PG8_BAR; PG8_SCHED;
            } else {
            PG8_LDB(B0, 0, 0); PG8_SCHED; PG8_LDA(At, 0, 0); PG8_STAGE(PG8_SA(1, 1), a1 + hstep, voffA);
            PG8_WAIT_L(8); PG8_BAR; PG8_WAIT_L(0); PG8_MMA(0, 0, At, B0); PG8_BAR; PG8_SCHED;
            PG8_LDB(B1, 0, 1); PG8_STAGE(PG8_SB(0, 0), b2, voffB);
            PG8_BAR; PG8_WAIT_L(0); PG8_MMA(0, 1, At, B1); PG8_BAR;
            PG8_LDA(At, 0, 1); PG8_STAGE(PG8_SA(0, 0), a2, voffA);
            PG8_BAR; PG8_WAIT_L(0); PG8_MMA(1, 0, At, B0); PG8_BAR; PG8_SCHED;
            PG8_STAGE(PG8_SB(0, 1), b2 + hstep, voffB);
            PG8_WAIT_V(6); PG8_BAR; PG8_MMA(1, 1, At, B1); PG8_BAR;
            PG8_LDB(B0, 1, 0); PG8_SCHED; PG8_LDA(At, 1, 0); PG8_STAGE(PG8_SA(0, 1), a2 + hstep, voffA);
            PG8_WAIT_L(8); PG8_BAR; PG8_WAIT_L(0); PG8_MMA(0, 0, At, B0); PG8_BAR; PG8_SCHED;
            PG8_LDB(B1, 1, 1); PG8_STAGE(PG8_SB(1, 0), b3, voffB);
            PG8_BAR; PG8_WAIT_L(0); PG8_MMA(0, 1, At, B1); PG8_BAR;
            PG8_LDA(At, 1, 1); PG8_STAGE(PG8_SA(1, 0), a3, voffA);
            PG8_BAR; PG8_WAIT_L(0); PG8_MMA(1, 0, At, B0); PG8_BAR; PG8_SCHED;
            PG8_STAGE(PG8_SB(1, 1), b3 + hstep, voffB);
            PG8_WAIT_V(6); PG8_BAR; PG8_MMA(1, 1, At, B1); PG8_BAR;
            }
        }
        if constexpr (ALIGN_EPI) { if (wr == 0) PG8_BAR; }
        if constexpr (!Epi::AFTER_DRAIN) { E(acc, cur, wr, wc, fr, fq); S.done(cur); }
        if (!has_next) break;
#pragma unroll
        for (int a = 0; a < 2; ++a)
#pragma unroll
            for (int b = 0; b < 2; ++b)
#pragma unroll
                for (int m = 0; m < 4; ++m)
#pragma unroll
                    for (int n = 0; n < 2; ++n) acc[a][b][m][n] = (f32x4){0.f, 0.f, 0.f, 0.f};
        cur = nxt; cA = nA; cB = nB; ++ui;
        if constexpr (ALIGN_EPI) { if (wr == 1) PG8_BAR; }
    }
    PG8_WAIT_V(0);
    if constexpr (!ALIGN_EPI) { if (wr == 0) PG8_BAR; }
    PG8_BAR;
    if constexpr (Epi::AFTER_DRAIN) { E.fused(acc, cur, wr, wc, fr, fq, lds, wid, lane); S.done(cur); }
#undef PG8_SA
#undef PG8_SB
#undef PG8_STAGE
#undef PG8_LDA
#undef PG8_LDB
#undef PG8_MMA
#undef PG8_WAIT_V
#undef PG8_WAIT_L
#undef PG8_BAR
#undef PG8_SCHED
}
}

#define DI __device__ __forceinline__
#define GAS __attribute__((address_space(1)))
#define LAS __attribute__((address_space(3)))
typedef unsigned short bf16;
typedef unsigned v4u __attribute__((ext_vector_type(4)));
typedef unsigned v2u __attribute__((ext_vector_type(2)));
typedef int v4i __attribute__((ext_vector_type(4)));
typedef float f32x4 __attribute__((ext_vector_type(4)));
typedef float f32x2 __attribute__((ext_vector_type(2)));
typedef float f32x16 __attribute__((ext_vector_type(16)));
typedef short bf16x8 __attribute__((ext_vector_type(8)));
typedef short s16x4 __attribute__((ext_vector_type(4)));

constexpr int D = 2048, T = 8192, BS = 128, FF = 5632;
constexpr int NA = 8192;
constexpr int NBR = 5264, NB = 5376;
constexpr int PAST = 2048, PAGE = 128, NPAGES = 16, TOPK = 256;
constexpr int SPAD = 192, DS_ = D + SPAD, FFS_ = FF + SPAD;
constexpr int SCS_LD = 2112;
constexpr float EPS = 1e-6f;
constexpr int NWAVES = 8, NTHR = 512;
constexpr int NPHASE = 15;
#ifndef MK_ONE_LAUNCH
#define MK_ONE_LAUNCH 1
#endif

constexpr size_t MiB = 1u << 20;
constexpr size_t WS_CTL = 0, CTL_ZERO_BYTES = 1 * MiB;
constexpr size_t WS_LB0 = 1 * MiB;
constexpr size_t WS_LUT = 1 * MiB + 65536;
constexpr size_t WS_SSQ = 1 * MiB + 131072;
constexpr size_t WS_WA_IN = 2 * MiB, WS_WA_OUT = 34 * MiB, WS_WGU0 = 42 * MiB, WS_WD0 = 86 * MiB, WS_WB_IN = 108 * MiB, WS_WB_OUT = 130 * MiB, WS_WGU1 = 138 * MiB, WS_WD1 = 182 * MiB;
constexpr size_t WS_HP = 204 * MiB, WS_ZQ = 236 * MiB, WS_ZK = 268 * MiB, WS_ZV = 300 * MiB, WS_ZG = 332 * MiB, WS_LF = 364 * MiB, WS_QG = 428 * MiB, WS_OL = 460 * MiB;
constexpr size_t WS_DS = 524 * MiB, WS_DSC = 540 * MiB, WS_OG = 542 * MiB, WS_Y1 = 574 * MiB, WS_HID = 638 * MiB, WS_Y2 = 726 * MiB, WS_Y3 = 790 * MiB;
constexpr size_t WS_QRAW = 854 * MiB, WS_QIB = 886 * MiB, WS_KRAW = 918 * MiB, WS_KIRAW = 934 * MiB, WS_WI = 938 * MiB, WS_KB = 940 * MiB, WS_VB = 948 * MiB, WS_KIB = 956 * MiB;
constexpr size_t WS_SC = 960 * MiB, WS_IDX = 1216 * MiB, WS_OATT = 1224 * MiB;
constexpr size_t WS_HS = 1256 * MiB, WS_RS1 = 1257 * MiB, WS_OGS = 1261 * MiB, WS_Y1S = 1262 * MiB, WS_HIDS = 1263 * MiB, WS_Y2S = 1265 * MiB, WS_R5S = 1266 * MiB;
constexpr size_t WS_QNS = 1269 * MiB, WS_SCS = 1270 * MiB, WS_IDXS = 1272 * MiB, WS_OATTS = 1273 * MiB, WS_Y3S = 1274 * MiB, WS_K8 = 1276 * MiB, WS_V8 = 1280 * MiB, WS_END = 1284 * MiB;

constexpr size_t O_YP = 0, O_YS = O_YP + (size_t)T * D, O_SP = O_YS + (size_t)BS * D, O_SS = O_SP + 16 * 128 * 128, O_KP = O_SS + (size_t)BS * 16 * 128 * 128;
constexpr size_t O_VP = O_KP + (size_t)T * 512, O_KIP = O_VP + (size_t)T * 512, O_KS = O_KIP + (size_t)T * 128, O_VS = O_KS + BS * 512, O_KIS = O_VS + BS * 512, O_END = O_KIS + BS * 128;

constexpr int CW_TMO = 0, CW_BAR = 4096;

constexpr int RING_BYTES = 131072, WSLAB = 16640  , LUT_OFF = NWAVES * WSLAB  , LUT_BYTES = 129 * 16 * 4  , MISC_OFF = 141440, LDS_BYTES = 147456;
static_assert(LUT_OFF >= RING_BYTES && LUT_OFF + LUT_BYTES <= MISC_OFF && MISC_OFF + 256 <= LDS_BYTES, "LDS map");

struct Args { const void* in[21]; float* out; unsigned char* ws; int ph_lo, ph_hi, li, pad; };

DI float bf2f(unsigned b) { return __uint_as_float(b << 16); }
typedef __bf16 bf16x2_t __attribute__((ext_vector_type(2)));
DI unsigned pk2(float lo, float hi) { const f32x2 v = {lo, hi}; return __builtin_bit_cast(unsigned, __builtin_convertvector(v, bf16x2_t)); }
DI float wave_sum(float v) {
#pragma unroll
    for (int o = 1; o < 64; o <<= 1) v += __shfl_xor(v, o);
    return v;
}
DI float grp16_sum(float v) {
#pragma unroll
    for (int o = 1; o < 16; o <<= 1) v += __shfl_xor(v, o);
    return v;
}
DI float sigm(float x) { return 1.f / (1.f + __expf(-x)); }
DI float silu(float x) { return x / (1.f + __expf(-x)); }
#define LDS_WAIT() asm volatile("s_waitcnt lgkmcnt(0)" ::: "memory")
#define VM_WAIT() asm volatile("s_waitcnt vmcnt(0)" ::: "memory")
#define MFMA16(a, b, c) __builtin_amdgcn_mfma_f32_16x16x32_bf16((a), (b), (c), 0, 0, 0)
#define MFMA32(a, b, c) __builtin_amdgcn_mfma_f32_32x32x16_bf16((a), (b), (c), 0, 0, 0)
DI bf16x8 pack8(const f32x4& a, const f32x4& b) { v4u w; w.x = pk2(a[0], a[1]); w.y = pk2(a[2], a[3]); w.z = pk2(b[0], b[1]); w.w = pk2(b[2], b[3]); return __builtin_bit_cast(bf16x8, w); }
DI bf16x8 pack8f(const float* p) { v4u w; w.x = pk2(p[0], p[1]); w.y = pk2(p[2], p[3]); w.z = pk2(p[4], p[5]); w.w = pk2(p[6], p[7]); return __builtin_bit_cast(bf16x8, w); }
static_assert(WS_ZK - WS_ZQ == (size_t)T * D * 2 && WS_ZV - WS_ZK == (size_t)T * D * 2 && WS_ZG - WS_ZV == (size_t)T * D * 2, "ZQ|ZK|ZV|ZG consecutive");

DI void rmsnorm_row(const float* x, const float* g, bf16* o, int lane) {
    const f32x4* xr = (const f32x4*)x + lane; const f32x4* gr = (const f32x4*)g + lane;
    f32x4 v[8]; float s = 0.f;
#pragma unroll
    for (int j = 0; j < 8; ++j) { v[j] = xr[64 * j]; s += (v[j].x * v[j].x + v[j].y * v[j].y) + (v[j].z * v[j].z + v[j].w * v[j].w); }
    const float rs = rsqrtf(wave_sum(s) * (1.f / D) + EPS);
    v2u* o8 = (v2u*)o + lane;
#pragma unroll
    for (int j = 0; j < 8; ++j) { const f32x4 gg = gr[64 * j]; v2u w; w.x = pk2(v[j].x * rs * gg.x, v[j].y * rs * gg.y); w.y = pk2(v[j].z * rs * gg.z, v[j].w * rs * gg.w); o8[64 * j] = w; }
}

struct TrItem { const float* W; bf16* WT; int K, N, mode, item; };
DI void tr_load(const TrItem& t, int lane, f32x4 (&r)[16]) {
    const int nblk = (t.N + 63) / 64, kb = t.item / nblk, nb = t.item % nblk, k0 = 64 * kb, n0 = 64 * nb, nq = lane & 15;
    const bool ok = n0 + 4 * nq < t.N;
    const float* p = t.W + (size_t)(k0 + (lane >> 4)) * t.N + n0 + 4 * nq;
#pragma unroll
    for (int i = 0; i < 16; ++i) r[i] = ok ? __builtin_nontemporal_load((const f32x4*)(p + (size_t)(4 * i) * t.N)) : (f32x4){0.f, 0.f, 0.f, 0.f};
}
DI void tr_store(const TrItem& t, int lane, const f32x4 (&r)[16], LAS float* scr) {
    const int nblk = (t.N + 63) / 64, kb = t.item / nblk, nb = t.item % nblk, k0 = 64 * kb, n0 = 64 * nb, nq = lane & 15;
#pragma unroll
    for (int i = 0; i < 16; ++i) { LAS float* d = scr + (4 * i + (lane >> 4)) * 65 + 4 * nq; d[0] = r[i][0]; d[1] = r[i][1]; d[2] = r[i][2]; d[3] = r[i][3]; }
    LDS_WAIT(); asm volatile("" ::: "memory");
    int row0 = n0;
    if (t.mode == 1) { row0 = (n0 < FF) ? 256 * (n0 / 128) + (n0 % 128) : 256 * ((n0 - FF) / 128) + 128 + ((n0 - FF) % 128); }
    const int c = lane & 7;
#pragma unroll
    for (int j = 0; j < 8; ++j) { const int n = (lane >> 3) + 8 * j; const LAS float* s = scr + (8 * c) * 65 + n;
        v4u o; o.x = pk2(s[0 * 65], s[1 * 65]); o.y = pk2(s[2 * 65], s[3 * 65]); o.z = pk2(s[4 * 65], s[5 * 65]); o.w = pk2(s[6 * 65], s[7 * 65]);
        *(v4u*)(t.WT + (size_t)(row0 + n) * t.K + k0 + 8 * c) = o; }
    LDS_WAIT(); asm volatile("" ::: "memory");
}

#define EPI_LOOP_BEGIN  _Pragma("unroll") for (int ai = 0; ai < 2; ++ai) _Pragma("unroll") for (int m = 0; m < 4; ++m) { const int row = u.pm * 256 + ai * 128 + wr * 64 + m * 16 + fr;
#define EPI_LOOP_END }

struct EpiA {
    static constexpr bool PERM = true, AFTER_DRAIN = false;
    bf16* zq; float* lf; const float* lb0;
    DI void operator()(const f32x4 (&acc)[2][2][4][2], const pg8::Unit& u, int wr, int wc, int fr, int fq) const {
        const int ty = u.pn >> 3, cbase = (u.pn & 7) * 256 + wc * 32 + 8 * fq;
        if (ty == 1) {
            f32x4 lbv[2][2];
#pragma unroll
            for (int bj = 0; bj < 2; ++bj) { lbv[bj][0] = *(const f32x4*)(lb0 + cbase + bj * 128); lbv[bj][1] = *(const f32x4*)(lb0 + cbase + bj * 128 + 4); }
            EPI_LOOP_BEGIN
#pragma unroll
                for (int bj = 0; bj < 2; ++bj) { const size_t o = (size_t)row * D + cbase + bj * 128; f32x4 lg[2], kk[2];
#pragma unroll
                    for (int n = 0; n < 2; ++n)
#pragma unroll
                        for (int e = 0; e < 4; ++e) { const float f = fminf(fmaxf(acc[ai][bj][m][n][e], -30.f), 30.f), lb = lbv[bj][n][e], ef = __expf(-f), sg = 1.f / (1.f + ef), sgn = ef / (1.f + ef);
                            lg[n][e] = __logf(lb + (1.f - lb) * sg); kk[n][e] = (1.f - lb) * sgn; }
                    *(f32x4*)(lf + o) = lg[0]; *(f32x4*)(lf + o + 4) = lg[1]; *(bf16x8*)(zq + (size_t)T * D + o) = pack8(kk[0], kk[1]); }
            EPI_LOOP_END
        } else {
            bf16* dst = zq + (size_t)ty * T * D;
            EPI_LOOP_BEGIN
#pragma unroll
                for (int bj = 0; bj < 2; ++bj) { const size_t o = (size_t)row * D + cbase + bj * 128; f32x4 a = acc[ai][bj][m][0], b = acc[ai][bj][m][1];
                    if (ty != 2) {
#pragma unroll
                        for (int e = 0; e < 4; ++e) { a[e] = silu(a[e]); b[e] = silu(b[e]); } }
                    *(bf16x8*)(dst + o) = pack8(a, b); }
            EPI_LOOP_END
        }
    }
};
template <bool RESB, bool OUTB>
struct EpiRes {
    static constexpr bool PERM = true, AFTER_DRAIN = false;
    const void* res; void* out; const float* gain; bf16* hp; float* ssq;
    DI void operator()(const f32x4 (&acc)[2][2][4][2], const pg8::Unit& u, int wr, int wc, int fr, int fq) const {
        const int cbase = u.pn * 256 + wc * 32 + 8 * fq;
        f32x4 gv[2][2];
        if (gain) {
#pragma unroll
            for (int bj = 0; bj < 2; ++bj) { gv[bj][0] = *(const f32x4*)(gain + cbase + bj * 128); gv[bj][1] = *(const f32x4*)(gain + cbase + bj * 128 + 4); } }
#pragma unroll
        for (int ai = 0; ai < 2; ++ai) {
            f32x4 rr[4][2][2];
#pragma unroll
            for (int m = 0; m < 4; ++m)
#pragma unroll
                for (int bj = 0; bj < 2; ++bj) { const size_t o = (size_t)(u.pm * 256 + ai * 128 + wr * 64 + m * 16 + fr) * D + cbase + bj * 128;
                    if (RESB) { const v4u w = *(const v4u*)((const bf16*)res + o);
                        rr[m][bj][0] = (f32x4){bf2f(w.x & 0xffffu), bf2f(w.x >> 16), bf2f(w.y & 0xffffu), bf2f(w.y >> 16)}; rr[m][bj][1] = (f32x4){bf2f(w.z & 0xffffu), bf2f(w.z >> 16), bf2f(w.w & 0xffffu), bf2f(w.w >> 16)}; }
                    else { rr[m][bj][0] = *(const f32x4*)((const float*)res + o); rr[m][bj][1] = *(const f32x4*)((const float*)res + o + 4); } }
#pragma unroll
            for (int m = 0; m < 4; ++m) { const int row = u.pm * 256 + ai * 128 + wr * 64 + m * 16 + fr;
                float sq = 0.f;
#pragma unroll
                for (int bj = 0; bj < 2; ++bj) { const size_t o = (size_t)row * D + cbase + bj * 128;
                    const f32x4 y0 = acc[ai][bj][m][0] + rr[m][bj][0], y1 = acc[ai][bj][m][1] + rr[m][bj][1];
                    if (OUTB) *(bf16x8*)((bf16*)out + o) = pack8(y0, y1); else { __builtin_nontemporal_store(y0, (f32x4*)((float*)out + o)); __builtin_nontemporal_store(y1, (f32x4*)((float*)out + o + 4)); }
                    if (gain) { *(bf16x8*)(hp + o) = pack8(y0 * gv[bj][0], y1 * gv[bj][1]);
                        sq += (y0[0] * y0[0] + y0[1] * y0[1]) + (y0[2] * y0[2] + y0[3] * y0[3]) + (y1[0] * y1[0] + y1[1] * y1[1]) + (y1[2] * y1[2] + y1[3] * y1[3]); } }
                if (gain) { sq += __shfl_xor(sq, 16); sq += __shfl_xor(sq, 32); if (fq == 0) atomicAdd(ssq + row, sq); }
            }
        }
    }
};
struct EpiSwiglu {
    static constexpr bool PERM = true, AFTER_DRAIN = false;
    bf16* hid; const float* ssq;
    DI void operator()(const f32x4 (&acc)[2][2][4][2], const pg8::Unit& u, int wr, int wc, int fr, int fq) const {
        const int cbase = u.pn * 128 + wc * 32 + 8 * fq;
        EPI_LOOP_BEGIN
            const float rs = rsqrtf(ssq[row] * (1.f / D) + EPS);
            f32x4 a = acc[ai][0][m][0], b = acc[ai][0][m][1]; const f32x4 ua = acc[ai][1][m][0], ub = acc[ai][1][m][1];
#pragma unroll
            for (int e = 0; e < 4; ++e) { a[e] = silu(a[e] * rs) * (ua[e] * rs); b[e] = silu(b[e] * rs) * (ub[e] * rs); }
            *(bf16x8*)(hid + (size_t)row * FF + cbase) = pack8(a, b);
        EPI_LOOP_END
    }
};
struct EpiB {
    static constexpr bool PERM = true, AFTER_DRAIN = false;
    bf16 *qraw, *qib, *vb; float *kraw, *vout, *kiraw, *wi; const float* ssq;
    DI void operator()(const f32x4 (&acc_)[2][2][4][2], const pg8::Unit& u, int wr, int wc, int fr, int fq) const {
        const int pn = u.pn, ct = wc * 32 + 8 * fq;
        f32x4 acc[2][2][4][2];
#pragma unroll
        for (int ai = 0; ai < 2; ++ai)
#pragma unroll
            for (int m = 0; m < 4; ++m) { const float rs = rsqrtf(ssq[u.pm * 256 + ai * 128 + wr * 64 + m * 16 + fr] * (1.f / D) + EPS);
#pragma unroll
                for (int bj = 0; bj < 2; ++bj) { acc[ai][bj][m][0] = acc_[ai][bj][m][0] * rs; acc[ai][bj][m][1] = acc_[ai][bj][m][1] * rs; } }
        if (pn < 8 || (pn >= 12 && pn < 20)) {
            bf16* dst = pn < 8 ? qraw : qib; const int cbase = (pn < 8 ? pn : pn - 12) * 256 + ct;
            EPI_LOOP_BEGIN
#pragma unroll
                for (int bj = 0; bj < 2; ++bj) *(bf16x8*)(dst + (size_t)row * D + cbase + bj * 128) = pack8(acc[ai][bj][m][0], acc[ai][bj][m][1]);
            EPI_LOOP_END
        } else if (pn < 10) {
            const int cbase = (pn - 8) * 256 + ct;
            EPI_LOOP_BEGIN
#pragma unroll
                for (int bj = 0; bj < 2; ++bj) { float* p = kraw + (size_t)row * 512 + cbase + bj * 128; *(f32x4*)p = acc[ai][bj][m][0]; *(f32x4*)(p + 4) = acc[ai][bj][m][1]; }
            EPI_LOOP_END
        } else if (pn < 12) {
            const int cbase = (pn - 10) * 256 + ct;
            EPI_LOOP_BEGIN
#pragma unroll
                for (int bj = 0; bj < 2; ++bj) { const size_t o = (size_t)row * 512 + cbase + bj * 128; __builtin_nontemporal_store(acc[ai][bj][m][0], (f32x4*)(vout + o)); __builtin_nontemporal_store(acc[ai][bj][m][1], (f32x4*)(vout + o + 4));
                    *(bf16x8*)(vb + o) = pack8(acc[ai][bj][m][0], acc[ai][bj][m][1]); }
            EPI_LOOP_END
        } else {
            const float wsc = 0.25f * 0.08838834764831845f;
            EPI_LOOP_BEGIN
                { float* p = kiraw + (size_t)row * 128 + ct; *(f32x4*)p = acc[ai][0][m][0]; *(f32x4*)(p + 4) = acc[ai][0][m][1]; }
                if (ct < 16) { float* p = wi + (size_t)row * 16 + ct; *(f32x4*)p = acc[ai][1][m][0] * wsc; *(f32x4*)(p + 4) = acc[ai][1][m][1] * wsc; }
            EPI_LOOP_END
        }
    }
};

template <int V> struct IntC { static constexpr int value = V; };
template <int S, int E, class LF> DI void skg_prime(const LF& L) { if constexpr (S < E) { L(IntC<S>{}); skg_prime<S + 1, E>(L); } }
template <int S, int NST, int NS, class LF, class MF>
DI void skg_stages(const LF& L, const MF& M) {
    if constexpr (S == 0) { skg_prime<0, (NS - 1 < NST ? NS - 1 : NST)>(L); }
    if constexpr (S < NST) {
        if constexpr (S + NS - 1 < NST) L(IntC<S + NS - 1>{});
        __builtin_amdgcn_sched_barrier(0);
        M(IntC<S>{});
        __builtin_amdgcn_sched_barrier(0);
        skg_stages<S + 1, NST, NS>(L, M);
    }
}
struct SkNorm { const float* ssq_in; const float* gain; bf16* hs; float* ssq_out; };
template <int MODE, int RT, int CT, int K>
DI void skinny_gemm(LAS unsigned char* lds, const bf16* A, int lda, const bf16* Bt, int ncb, float* out, const float* res, int ldo, bf16* hid, int bid, int G, int tid, int c0 = 0  , const SkNorm nrm = SkNorm{nullptr, nullptr, nullptr, nullptr}) {
    constexpr int R = 32 * RT, NRB = 128 / R, C = 16 * CT, LP = 36;
    constexpr int KSN = 8, RTW = 2 * RT, NPASS = CT / 2;
    static_assert(CT % 2 == 0 && 8 * R * LP * 4 <= 80 * 1024, "skinny_gemm: unit shape");
    const int wave = __builtin_amdgcn_readfirstlane(tid >> 6), lane = tid & 63, ks = wave, rh = 0, g = lane >> 4, lr = lane & 15;
    constexpr int Ks = K / KSN; const int nunits = ncb * NRB;
    LAS float* red = (LAS float*)lds;
    for (int u = bid - c0; u < nunits; u += G - c0) {
        if (u < 0) break;
        const int x8 = u & 7, j8 = u >> 3; const bool xo = (ncb & 7) == 0;
        const int cb = xo ? (j8 / NRB) * 8 + x8 : u / NRB, rb = xo ? j8 % NRB : u % NRB;
        int brow[CT];
#pragma unroll
        for (int ct = 0; ct < CT; ++ct) {
            if (MODE == 0) brow[ct] = C * cb + 16 * ct;
            else { const int h0 = (C / 2) * cb, pn = h0 >> 7, off = h0 & 127; brow[ct] = 256 * pn + off + (ct < CT / 2 ? 16 * ct : 128 + 16 * (ct - CT / 2)); }
        }
        f32x4 acc[RTW][CT];
#pragma unroll
        for (int rt = 0; rt < RTW; ++rt)
#pragma unroll
            for (int ct = 0; ct < CT; ++ct) acc[rt][ct] = (f32x4){0.f, 0.f, 0.f, 0.f};
        const bf16* ap = A + (size_t)(rb * R + rh * 16 * RTW + lr) * lda + 64 * ks + 16 * g;
        const bf16* bp = Bt + (size_t)lr * K + 64 * ks + 16 * g;
        constexpr int SK = 2, NST = Ks / (32 * SK), LPS = (RTW + CT) * SK, NS = (LPS * 4 <= 36) ? 4 : ((LPS * 3 <= 40) ? 3 : 2);
        static_assert(Ks % (32 * SK) == 0, "skinny_gemm: K quarter must be a whole number of stages");
        bf16x8 rga[NS][SK][RTW], rgb[NS][SK][CT];
#define SKG_LOAD(st) do { constexpr int s0_ = (st) * 32 * KSN * SK, sl_ = (st) % NS; _Pragma("unroll") for (int k_ = 0; k_ < SK; ++k_) { \
            _Pragma("unroll") for (int rt = 0; rt < RTW; ++rt) rga[sl_][k_][rt] = *(const bf16x8*)(ap + (size_t)(16 * rt) * lda + s0_ + 64 * KSN * (k_ >> 1) + 8 * (k_ & 1)); \
            _Pragma("unroll") for (int ct = 0; ct < CT; ++ct) rgb[sl_][k_][ct] = *(const bf16x8*)(bp + (size_t)brow[ct] * K + s0_ + 64 * KSN * (k_ >> 1) + 8 * (k_ & 1)); } } while (0)
#define SKG_MMA(st) do { constexpr int sl_ = (st) % NS; _Pragma("unroll") for (int k_ = 0; k_ < SK; ++k_) _Pragma("unroll") for (int rt = 0; rt < RTW; ++rt) _Pragma("unroll") for (int ct = 0; ct < CT; ++ct) \
            acc[rt][ct] = MFMA16(rga[sl_][k_][rt], rgb[sl_][k_][ct], acc[rt][ct]); } while (0)
        skg_stages<0, NST, NS>([&](auto st_) { constexpr int st = decltype(st_)::value; SKG_LOAD(st); }, [&](auto st_) { constexpr int st = decltype(st_)::value; SKG_MMA(st); });
#undef SKG_LOAD
#undef SKG_MMA
#pragma unroll
        for (int ps = 0; ps < NPASS; ++ps) {
            const int t0 = MODE == 0 ? 2 * ps : ps, t1 = MODE == 0 ? 2 * ps + 1 : ps + CT / 2;
#pragma unroll
            for (int rt = 0; rt < RTW; ++rt)
#pragma unroll
                for (int i = 0; i < 4; ++i) { red[(ks * R + 16 * rt + 4 * g + i) * LP + lr] = acc[rt][t0][i]; red[(ks * R + 16 * rt + 4 * g + i) * LP + 16 + lr] = acc[rt][t1][i]; }
            __syncthreads();
            if (MODE == 0) {
                for (int it = tid; it < R * 4; it += NTHR) {
                    const int rl = it >> 2, q = it & 3, row = rb * R + rl;
                    f32x4 s0 = (f32x4){0.f, 0.f, 0.f, 0.f}, s1 = s0;
#pragma unroll
                    for (int k = 0; k < KSN; ++k) { const LAS float* p = red + (k * R + rl) * LP + 8 * q; s0 += *(const LAS f32x4*)p; s1 += *(const LAS f32x4*)(p + 4); }
                    const int col = C * cb + 32 * ps + 8 * q; const size_t o = (size_t)row * ldo + col;
                    if (nrm.ssq_in) { const float rs = rsqrtf(nrm.ssq_in[row] * (1.f / D) + EPS); s0 = s0 * rs; s1 = s1 * rs; }
                    if (res) { s0 += *(const f32x4*)(res + o); s1 += *(const f32x4*)(res + o + 4); }
                    *(f32x4*)(out + o) = s0; *(f32x4*)(out + o + 4) = s1;
                    if (nrm.gain) { const f32x4 g0 = *(const f32x4*)(nrm.gain + col), g1 = *(const f32x4*)(nrm.gain + col + 4);
                        *(bf16x8*)(nrm.hs + (size_t)row * DS_ + col) = pack8(s0 * g0, s1 * g1);
                        float sq = (s0[0] * s0[0] + s0[1] * s0[1]) + (s0[2] * s0[2] + s0[3] * s0[3]) + (s1[0] * s1[0] + s1[1] * s1[1]) + (s1[2] * s1[2] + s1[3] * s1[3]);
                        sq += __shfl_xor(sq, 1); sq += __shfl_xor(sq, 2);
                        if (q == 0) atomicAdd(nrm.ssq_out + row, sq); }
                }
            } else {
                for (int it = tid; it < R * 2; it += NTHR) {
                    const int rl = it >> 1, q = it & 1, row = rb * R + rl;
                    f32x4 g0 = (f32x4){0.f, 0.f, 0.f, 0.f}, g1 = g0, u0 = g0, u1 = g0;
#pragma unroll
                    for (int k = 0; k < KSN; ++k) { const LAS float* p = red + (k * R + rl) * LP + 8 * q; g0 += *(const LAS f32x4*)p; g1 += *(const LAS f32x4*)(p + 4); u0 += *(const LAS f32x4*)(p + 16); u1 += *(const LAS f32x4*)(p + 20); }
                    const float rs = nrm.ssq_in ? rsqrtf(nrm.ssq_in[row] * (1.f / D) + EPS) : 1.f;
#pragma unroll
                    for (int e = 0; e < 4; ++e) { g0[e] = silu(g0[e] * rs) * (u0[e] * rs); g1[e] = silu(g1[e] * rs) * (u1[e] * rs); }
                    *(bf16x8*)(hid + (size_t)row * FFS_ + (C / 2) * cb + 16 * ps + 8 * q) = pack8(g0, g1);
                }
            }
            __syncthreads();
        }
    }
}

constexpr int HA_QS = 0, HA_KS = 16 * 272, HA_KE = 2 * 16 * 272, HA_DEC = HA_KE + 128 * 32, HA_BUF = HA_DEC + 512;
DI void hgrn_passA(LAS unsigned char* lds, const bf16* ZQ, const bf16* ZK, const bf16* ZV, const float* LF, bf16* QG, float* OL, float* DS, float* DSC, int bid, int G, int tid) {
    const int wave = __builtin_amdgcn_readfirstlane(tid >> 6), lane = tid & 63, g = lane >> 4, lr = lane & 15;
    for (int u = bid; u < 256; u += G) {
        const int h = u >> 4, sc = u & 15, t0 = sc * 512, col = h * 128 + 16 * wave + lr;
        float gbase = 0.f;
        f32x4 S[8];
#pragma unroll
        for (int j = 0; j < 8; ++j) S[j] = (f32x4){0.f, 0.f, 0.f, 0.f};
        unsigned short aq[4], ak[4], av[4], bq[4], bk[4], bv[4]; float al[4], bl[4];
#define HA_FETCH(q_, k_, v_, l_, cc) do { _Pragma("unroll") for (int j = 0; j < 4; ++j) { const size_t o_ = (size_t)(t0 + 16 * (cc) + 4 * g + j) * D + col; q_[j] = ZQ[o_]; k_[j] = ZK[o_]; v_[j] = ZV[o_]; l_[j] = LF[o_]; } } while (0)
        HA_FETCH(aq, ak, av, al, 0); HA_FETCH(bq, bk, bv, bl, 1);
#pragma unroll 2
        for (int c = 0; c < 32; ++c) {
            LAS unsigned char* B = lds + (c & 1) * HA_BUF;
            float q[4], k[4], lfv[4]; unsigned short vv[4];
            if ((c & 1) == 0) {
#pragma unroll
                for (int j = 0; j < 4; ++j) { q[j] = bf2f(aq[j]); k[j] = bf2f(ak[j]); lfv[j] = al[j]; vv[j] = av[j]; }
                if (c + 2 < 32) HA_FETCH(aq, ak, av, al, c + 2);
            } else {
#pragma unroll
                for (int j = 0; j < 4; ++j) { q[j] = bf2f(bq[j]); k[j] = bf2f(bk[j]); lfv[j] = bl[j]; vv[j] = bv[j]; }
                if (c + 2 < 32) HA_FETCH(bq, bk, bv, bl, c + 2);
            }
            float cs[4]; cs[0] = lfv[0]; cs[1] = cs[0] + lfv[1]; cs[2] = cs[1] + lfv[2]; cs[3] = cs[2] + lfv[3];
            const float t1 = __shfl(cs[3], (lane + 48) & 63), t2 = __shfl(cs[3], (lane + 32) & 63), t3 = __shfl(cs[3], (lane + 16) & 63);
            const float pre = (g >= 1 ? t1 : 0.f) + (g >= 2 ? t2 : 0.f) + (g >= 3 ? t3 : 0.f);
            const float gend = __shfl(pre + cs[3], lr + 48);
            float ke[4];
#pragma unroll
            for (int j = 0; j < 4; ++j) {
                const float G_ = pre + cs[j], eg = __expf(G_), qs = q[j] * eg;
                const int t = 4 * g + j;
                *(LAS unsigned short*)(B + HA_QS + t * 272 + 2 * (16 * wave + lr)) = (unsigned short)(pk2(qs, 0.f) & 0xffffu);
                *(LAS unsigned short*)(B + HA_KS + t * 272 + 2 * (16 * wave + lr)) = (unsigned short)(pk2(k[j] * __expf(-G_), 0.f) & 0xffffu);
                ke[j] = k[j] * __expf(gend - G_);
                QG[(size_t)(t0 + 16 * c + t) * D + col] = (unsigned short)(pk2(qs * __expf(gbase), 0.f) & 0xffffu);
            }
            { v2u w; w.x = pk2(ke[0], ke[1]); w.y = pk2(ke[2], ke[3]); *(LAS v2u*)(B + HA_KE + (16 * wave + lr) * 32 + 8 * g) = w; }
            if (g == 0) *(LAS float*)(B + HA_DEC + 4 * (16 * wave + lr)) = __expf(gend);
            gbase += gend;
            LDS_WAIT(); __builtin_amdgcn_s_barrier(); asm volatile("" ::: "memory");
            bf16x8 vreg; { v4u w; w.x = (unsigned)vv[0] | ((unsigned)vv[1] << 16); w.y = (unsigned)vv[2] | ((unsigned)vv[3] << 16); w.z = 0u; w.w = 0u; vreg = __builtin_bit_cast(bf16x8, w); }
            f32x4 am = (f32x4){0.f, 0.f, 0.f, 0.f};
#pragma unroll
            for (int s = 0; s < 4; ++s) { const bf16x8 fa = *(const LAS bf16x8*)(B + HA_KS + lr * 272 + 64 * s + 16 * g), fb = *(const LAS bf16x8*)(B + HA_QS + lr * 272 + 64 * s + 16 * g); am = MFMA16(fa, fb, am); }
#pragma unroll
            for (int i = 0; i < 4; ++i) am[i] = (4 * g + i <= lr) ? am[i] : 0.f;
            bf16x8 afrag; { v4u w; w.x = pk2(am[0], am[1]); w.y = pk2(am[2], am[3]); w.z = 0u; w.w = 0u; afrag = __builtin_bit_cast(bf16x8, w); }
            f32x4 o = MFMA16(afrag, vreg, ((f32x4){0.f, 0.f, 0.f, 0.f}));
#pragma unroll
            for (int s = 0; s < 4; ++s) {
                const v2u lo = *(const LAS v2u*)(B + HA_QS + lr * 272 + 2 * (32 * s + 4 * g)), hi = *(const LAS v2u*)(B + HA_QS + lr * 272 + 2 * (32 * s + 16 + 4 * g));
                v4u w; w.x = lo.x; w.y = lo.y; w.z = hi.x; w.w = hi.y;
                o = MFMA16(__builtin_bit_cast(bf16x8, w), pack8(S[2 * s], S[2 * s + 1]), o);
            }
            *(f32x4*)(OL + ((((size_t)(h * 16 + sc) * 32 + c) * 8 + wave) * 64 + lane) * 4) = o;
#pragma unroll
            for (int j = 0; j < 8; ++j) {
                const f32x4 dj = *(const LAS f32x4*)(B + HA_DEC + 4 * (16 * j + 4 * g));
                const v2u kf = *(const LAS v2u*)(B + HA_KE + (16 * j + lr) * 32 + 8 * g);
                v4u w; w.x = kf.x; w.y = kf.y; w.z = 0u; w.w = 0u;
                S[j] = MFMA16(__builtin_bit_cast(bf16x8, w), vreg, S[j] * dj);
            }
        }
#undef HA_FETCH
#pragma unroll
        for (int j = 0; j < 8; ++j)
#pragma unroll
            for (int i = 0; i < 4; ++i) DS[((size_t)(h * 16 + sc) * 128 + 16 * j + 4 * g + i) * 128 + 16 * wave + lr] = S[j][i];
        if (g == 0) DSC[(h * 16 + sc) * 128 + 16 * wave + lr] = __expf(gbase);
        LDS_WAIT(); __builtin_amdgcn_s_barrier(); asm volatile("" ::: "memory");
    }
}

constexpr int HC_SINT = 0, HC_STG = 128 * 272  , HC_STG_W = 16 * 528;
DI void hgrn_passC(LAS unsigned char* lds, const bf16* QG, const float* OL, const float* DS, const float* DSC, const bf16* ZG, const float* gnorm, bf16* OG, float* state_out, int bid, int G, int tid) {
    const int wave = __builtin_amdgcn_readfirstlane(tid >> 6), lane = tid & 63, g = lane >> 4, lr = lane & 15;
    for (int u = bid; u < 256; u += G) {
        const int h = u >> 4, sc = u & 15, t0 = sc * 512, cb = h * 128;
        f32x4 S[8];
#pragma unroll
        for (int j = 0; j < 8; ++j) S[j] = (f32x4){0.f, 0.f, 0.f, 0.f};
        const int nprev = (sc == 15) ? 16 : sc;
        for (int p = 0; p < nprev; ++p) {
#pragma unroll
            for (int j = 0; j < 8; ++j) {
                const f32x4 d = *(const f32x4*)(DSC + (h * 16 + p) * 128 + 16 * j + 4 * g);
#pragma unroll
                for (int i = 0; i < 4; ++i) S[j][i] = S[j][i] * d[i] + DS[((size_t)(h * 16 + p) * 128 + 16 * j + 4 * g + i) * 128 + 16 * wave + lr];
            }
            if (p == 14 && sc == 15) {
#pragma unroll
                for (int j = 0; j < 8; ++j) { v2u w; w.x = pk2(S[j][0], S[j][1]); w.y = pk2(S[j][2], S[j][3]); *(LAS v2u*)(lds + HC_SINT + (16 * wave + lr) * 272 + 2 * (16 * j + 4 * g)) = w; }
            }
        }
        if (sc == 15) {
#pragma unroll
            for (int j = 0; j < 8; ++j)
#pragma unroll
                for (int i = 0; i < 4; ++i) state_out[((size_t)h * 128 + 16 * j + 4 * g + i) * 128 + 16 * wave + lr] = S[j][i];
        } else {
#pragma unroll
            for (int j = 0; j < 8; ++j) { v2u w; w.x = pk2(S[j][0], S[j][1]); w.y = pk2(S[j][2], S[j][3]); *(LAS v2u*)(lds + HC_SINT + (16 * wave + lr) * 272 + 2 * (16 * j + 4 * g)) = w; }
        }
        LDS_WAIT(); __builtin_amdgcn_s_barrier(); asm volatile("" ::: "memory");
        LAS float* stg = (LAS float*)(lds + HC_STG + wave * HC_STG_W);
        for (int c = wave; c < 32; c += 8) {
            bf16x8 a[4];
#pragma unroll
            for (int s = 0; s < 4; ++s) a[s] = *(const bf16x8*)(QG + (size_t)(t0 + 16 * c + lr) * D + cb + 32 * s + 8 * g);
            f32x4 o[8]; float ssq[4] = {0.f, 0.f, 0.f, 0.f};
#pragma unroll
            for (int vt = 0; vt < 8; ++vt) {
                f32x4 acc = *(const f32x4*)(OL + ((((size_t)(h * 16 + sc) * 32 + c) * 8 + vt) * 64 + lane) * 4);
#pragma unroll
                for (int s = 0; s < 4; ++s) acc = MFMA16(a[s], *(const LAS bf16x8*)(lds + HC_SINT + (16 * vt + lr) * 272 + 64 * s + 16 * g), acc);
                o[vt] = acc;
#pragma unroll
                for (int i = 0; i < 4; ++i) ssq[i] += acc[i] * acc[i];
            }
            float rs[4];
#pragma unroll
            for (int i = 0; i < 4; ++i) rs[i] = rsqrtf(grp16_sum(ssq[i]) * (1.f / 128.f) + EPS);
#pragma unroll
            for (int vt = 0; vt < 8; ++vt) { const float gn = gnorm[16 * vt + lr];
#pragma unroll
                for (int i = 0; i < 4; ++i) stg[(4 * g + i) * 132 + 16 * vt + lr] = o[vt][i] * rs[i] * gn; }
            LDS_WAIT(); asm volatile("" ::: "memory");
#pragma unroll
            for (int it = 0; it < 4; ++it) {
                const int ci = lane + 64 * it, r = ci >> 4, ch = ci & 15; const size_t go = (size_t)(t0 + 16 * c + r) * D + cb + 8 * ch;
                const f32x4 x0 = *(const LAS f32x4*)(stg + r * 132 + 8 * ch), x1 = *(const LAS f32x4*)(stg + r * 132 + 8 * ch + 4);
                const v4u gt = *(const v4u*)(ZG + go);
                f32x4 y0, y1; y0[0] = x0[0] * bf2f(gt.x & 0xffffu); y0[1] = x0[1] * bf2f(gt.x >> 16); y0[2] = x0[2] * bf2f(gt.y & 0xffffu); y0[3] = x0[3] * bf2f(gt.y >> 16);
                y1[0] = x1[0] * bf2f(gt.z & 0xffffu); y1[1] = x1[1] * bf2f(gt.z >> 16); y1[2] = x1[2] * bf2f(gt.w & 0xffffu); y1[3] = x1[3] * bf2f(gt.w >> 16);
                *(bf16x8*)(OG + go) = pack8(y0, y1);
            }
            LDS_WAIT(); asm volatile("" ::: "memory");
        }
        LDS_WAIT(); __builtin_amdgcn_s_barrier(); asm volatile("" ::: "memory");
    }
}

DI void hgrn_sample(LAS float* wsc, const float* RS1, const float* LB0, const float* st_in, float* st_out, const float* gnorm, bf16* OGS, int b, int h, int lane) {
    { const float* r = RS1 + (size_t)b * NA + h * 128 + 2 * lane;
      const f32x2 qr = *(const f32x2*)r, fr_ = *(const f32x2*)(r + 2048), lb = *(const f32x2*)(LB0 + h * 128 + 2 * lane);
#pragma unroll
      for (int e = 0; e < 2; ++e) { const float f = fminf(fmaxf(fr_[e], -30.f), 30.f), ef = __expf(-f), sg = 1.f / (1.f + ef), sgn = ef / (1.f + ef);
          wsc[2 * lane + e] = lb[e] + (1.f - lb[e]) * sg; wsc[128 + 2 * lane + e] = (1.f - lb[e]) * sgn; wsc[256 + 2 * lane + e] = silu(qr[e]); } }
    LDS_WAIT(); asm volatile("" ::: "memory");
    const int half = lane >> 5, c4 = lane & 31;
    const f32x4 iv = *(const f32x4*)(RS1 + (size_t)b * NA + 4096 + h * 128 + 4 * c4), gr = *(const f32x4*)(RS1 + (size_t)b * NA + 6144 + h * 128 + 4 * c4);
    const float* S0 = st_in + ((size_t)(b * 16 + h) * 128 + half) * 128 + 4 * c4; float* So = st_out + ((size_t)(b * 16 + h) * 128 + half) * 128 + 4 * c4;
    f32x4 o = (f32x4){0.f, 0.f, 0.f, 0.f};
    f32x4 ra[8], rb[8];
#define HS_LOAD(r_, bt) do { _Pragma("unroll") for (int i_ = 0; i_ < 8; ++i_) r_[i_] = __builtin_nontemporal_load((const f32x4*)(S0 + (size_t)(2 * (8 * (bt) + i_)) * 128)); } while (0)
#define HS_STEP(r_, bt) do { _Pragma("unroll") for (int i_ = 0; i_ < 8; ++i_) { const int k_ = 2 * (8 * (bt) + i_) + half; const float fg = wsc[k_], kk = wsc[128 + k_], qk = wsc[256 + k_]; \
        const f32x4 sn = r_[i_] * fg + iv * kk; o += sn * qk; __builtin_nontemporal_store(sn, (f32x4*)(So + (size_t)(2 * (8 * (bt) + i_)) * 128)); } } while (0)
    HS_LOAD(ra, 0);
#pragma unroll 1
    for (int bt = 0; bt < 8; bt += 2) {
        HS_LOAD(rb, bt + 1);
        __builtin_amdgcn_sched_barrier(0);
        HS_STEP(ra, bt);
        __builtin_amdgcn_sched_barrier(0);
        if (bt + 2 < 8) HS_LOAD(ra, bt + 2);
        __builtin_amdgcn_sched_barrier(0);
        HS_STEP(rb, bt + 1);
        __builtin_amdgcn_sched_barrier(0);
    }
#undef HS_LOAD
#undef HS_STEP
#pragma unroll
    for (int e = 0; e < 4; ++e) o[e] += __shfl_xor(o[e], 32);
    float ss = (o[0] * o[0] + o[1] * o[1]) + (o[2] * o[2] + o[3] * o[3]);
#pragma unroll
    for (int x = 1; x < 32; x <<= 1) ss += __shfl_xor(ss, x);
    const float rs = rsqrtf(ss * (1.f / 128.f) + EPS);
    const f32x4 gn = *(const f32x4*)(gnorm + 4 * c4);
    if (half == 0) { v2u w; w.x = pk2(o[0] * rs * gn[0] * silu(gr[0]), o[1] * rs * gn[1] * silu(gr[1])); w.y = pk2(o[2] * rs * gn[2] * silu(gr[2]), o[3] * rs * gn[3] * silu(gr[3]));
        *(v2u*)(OGS + (size_t)b * DS_ + h * 128 + 4 * c4) = w; }
    LDS_WAIT(); asm volatile("" ::: "memory");
}

DI unsigned pk4_fp8(float a, float b, float c, float d) { int p = __builtin_amdgcn_cvt_pk_fp8_f32(a, b, 0, false); p = __builtin_amdgcn_cvt_pk_fp8_f32(c, d, p, true); return (unsigned)p; }
DI void dsa_post_row(const float* KRAW, const float* KIRAW, const float* knorm, const float* kinorm, float* kout, float* kiout, bf16* KB, bf16* KIB, const bf16* VB, unsigned char* K8, unsigned char* V8, int t, int lane) {
    { const float* p = KRAW + (size_t)t * 512 + 8 * lane; f32x4 a = *(const f32x4*)p, b = *(const f32x4*)(p + 4);
      const float rs = rsqrtf(grp16_sum((a.x * a.x + a.y * a.y) + (a.z * a.z + a.w * a.w) + (b.x * b.x + b.y * b.y) + (b.z * b.z + b.w * b.w)) * (1.f / 128.f) + EPS);
      const float* gp = knorm + ((8 * lane) & 127); const f32x4 g0 = *(const f32x4*)gp, g1 = *(const f32x4*)(gp + 4);
      a = a * rs * g0; b = b * rs * g1; float* o = kout + (size_t)t * 512 + 8 * lane; __builtin_nontemporal_store(a, (f32x4*)o); __builtin_nontemporal_store(b, (f32x4*)(o + 4)); *(bf16x8*)(KB + (size_t)t * 512 + 8 * lane) = pack8(a, b);
      *(v2u*)(K8 + (size_t)t * 512 + 8 * lane) = (v2u){pk4_fp8(a[0], a[1], a[2], a[3]), pk4_fp8(b[0], b[1], b[2], b[3])};
      const v4u vw = *(const v4u*)(VB + (size_t)t * 512 + 8 * lane);
      *(v2u*)(V8 + (size_t)t * 512 + 8 * lane) = (v2u){pk4_fp8(bf2f(vw.x & 0xffffu), bf2f(vw.x >> 16), bf2f(vw.y & 0xffffu), bf2f(vw.y >> 16)), pk4_fp8(bf2f(vw.z & 0xffffu), bf2f(vw.z >> 16), bf2f(vw.w & 0xffffu), bf2f(vw.w >> 16))}; }
    { const f32x2 a = *(const f32x2*)(KIRAW + (size_t)t * 128 + 2 * lane); const float rs = rsqrtf(wave_sum(a.x * a.x + a.y * a.y) * (1.f / 128.f) + EPS);
      const f32x2 gk = *(const f32x2*)(kinorm + 2 * lane); const float x = a.x * rs * gk.x, y = a.y * rs * gk.y;
      *(f32x2*)(kiout + (size_t)t * 128 + 2 * lane) = (f32x2){x, y}; *(unsigned*)(KIB + (size_t)t * 128 + 2 * lane) = pk2(x, y); }
}
DI void dsa_sample_prep(const float* R5S, const float* qnorm, const float* knorm, const float* kinorm, bf16* QNS, float* kout, float* vout, float* kiout, int b, int lane) {
    const float* r = R5S + (size_t)b * NB;
#pragma unroll
    for (int it = 0; it < 4; ++it) {
        const int c = it * 512 + 8 * lane; f32x4 a = *(const f32x4*)(r + c), bb = *(const f32x4*)(r + c + 4);
        const float rs = rsqrtf(grp16_sum((a.x * a.x + a.y * a.y) + (a.z * a.z + a.w * a.w) + (bb.x * bb.x + bb.y * bb.y) + (bb.z * bb.z + bb.w * bb.w)) * (1.f / 128.f) + EPS) * 0.08838834764831845f;
        const float* gp = qnorm + (c & 127); a = a * rs * *(const f32x4*)gp; bb = bb * rs * *(const f32x4*)(gp + 4);
        *(bf16x8*)(QNS + (size_t)b * D + c) = pack8(a, bb);
    }
    { const int c = 8 * lane; f32x4 a = *(const f32x4*)(r + 2048 + c), bb = *(const f32x4*)(r + 2048 + c + 4);
      const float rs = rsqrtf(grp16_sum((a.x * a.x + a.y * a.y) + (a.z * a.z + a.w * a.w) + (bb.x * bb.x + bb.y * bb.y) + (bb.z * bb.z + bb.w * bb.w)) * (1.f / 128.f) + EPS);
      const float* gp = knorm + (c & 127); a = a * rs * *(const f32x4*)gp; bb = bb * rs * *(const f32x4*)(gp + 4);
      float* o = kout + (size_t)b * 512 + c; *(f32x4*)o = a; *(f32x4*)(o + 4) = bb;
      float* ov = vout + (size_t)b * 512 + c; *(f32x4*)ov = *(const f32x4*)(r + 2560 + c); *(f32x4*)(ov + 4) = *(const f32x4*)(r + 2560 + c + 4); }
    { const f32x2 a = *(const f32x2*)(r + 5120 + 2 * lane); const float rs = rsqrtf(wave_sum(a.x * a.x + a.y * a.y) * (1.f / 128.f) + EPS);
      const f32x2 gk = *(const f32x2*)(kinorm + 2 * lane); *(f32x2*)(kiout + (size_t)b * 128 + 2 * lane) = (f32x2){a.x * rs * gk.x, a.y * rs * gk.y}; }
}

constexpr int IX_W = 0, IX_ST0 = 4096, IX_STB = 128 * 272;
__device__ const int IXTAB[257] = {0, 15, 30, 46, 62, 78, 94, 110, 126, 142, 158, 174, 190, 206, 222, 238, 254, 270, 286, 302, 318, 334, 350, 366, 382, 399, 415, 431, 447, 463, 480, 496, 512, 529, 546, 562, 578, 595, 611, 627, 644, 660, 676, 693, 709, 726, 742, 758, 775, 791, 808, 824, 841, 858, 874, 891, 907, 924, 940, 957, 973, 990, 1006, 1023, 1039, 1056, 1073, 1089, 1106, 1122, 1139, 1156, 1173, 1190, 1207, 1224, 1240, 1257, 1273, 1290, 1306, 1323, 1339, 1356, 1372, 1389, 1406, 1423, 1440, 1456, 1473, 1489, 1506, 1522, 1539, 1556, 1572, 1589, 1605, 1622, 1639, 1655, 1672, 1688, 1705, 1722, 1739, 1756, 1772, 1789, 1806, 1823, 1840, 1856, 1873, 1890, 1906, 1923, 1939, 1956, 1973, 1989, 2006, 2023, 2039, 2056, 2072, 2089, 2106, 2122, 2139, 2156, 2172, 2189, 2206, 2222, 2239, 2256, 2273, 2290, 2306, 2323, 2340, 2356, 2373, 2390, 2406, 2423, 2440, 2456, 2473, 2490, 2506, 2523, 2540, 2556, 2573, 2590, 2606, 2623, 2640, 2656, 2673, 2690, 2706, 2723, 2740, 2756, 2773, 2790, 2807, 2823, 2840, 2857, 2873, 2890, 2907, 2923, 2940, 2957, 2973, 2990, 3007, 3024, 3040, 3057, 3074, 3090, 3107, 3124, 3140, 3157, 3174, 3191, 3207, 3224, 3241, 3257, 3274, 3291, 3307, 3324, 3341, 3358, 3374, 3391, 3408, 3424, 3441, 3458, 3475, 3491, 3508, 3525, 3541, 3558, 3575, 3592, 3608, 3625, 3642, 3659, 3675, 3692, 3709, 3725, 3742, 3759, 3776, 3792, 3809, 3826, 3843, 3859, 3876, 3893, 3909, 3926, 3943, 3960, 3976, 3993, 4010, 4027, 4043, 4060, 4077, 4094, 4110, 4127, 4144, 4160, 4160, 4160, 4160, 4160, 4160};
DI void indexer_prompt(LAS unsigned char* lds, const bf16* QIB, const bf16* KIB, const float* WI, float* SC, int bid, int G, int tid_) {
    const int wave = __builtin_amdgcn_readfirstlane(tid_ >> 6);
    constexpr int NITEMS = 4160, IX_W2 = IX_ST0 + 2 * IX_STB;
    const int per = NITEMS / G, extra = NITEMS % G;
    int lo = bid * per + (bid < extra ? bid : extra), hi = lo + per + (bid < extra ? 1 : 0);
    if (G == 256) { lo = IXTAB[bid]; hi = IXTAB[bid + 1]; }
    int p = 0; while ((p + 1) * (p + 2) <= lo) ++p;
    int qb = 2 * p, s = lo - p * (p + 1); if (s > p) { qb += 1; s -= p + 1; }
    int wsel = 0; bool newq = true;
    if (lo < hi) {
        int tid = tid_; asm volatile("" : "+v"(tid));
        *(LAS f32x2*)(lds + IX_W + 8 * tid) = *(const f32x2*)(WI + (size_t)(64 * qb) * 16 + 2 * tid);
        v4u st[4];
#pragma unroll
        for (int it = 0; it < 4; ++it) { const int ci = tid + 512 * it, row = ci >> 4, ch = ci & 15; st[it] = *(const v4u*)(KIB + (size_t)(128 * s + row) * 128 + 8 * ch); }
#pragma unroll
        for (int it = 0; it < 4; ++it) { const int ci = tid + 512 * it, row = ci >> 4, ch = ci & 15; *(LAS v4u*)(lds + IX_ST0 + row * 272 + 16 * ch) = st[it]; }
    }
    __syncthreads();
    bf16x8 af[4][8];
    for (int item = lo; item < hi; ++item) {
        int tid = tid_; asm volatile("" : "+v"(tid));
        const int lane = tid & 63, hh = lane >> 5, m = lane & 31;
        const int q0 = 64 * qb, k0s = 128 * s;
        if (newq) {
#pragma unroll
            for (int a = 0; a < 4; ++a) { const int qq = q0 + 8 * wave + 2 * a + ((m >> 2) & 1), hd = 4 * (m >> 3) + (m & 3);
#pragma unroll
                for (int s_ = 0; s_ < 8; ++s_) af[a][s_] = *(const bf16x8*)(QIB + (size_t)qq * D + hd * 128 + 16 * s_ + 8 * hh); }
        }
        int nqb = qb, ns = s + 1; if (ns > (qb >> 1)) { nqb = qb + 1; ns = 0; }
        const bool more = item + 1 < hi;
        v4u st[2];
        LAS unsigned char* NBUF = lds + IX_ST0 + (((item - lo) & 1) ^ 1) * IX_STB;
#define IX_PF_LOAD(h_) do { if (more) { _Pragma("unroll") for (int it = 0; it < 2; ++it) { const int ci = tid + 512 * (2 * (h_) + it), row = ci >> 4, ch = ci & 15; st[it] = *(const v4u*)(KIB + (size_t)(128 * ns + row) * 128 + 8 * ch); } } } while (0)
#define IX_PF_STORE(h_) do { if (more) { _Pragma("unroll") for (int it = 0; it < 2; ++it) { const int ci = tid + 512 * (2 * (h_) + it), row = ci >> 4, ch = ci & 15; *(LAS v4u*)(NBUF + row * 272 + 16 * ch) = st[it]; } } } while (0)
        IX_PF_LOAD(0);
        f32x2 wn = (f32x2){0.f, 0.f};
        if (more && nqb != qb) wn = *(const f32x2*)(WI + (size_t)(64 * nqb) * 16 + 2 * tid);
        const int qlast_w = q0 + 8 * wave + 7;
        const int par = (item - lo) & 1;
        LAS unsigned char* SB = lds + IX_ST0 + par * IX_STB;
        LAS unsigned char* WBUF = lds + (wsel ? IX_W2 : IX_W);
#pragma unroll
        for (int bt = 0; bt < 4; ++bt) {
            const int key0 = k0s + 32 * bt;
            if (bt == 2) { IX_PF_STORE(0); IX_PF_LOAD(1); }
            if (key0 <= qlast_w) {
            bf16x8 bfr[8];
#pragma unroll
            for (int s_ = 0; s_ < 8; ++s_) bfr[s_] = *(const LAS bf16x8*)(SB + (32 * bt + m) * 272 + 32 * s_ + 16 * hh);
            f32x16 accA;
#define IX_CHAIN(acc_, a_) do { _Pragma("unroll") for (int i_ = 0; i_ < 16; ++i_) acc_[i_] = 0.f; __builtin_amdgcn_s_setprio(1); _Pragma("unroll") for (int s_ = 0; s_ < 8; ++s_) acc_ = MFMA32(af[a_][s_], bfr[s_], acc_); __builtin_amdgcn_s_setprio(0); } while (0)
#define IX_EPI(acc_, a_) do { const LAS f32x4* wp = (const LAS f32x4*)(WBUF + 64 * (8 * wave + 2 * (a_) + hh)); float s2[2] = {0.f, 0.f}; \
                const float big = __builtin_bit_cast(float, __builtin_amdgcn_readfirstlane(0x7f7fffff)); \
                _Pragma("unroll") for (int i4 = 0; i4 < 4; ++i4) { const f32x4 w4 = wp[i4]; _Pragma("unroll") for (int e = 0; e < 4; ++e) s2[e & 1] += w4[e] * __builtin_amdgcn_fmed3f(acc_[4 * i4 + e], 0.f, big); } \
                SC[(size_t)(q0 + 8 * wave + 2 * (a_) + hh) * T + key0 + m] = s2[0] + s2[1]; } while (0)
            IX_CHAIN(accA, 0); IX_EPI(accA, 0);
            IX_CHAIN(accA, 1); IX_EPI(accA, 1);
            IX_CHAIN(accA, 2); IX_EPI(accA, 2);
            IX_CHAIN(accA, 3); IX_EPI(accA, 3);
#undef IX_CHAIN
#undef IX_EPI
            }
        }
        IX_PF_STORE(1);
#undef IX_PF_LOAD
#undef IX_PF_STORE
        if (more) {
            if (nqb != qb) *(LAS f32x2*)(lds + (wsel ? IX_W : IX_W2) + 8 * tid) = wn;
        }
        __syncthreads();
        newq = nqb != qb; if (newq) wsel ^= 1;
        qb = nqb; s = ns;
    }
}

DI unsigned mono_key(float v) { const unsigned u = __float_as_uint(v); return (u & 0x80000000u) ? ~u : (u | 0x80000000u); }
DI int wave_sum_i(int v) {
#pragma unroll
    for (int o = 1; o < 64; o <<= 1) v += __shfl_xor(v, o);
    return v;
}
template <int NPL>
DI void topk_row(const float* sc, int n, int* idx_out, int lane_) {
    int lane = lane_; asm volatile("" : "+v"(lane));
    unsigned key[NPL];
    { const float* p = sc + lane;
#pragma unroll
    for (int j = 0; j < NPL; ++j) key[j] = __float_as_uint(p[64 * j]);
#pragma unroll
    for (int j = 0; j + 8 <= NPL; j += 8) asm volatile("" : "+v"(key[j]), "+v"(key[j + 1]), "+v"(key[j + 2]), "+v"(key[j + 3]), "+v"(key[j + 4]), "+v"(key[j + 5]), "+v"(key[j + 6]), "+v"(key[j + 7]));
#pragma unroll
    for (int j = NPL & ~7; j < NPL; ++j) asm volatile("" : "+v"(key[j]));
    const int ns = __builtin_amdgcn_readfirstlane(n);
#pragma unroll
    for (int j = 0; j < NPL; ++j) key[j] = (lane < ns - 64 * j) ? mono_key(__uint_as_float(key[j])) : 0u; }
    unsigned Tk = 0u;
#pragma unroll 1
    for (int bit = 31; bit >= 0; --bit) {
        const unsigned cand = __builtin_amdgcn_readfirstlane(Tk | (1u << bit)); int cnt = 0;
#pragma unroll
        for (int j = 0; j < NPL; ++j) asm volatile("v_cmp_le_u32 vcc, %2, %1\n\tv_addc_co_u32 %0, vcc, 0, %0, vcc" : "+v"(cnt) : "v"(key[j]), "s"(cand) : "vcc");
        cnt = wave_sum_i(cnt);
        if (cnt >= TOPK) Tk = cand;
    }
    int cgt = 0;
    { const unsigned tks = __builtin_amdgcn_readfirstlane(Tk);
#pragma unroll
    for (int j = 0; j < NPL; ++j) asm volatile("v_cmp_lt_u32 vcc, %2, %1\n\tv_addc_co_u32 %0, vcc, 0, %0, vcc" : "+v"(cgt) : "v"(key[j]), "s"(tks) : "vcc"); }
    cgt = wave_sum_i(cgt);
    const int need_eq = TOPK - cgt; int base = 0, eqb = 0;
    int lane2 = lane_; asm volatile("" : "+v"(lane2));
    const unsigned long long below = (1ull << lane2) - 1ull;
#pragma unroll
    for (int j = 0; j < NPL; ++j) {
        const bool ge = key[j] >= Tk;
        if (__ballot(ge) != 0ull) {
            const bool gt = key[j] > Tk, eq = key[j] == Tk;
            const unsigned long long mg = __ballot(gt), me = __ballot(eq);
            if (gt) idx_out[base + __builtin_popcountll(mg & below)] = lane2 + 64 * j;
            const int re = eqb + __builtin_popcountll(me & below);
            if (eq && re < need_eq) idx_out[cgt + re] = lane2 + 64 * j;
            base += __builtin_popcountll(mg); eqb += __builtin_popcountll(me);
        }
        __builtin_amdgcn_sched_barrier(0);
    }
}
constexpr int TK_CAP = 1024, TK_CPL = TK_CAP / 64;
template <int NPL>
DI void topk_row2(const float* sc, int n, int* idx_out, LAS unsigned* cbuf  , int lane_) {
    int lane = lane_; asm volatile("" : "+v"(lane));
    unsigned key[NPL];
    { const float* p = sc + lane;
#pragma unroll
    for (int j = 0; j < NPL; ++j) key[j] = __float_as_uint(p[64 * j]);
#pragma unroll
    for (int j = 0; j + 8 <= NPL; j += 8) asm volatile("" : "+v"(key[j]), "+v"(key[j + 1]), "+v"(key[j + 2]), "+v"(key[j + 3]), "+v"(key[j + 4]), "+v"(key[j + 5]), "+v"(key[j + 6]), "+v"(key[j + 7]));
#pragma unroll
    for (int j = NPL & ~7; j < NPL; ++j) asm volatile("" : "+v"(key[j]));
    const int ns = __builtin_amdgcn_readfirstlane(n);
#pragma unroll
    for (int j = 0; j < NPL; ++j) key[j] = (lane < ns - 64 * j) ? mono_key(__uint_as_float(key[j])) : 0u; }
    unsigned a0 = 0u, a1 = 0u, a2 = 0u, a3 = 0u;
#pragma unroll
    for (int j = 0; j < NPL; ++j) { unsigned x = key[j]; const unsigned n0 = a0 > x ? a0 : x; x = a0 < x ? a0 : x; a0 = n0; const unsigned n1 = a1 > x ? a1 : x; x = a1 < x ? a1 : x; a1 = n1;
        const unsigned n2 = a2 > x ? a2 : x; x = a2 < x ? a2 : x; a2 = n2; a3 = a3 > x ? a3 : x; }
    unsigned t0 = a3;
#pragma unroll
    for (int o = 1; o < 64; o <<= 1) { const unsigned y = (unsigned)__shfl_xor((int)t0, o); t0 = y < t0 ? y : t0; }
    const unsigned T0 = __builtin_amdgcn_readfirstlane(t0);
    int base = 0;
    int lane2 = lane_; asm volatile("" : "+v"(lane2));
    const unsigned long long below = (1ull << lane2) - 1ull;
#pragma unroll
    for (int j = 0; j < NPL; ++j) {
        const bool c = key[j] >= T0; const unsigned long long mk = __ballot(c);
        if (mk != 0ull) { const int pos = base + __builtin_popcountll(mk & below); if (c && pos < TK_CAP) { cbuf[pos] = key[j]; cbuf[TK_CAP + pos] = (unsigned)(lane2 + 64 * j); } base += __builtin_popcountll(mk); }
        __builtin_amdgcn_sched_barrier(0);
    }
    const int ncand = __builtin_amdgcn_readfirstlane(base);
    if (ncand > TK_CAP) { topk_row<NPL>(sc, n, idx_out, lane_); return; }
    LDS_WAIT(); asm volatile("" ::: "memory");
    unsigned ck[TK_CPL], ci[TK_CPL];
#pragma unroll
    for (int c = 0; c < TK_CPL; ++c) { const int q = lane2 + 64 * c; const bool v = q < ncand; ck[c] = v ? cbuf[q] : 0u; ci[c] = v ? cbuf[TK_CAP + q] : 0u; }
    unsigned Tk = 0u;
#pragma unroll 1
    for (int bit = 31; bit >= 0; --bit) {
        const unsigned cand = __builtin_amdgcn_readfirstlane(Tk | (1u << bit)); int cnt = 0;
#pragma unroll
        for (int c = 0; c < TK_CPL; ++c) asm volatile("v_cmp_le_u32 vcc, %2, %1\n\tv_addc_co_u32 %0, vcc, 0, %0, vcc" : "+v"(cnt) : "v"(ck[c]), "s"(cand) : "vcc");
        cnt = wave_sum_i(cnt);
        if (cnt >= TOPK) Tk = cand;
    }
    int cgt = 0;
    { const unsigned tks = __builtin_amdgcn_readfirstlane(Tk);
#pragma unroll
    for (int c = 0; c < TK_CPL; ++c) asm volatile("v_cmp_lt_u32 vcc, %2, %1\n\tv_addc_co_u32 %0, vcc, 0, %0, vcc" : "+v"(cgt) : "v"(ck[c]), "s"(tks) : "vcc"); }
    cgt = wave_sum_i(cgt);
    const int need_eq = TOPK - cgt; int ob = 0, eqb = 0;
#pragma unroll
    for (int c = 0; c < TK_CPL; ++c) {
        const bool gt = ck[c] > Tk, eq = ck[c] == Tk && ck[c] != 0u;
        const unsigned long long mg = __ballot(gt), me = __ballot(eq);
        if (gt) idx_out[ob + __builtin_popcountll(mg & below)] = (int)ci[c];
        const int re = eqb + __builtin_popcountll(me & below);
        if (eq && re < need_eq) idx_out[cgt + re] = (int)ci[c];
        ob += __builtin_popcountll(mg); eqb += __builtin_popcountll(me);
        __builtin_amdgcn_sched_barrier(0);
    }
    LDS_WAIT(); asm volatile("" ::: "memory");
}
DI void topk_dispatch(const float* sc, int n, int* idx_out, LAS unsigned* cbuf, int lane) {
    if (n <= TOPK) { for (int i = lane; i < TOPK; i += 64) idx_out[i] = i < n ? i : 0; return; }
    if (n <= 2112) topk_row2<33>(sc, n, idx_out, cbuf, lane);
    else if (n <= 4096) topk_row2<64>(sc, n, idx_out, cbuf, lane);
    else if (n <= 6144) topk_row2<96>(sc, n, idx_out, cbuf, lane);
    else topk_row2<128>(sc, n, idx_out, cbuf, lane);
}

template <bool F32SRC, class SRC>
DI void attn_unit(LAS unsigned char* vbuf  , const LAS float* lut, const bf16x8 (&qf)[4], const int* idx, int cnt_, int qpos_, int kvh, const SRC& src, bf16* orow, int lane_) {
    constexpr int NL = F32SRC ? 8 : 4, DEPTH = F32SRC ? 2 : 4;
    int lane = lane_; asm volatile("" : "+v"(lane));
    const int cnt = __builtin_amdgcn_readfirstlane(cnt_), qpos = __builtin_amdgcn_readfirstlane(qpos_);
    const int g = lane >> 4, lr = lane & 15;
    const unsigned vb_addr = (unsigned)(size_t)vbuf;
    const unsigned q_ = (unsigned)lr >> 2, p_ = (unsigned)lr & 3u;
    const unsigned wbase = 512u * ((unsigned)lr >> 2) + 64u * (unsigned)g;
    const unsigned rbase = vb_addr + 2048u * (unsigned)g + 64u * q_ + 8u * (p_ & 1u);
    v4u ring[DEPTH][NL];
    int R[16], RP[16];
#pragma unroll
    for (int kt = 0; kt < 16; ++kt) R[kt] = idx[16 * kt + lr];
#pragma unroll
    for (int kt = 0; kt < 16; ++kt) RP[kt] = src.rowid(R[kt]);
#define AT_ISSUE_K(slot, kt) do { const char* kr_ = src.kptr(RP[kt], kvh); _Pragma("unroll") for (int s_ = 0; s_ < 4; ++s_) { \
        if (F32SRC) { ring[slot][2 * s_] = __builtin_nontemporal_load((const v4u*)(kr_ + 4 * (32 * s_ + 8 * g))); ring[slot][2 * s_ + 1] = __builtin_nontemporal_load((const v4u*)(kr_ + 4 * (32 * s_ + 8 * g) + 16)); } \
        else ring[slot][s_] = *(const v4u*)(kr_ + 2 * (32 * s_ + 8 * g)); } } while (0)
#define AT_ISSUE_V(slot, hc) do { _Pragma("unroll") for (int q2_ = 0; q2_ < 4; ++q2_) { const int rid_ = __shfl(RP[hc], 4 * q2_ + g); const char* vr_ = src.vptr(rid_, kvh); \
        if (F32SRC) { ring[slot][2 * q2_] = __builtin_nontemporal_load((const v4u*)(vr_ + 32 * lr)); ring[slot][2 * q2_ + 1] = __builtin_nontemporal_load((const v4u*)(vr_ + 32 * lr + 16)); } \
        else ring[slot][q2_] = *(const v4u*)(vr_ + 16 * lr); } } while (0)
#pragma unroll
    for (int i = 0; i < DEPTH; ++i) AT_ISSUE_K(i, i);
    f32x4 lg[16]; f32x4 o[8]; bf16x8 pf[8]; float inv = 0.f;
#pragma unroll
    for (int i = 0; i < 16; ++i) {
        asm volatile("" ::: "memory");
        const int slot = i % DEPTH;
        {
            f32x4 acc = (f32x4){0.f, 0.f, 0.f, 0.f};
#pragma unroll
            for (int s = 0; s < 4; ++s) { bf16x8 kf; if (F32SRC) kf = pack8(__builtin_bit_cast(f32x4, ring[slot][2 * s]), __builtin_bit_cast(f32x4, ring[slot][2 * s + 1])); else kf = __builtin_bit_cast(bf16x8, ring[slot][s]);
                acc = MFMA16(kf, qf[s], acc); }
#pragma unroll
            for (int e = 0; e < 4; ++e) { const int kp = __shfl(R[i], 4 * g + e), rel = qpos - kp; const bool ok = (4 * g + e < cnt - 16 * i) && rel >= 0; const int rc = rel < 0 ? 0 : (rel > 128 ? 128 : rel);
                acc[e] = ok ? acc[e] + lut[rc * 16 + 4 * kvh + (lr & 3)] : -3.0e38f; }
            lg[i] = acc;
        }
        { const int ni = i + DEPTH;
          if (ni < 16) AT_ISSUE_K(slot, ni);
          else AT_ISSUE_V(slot, ni - 16); }
    }
    {
        {
            float mx = -3.0e38f;
#pragma unroll
            for (int kt = 0; kt < 16; ++kt) mx = fmaxf(fmaxf(fmaxf(lg[kt][0], lg[kt][1]), fmaxf(lg[kt][2], lg[kt][3])), mx);
            mx = fmaxf(mx, __shfl_xor(mx, 16)); mx = fmaxf(mx, __shfl_xor(mx, 32));
            float sum = 0.f;
#pragma unroll
            for (int kt = 0; kt < 16; ++kt)
#pragma unroll
                for (int e = 0; e < 4; ++e) { const float p = lg[kt][e] > -1.0e38f ? __expf(lg[kt][e] - mx) : 0.f; lg[kt][e] = p; sum += p; }
            sum += __shfl_xor(sum, 16); sum += __shfl_xor(sum, 32);
            inv = 1.f / sum;
#pragma unroll
            for (int ks = 0; ks < 8; ++ks) pf[ks] = pack8(lg[2 * ks], lg[2 * ks + 1]);
        }
    }
#pragma unroll
    for (int dt = 0; dt < 8; ++dt) o[dt] = (f32x4){0.f, 0.f, 0.f, 0.f};
#pragma unroll
    for (int i = 16; i < 32; ++i) {
        asm volatile("" ::: "memory");
        const int slot = i % DEPTH;
        {
            const int hc = i - 16, ks = hc >> 1, par = hc & 1;
            unsigned wb = wbase; asm volatile("" : "+v"(wb));
#pragma unroll
            for (int q2 = 0; q2 < 4; ++q2) { const unsigned off = wb + (unsigned)((ks & 1) * 8192 + 2048 * q2 + 256 * par) + 16u * (((unsigned)lr & 3u) ^ (unsigned)((par + 2 * q2) & 3));
                if (F32SRC) *(LAS bf16x8*)(vbuf + off) = pack8(__builtin_bit_cast(f32x4, ring[slot][2 * q2]), __builtin_bit_cast(f32x4, ring[slot][2 * q2 + 1]));
                else *(LAS v4u*)(vbuf + off) = ring[slot][q2]; }
            if (par == 1) {
                LDS_WAIT(); asm volatile("" ::: "memory");
#pragma unroll
                for (int dt = 0; dt < 8; dt += 2) {
                    s16x4 r0, r1, r2, r3;
                    unsigned rb = rbase; asm volatile("" : "+v"(rb));
                    const unsigned kso = (unsigned)((ks & 1) * 8192 + 512 * (dt >> 1));
                    const unsigned x0 = (unsigned)(2 * g) & 3u, x1 = (unsigned)(2 * g + 1) & 3u, c0 = 2u * (unsigned)(dt & 1) + (p_ >> 1), c2 = 2u * (unsigned)((dt + 1) & 1) + (p_ >> 1);
                    const unsigned a0 = rb + kso + 16u * (c0 ^ x0), a1 = rb + kso + 256u + 16u * (c0 ^ x1);
                    const unsigned a2 = rb + (unsigned)((ks & 1) * 8192 + 512 * ((dt + 1) >> 1)) + 16u * (c2 ^ x0), a3 = rb + (unsigned)((ks & 1) * 8192 + 512 * ((dt + 1) >> 1)) + 256u + 16u * (c2 ^ x1);
                    asm volatile("ds_read_b64_tr_b16 %0, %4\n\tds_read_b64_tr_b16 %1, %5\n\tds_read_b64_tr_b16 %2, %6\n\tds_read_b64_tr_b16 %3, %7\n\ts_waitcnt lgkmcnt(0)"
                                 : "=&v"(r0), "=&v"(r1), "=&v"(r2), "=&v"(r3) : "v"(a0), "v"(a1), "v"(a2), "v"(a3) : "memory");
                    bf16x8 va, vb2;
                    va[0] = r0[0]; va[1] = r0[1]; va[2] = r0[2]; va[3] = r0[3]; va[4] = r1[0]; va[5] = r1[1]; va[6] = r1[2]; va[7] = r1[3];
                    vb2[0] = r2[0]; vb2[1] = r2[1]; vb2[2] = r2[2]; vb2[3] = r2[3]; vb2[4] = r3[0]; vb2[5] = r3[1]; vb2[6] = r3[2]; vb2[7] = r3[3];
                    o[dt] = MFMA16(va, pf[ks], o[dt]); o[dt + 1] = MFMA16(vb2, pf[ks], o[dt + 1]);
                }
            }
        }
        { const int ni = i + DEPTH;
          if (ni < 32) AT_ISSUE_V(slot, ni - 16); }
    }
    if (lr < 4) {
#pragma unroll
        for (int dt = 0; dt < 8; ++dt) { v2u w; w.x = pk2(o[dt][0] * inv, o[dt][1] * inv); w.y = pk2(o[dt][2] * inv, o[dt][3] * inv); *(v2u*)(orow + (4 * kvh + lr) * 128 + 16 * dt + 4 * g) = w; } }
#undef AT_ISSUE_K
#undef AT_ISSUE_V
}

#define A8_TR4(ADDR0, ADDR1, OFF) asm volatile("ds_read_b64_tr_b16 %0, %4 offset:" #OFF "\n\tds_read_b64_tr_b16 %1, %5 offset:" #OFF "\n\tds_read_b64_tr_b16 %2, %6 offset:" #OFF "\n\tds_read_b64_tr_b16 %3, %7 offset:" #OFF "\n\ts_waitcnt lgkmcnt(0)" \
        : "=&v"(r0), "=&v"(r1), "=&v"(r2), "=&v"(r3) : "v"(ADDR0), "v"(ADDR1), "v"(ADDR0##b), "v"(ADDR1##b) : "memory")
DI void attn_unit_f8(LAS unsigned char* vbuf  , const LAS float* lut2  , const long (&qf)[4], const int* idx, int cnt_, int qpos_, int kvh, const unsigned char* K8, const bf16* VB, bf16* orow, int lane_) {
    int lane = lane_; asm volatile("" : "+v"(lane));
    const int cnt = __builtin_amdgcn_readfirstlane(cnt_), qpos = __builtin_amdgcn_readfirstlane(qpos_);
    const int g = lane >> 4, lr = lane & 15;
    const unsigned vb_addr = (unsigned)(size_t)vbuf;
    const unsigned q_ = (unsigned)lr >> 2, p_ = (unsigned)lr & 3u;
    const unsigned rb0 = vb_addr + 2048u * (unsigned)g + 64u * q_ + 8u * (p_ & 1u);
    const unsigned x0 = (unsigned)(2 * g) & 3u, x1 = (unsigned)(2 * g + 1) & 3u;
    const unsigned te = rb0 + 16u * ((p_ >> 1) ^ x0), teb = rb0 + 256u + 16u * ((p_ >> 1) ^ x1), to = rb0 + 16u * ((2u + (p_ >> 1)) ^ x0), tob = rb0 + 256u + 16u * ((2u + (p_ >> 1)) ^ x1);
    const unsigned wb = 512u * ((unsigned)lr >> 2) + 64u * (unsigned)g;
    const unsigned wx0 = wb + 16u * (((unsigned)lr & 3u) ^ 0u), wx1 = wb + 16u * (((unsigned)lr & 3u) ^ 1u), wx2 = wb + 16u * (((unsigned)lr & 3u) ^ 2u), wx3 = wb + 16u * (((unsigned)lr & 3u) ^ 3u);
    v4u ring[16];
    int R[16];
#pragma unroll
    for (int kt = 0; kt < 16; ++kt) R[kt] = idx[16 * kt + lr];
#define A8_ISSUE_K(kt) do { const char* kr_ = (const char*)K8 + (unsigned)(R[kt] * 512 + kvh * 128 + 32 * g); ring[(2 * (kt)) & 15] = *(const v4u*)kr_; ring[(2 * (kt) + 1) & 15] = *(const v4u*)(kr_ + 16); } while (0)
#define A8_ISSUE_V(hc) do { _Pragma("unroll") for (int q2_ = 0; q2_ < 4; ++q2_) { const int rid_ = __shfl(R[hc], 4 * q2_ + g); \
        ring[(4 * (hc) + q2_) & 15] = *(const v4u*)((const char*)VB + (unsigned)(rid_ * 1024 + kvh * 256 + 16 * lr)); } } while (0)
#pragma unroll
    for (int i = 0; i < 8; ++i) A8_ISSUE_K(i);
    f32x4 lg[16]; f32x4 o[8]; bf16x8 pf[8]; float inv = 0.f;
    const int hcol = 4 * kvh + (lr & 3);
#pragma unroll
    for (int i = 0; i < 16; ++i) {
        asm volatile("" ::: "memory");
        {
            int kp4[4];
#pragma unroll
            for (int e = 0; e < 4; ++e) kp4[e] = __shfl(R[i], 4 * g + e);
            f32x4 acc = (f32x4){0.f, 0.f, 0.f, 0.f};
#pragma unroll
            for (int s = 0; s < 4; ++s) { const v4u w = ring[(2 * i + (s >> 1)) & 15]; const unsigned long long ka = (s & 1) ? ((unsigned long long)w.w << 32 | w.z) : ((unsigned long long)w.y << 32 | w.x);
                acc = __builtin_amdgcn_mfma_f32_16x16x32_fp8_fp8((long)ka, qf[s], acc, 0, 0, 0); }
            float bs[4]; bool okv[4];
#pragma unroll
            for (int e = 0; e < 4; ++e) { const int rel = qpos - kp4[e]; okv[e] = (4 * g + e < cnt - 16 * i) && rel >= 0; const int rc = rel > 128 ? 128 : (rel < 0 ? 0 : rel); bs[e] = lut2[rc * 16 + hcol]; }
            asm volatile("" : "+v"(bs[0]), "+v"(bs[1]), "+v"(bs[2]), "+v"(bs[3]));
#pragma unroll
            for (int e = 0; e < 4; ++e) acc[e] = okv[e] ? acc[e] * (0.08838834764831845f * 1.4426950408889634f) + bs[e] : -3.0e38f;
            lg[i] = acc;
        }
        if (i + 8 < 16) A8_ISSUE_K(i + 8);
        else if ((i & 1) == 1) A8_ISSUE_V((i - 9) / 2);
    }
    {
        float mx = -3.0e38f;
#pragma unroll
        for (int kt = 0; kt < 16; ++kt) mx = fmaxf(fmaxf(fmaxf(lg[kt][0], lg[kt][1]), fmaxf(lg[kt][2], lg[kt][3])), mx);
        mx = fmaxf(mx, __shfl_xor(mx, 16)); mx = fmaxf(mx, __shfl_xor(mx, 32));
        float sum = 0.f;
#pragma unroll
        for (int kt = 0; kt < 16; ++kt)
#pragma unroll
            for (int e = 0; e < 4; ++e) { const float p = __builtin_amdgcn_exp2f(lg[kt][e] - mx); lg[kt][e] = p; sum += p; }
        sum += __shfl_xor(sum, 16); sum += __shfl_xor(sum, 32);
        inv = 1.f / sum;
#pragma unroll
        for (int ks = 0; ks < 8; ++ks) pf[ks] = pack8(lg[2 * ks], lg[2 * ks + 1]);
    }
#pragma unroll
    for (int dt = 0; dt < 8; ++dt) o[dt] = (f32x4){0.f, 0.f, 0.f, 0.f};
#pragma unroll
    for (int hc = 0; hc < 16; ++hc) {
        asm volatile("" ::: "memory");
        const int ks = hc >> 1, par = hc & 1;
        {
            unsigned w0 = wx0, w1 = wx1, w2 = wx2, w3 = wx3; asm volatile("" : "+v"(w0), "+v"(w1), "+v"(w2), "+v"(w3));
#pragma unroll
            for (int q2 = 0; q2 < 4; ++q2) { const int xr = (par + 2 * q2) & 3; const unsigned bs = xr == 0 ? w0 : (xr == 1 ? w1 : (xr == 2 ? w2 : w3));
                *(LAS v4u*)(vbuf + bs + (unsigned)((ks & 1) * 8192 + 2048 * q2 + 256 * par)) = ring[(4 * hc + q2) & 15]; }
        }
        if (par == 1) {
            LDS_WAIT(); asm volatile("" ::: "memory");
            s16x4 r0, r1, r2, r3; bf16x8 va, vb2;
#define A8_PV(dt) do { va[0] = r0[0]; va[1] = r0[1]; va[2] = r0[2]; va[3] = r0[3]; va[4] = r1[0]; va[5] = r1[1]; va[6] = r1[2]; va[7] = r1[3]; \
                vb2[0] = r2[0]; vb2[1] = r2[1]; vb2[2] = r2[2]; vb2[3] = r2[3]; vb2[4] = r3[0]; vb2[5] = r3[1]; vb2[6] = r3[2]; vb2[7] = r3[3]; \
                o[dt] = MFMA16(va, pf[ks], o[dt]); o[(dt) + 1] = MFMA16(vb2, pf[ks], o[(dt) + 1]); } while (0)
            unsigned tE = te, tEb = teb, tO = to, tOb = tob; asm volatile("" : "+v"(tE), "+v"(tEb), "+v"(tO), "+v"(tOb));
#define A8_TRP(OFF) asm volatile("ds_read_b64_tr_b16 %0, %4 offset:" #OFF "\n\tds_read_b64_tr_b16 %1, %5 offset:" #OFF "\n\tds_read_b64_tr_b16 %2, %6 offset:" #OFF "\n\tds_read_b64_tr_b16 %3, %7 offset:" #OFF "\n\ts_waitcnt lgkmcnt(0)" \
                : "=&v"(r0), "=&v"(r1), "=&v"(r2), "=&v"(r3) : "v"(tE), "v"(tEb), "v"(tO), "v"(tOb) : "memory")
            if ((ks & 1) == 0) { A8_TRP(0); A8_PV(0); A8_TRP(512); A8_PV(2); A8_TRP(1024); A8_PV(4); A8_TRP(1536); A8_PV(6); }
            else { A8_TRP(8192); A8_PV(0); A8_TRP(8704); A8_PV(2); A8_TRP(9216); A8_PV(4); A8_TRP(9728); A8_PV(6); }
#undef A8_TRP
#undef A8_PV
        }
        if (hc + 4 < 16) A8_ISSUE_V(hc + 4);
    }
    if (lr < 4) {
#pragma unroll
        for (int dt = 0; dt < 8; ++dt) { v2u w; w.x = pk2(o[dt][0] * inv, o[dt][1] * inv); w.y = pk2(o[dt][2] * inv, o[dt][3] * inv); *(v2u*)(orow + (4 * kvh + lr) * 128 + 16 * dt + 4 * g) = w; } }
#undef A8_ISSUE_K
#undef A8_ISSUE_V
}
#undef A8_TR4

DI void indexer_sample(const float* R5S, const float* cache_kidx, const int* page_table, const float* kinorm, float* SCS, int u, int tid) {
    const int wave = __builtin_amdgcn_readfirstlane(tid >> 6), lane = tid & 63, g = lane >> 4, lr = lane & 15, b = u >> 1, half = u & 1;
    const float wsc = 0.25f * 0.08838834764831845f;
    const float* qi = R5S + (size_t)b * NB + 3072 + lr * 128;
    bf16x8 qf[4];
#pragma unroll
    for (int s = 0; s < 4; ++s) qf[s] = pack8(*(const f32x4*)(qi + 32 * s + 8 * g), *(const f32x4*)(qi + 32 * s + 8 * g + 4));
    const float w = R5S[(size_t)b * NB + 5248 + lr] * wsc;
    const int phys = page_table[b * NPAGES + ((half * 1024 + wave * 128) >> 7)];
    const float* rbase = cache_kidx + ((size_t)phys * PAGE + ((wave * 128) & 127) + lr) * 128 + 8 * g;
    f32x4 rg[3][8];
#define IS_LOAD(kt_) do { const float* row_ = rbase + (size_t)(16 * (kt_)) * 128; _Pragma("unroll") for (int s_ = 0; s_ < 4; ++s_) { \
        rg[(kt_) % 3][2 * s_] = __builtin_nontemporal_load((const f32x4*)(row_ + 32 * s_)); rg[(kt_) % 3][2 * s_ + 1] = __builtin_nontemporal_load((const f32x4*)(row_ + 32 * s_ + 4)); } } while (0)
    IS_LOAD(0); IS_LOAD(1);
#pragma unroll
    for (int kt = 0; kt < 8; ++kt) {
        if (kt + 2 < 8) IS_LOAD(kt + 2);
        __builtin_amdgcn_sched_barrier(0);
        const int key0 = half * 1024 + wave * 128 + 16 * kt;
        f32x4 acc = (f32x4){0.f, 0.f, 0.f, 0.f};
#pragma unroll
        for (int s = 0; s < 4; ++s) acc = MFMA16(pack8(rg[kt % 3][2 * s], rg[kt % 3][2 * s + 1]), qf[s], acc);
        f32x4 v;
#pragma unroll
        for (int i = 0; i < 4; ++i) v[i] = grp16_sum(w * fmaxf(acc[i], 0.f));
        if (lr == 0) *(f32x4*)(SCS + (size_t)b * SCS_LD + key0 + 4 * g) = v;
        __builtin_amdgcn_sched_barrier(0);
    }
#undef IS_LOAD
    if (half == 1 && wave == 7) {
        const float* kr = R5S + (size_t)b * NB + 5120; const f32x2 a = *(const f32x2*)(kr + 2 * lane);
        const float rs = rsqrtf(wave_sum(a.x * a.x + a.y * a.y) * (1.f / 128.f) + EPS);
        const int hd = lane >> 2, part = lane & 3; const float* qh = R5S + (size_t)b * NB + 3072 + hd * 128 + 32 * part;
        float dot = 0.f;
#pragma unroll 8
        for (int d = 0; d < 32; ++d) dot += qh[d] * (kr[32 * part + d] * rs * kinorm[32 * part + d]);
        dot += __shfl_xor(dot, 1); dot += __shfl_xor(dot, 2);
        float sc = (R5S[(size_t)b * NB + 5248 + hd] * wsc) * fmaxf(dot, 0.f);
        sc += __shfl_xor(sc, 4); sc += __shfl_xor(sc, 8); sc += __shfl_xor(sc, 16); sc += __shfl_xor(sc, 32);
        if (lane == 0) SCS[(size_t)b * SCS_LD + 2048] = sc;
    }
}

struct SrcPrompt { const bf16* KB; const bf16* VB;
    DI int rowid(int pos) const { return pos; }
    DI const char* kptr(int rid, int kvh) const { return (const char*)KB + (unsigned)(rid * 1024 + kvh * 256); }
    DI const char* vptr(int rid, int kvh) const { return (const char*)VB + (unsigned)(rid * 1024 + kvh * 256); } };
struct SrcSample { const float* ck; const float* cv; const float* knew; const float* vnew; const int* pt;
    DI int rowid(int pos) const { return pos < PAST ? pt[pos >> 7] * PAGE + (pos & 127) : -1; }
    DI const char* kptr(int rid, int kvh) const { return rid >= 0 ? (const char*)ck + (unsigned)(rid * 2048 + kvh * 512) : (const char*)knew + kvh * 512; }
    DI const char* vptr(int rid, int kvh) const { return rid >= 0 ? (const char*)cv + (unsigned)(rid * 2048 + kvh * 512) : (const char*)vnew + kvh * 512; } };
struct UnitsPrompt { const int* IDX; const bf16* QRAW; const float* qnorm; bf16* OATT; int t0, stride, kvh, lane;
    DI int n() const { return t0 < T ? (T - t0 + stride - 1) / stride : 0; }
    DI const int* idx(int u) const { return IDX + (size_t)(t0 + u * stride) * TOPK; }
    DI int cnt(int u) const { const int t = t0 + u * stride; return t + 1 < TOPK ? t + 1 : TOPK; }
    DI int qpos(int u) const { return t0 + u * stride; }
    DI bf16* orow(int u) const { return OATT + (size_t)(t0 + u * stride) * D; }
    DI void qfrag(int u, bf16x8 (&qf)[4]) const {
        const int g = lane >> 4, lr = lane & 15; const bf16* qr = QRAW + (size_t)(t0 + u * stride) * D + (4 * kvh + (lr & 3)) * 128;
        float qv[4][8]; float ss = 0.f;
#pragma unroll
        for (int s = 0; s < 4; ++s) { const v4u w = *(const v4u*)(qr + 32 * s + 8 * g);
            qv[s][0] = bf2f(w.x & 0xffffu); qv[s][1] = bf2f(w.x >> 16); qv[s][2] = bf2f(w.y & 0xffffu); qv[s][3] = bf2f(w.y >> 16);
            qv[s][4] = bf2f(w.z & 0xffffu); qv[s][5] = bf2f(w.z >> 16); qv[s][6] = bf2f(w.w & 0xffffu); qv[s][7] = bf2f(w.w >> 16);
#pragma unroll
            for (int e = 0; e < 8; ++e) ss += qv[s][e] * qv[s][e]; }
        ss += __shfl_xor(ss, 16); ss += __shfl_xor(ss, 32);
        const float rs = (lr < 4) ? rsqrtf(ss * (1.f / 128.f) + EPS) * 0.08838834764831845f : 0.f;
#pragma unroll
        for (int s = 0; s < 4; ++s) { const f32x4 g0 = *(const f32x4*)(qnorm + 32 * s + 8 * g), g1 = *(const f32x4*)(qnorm + 32 * s + 8 * g + 4);
            f32x4 a, b; a[0] = qv[s][0] * rs * g0[0]; a[1] = qv[s][1] * rs * g0[1]; a[2] = qv[s][2] * rs * g0[2]; a[3] = qv[s][3] * rs * g0[3];
            b[0] = qv[s][4] * rs * g1[0]; b[1] = qv[s][5] * rs * g1[1]; b[2] = qv[s][6] * rs * g1[2]; b[3] = qv[s][7] * rs * g1[3]; qf[s] = pack8(a, b); }
    } };
struct UnitsSample { const int* idxs; const bf16* qns; bf16* orow_; int valid, kvh, lane;
    DI int n() const { return valid; }
    DI const int* idx(int) const { return idxs; }
    DI int cnt(int) const { return TOPK; }
    DI int qpos(int) const { return PAST; }
    DI bf16* orow(int) const { return orow_; }
    DI void qfrag(int, bf16x8 (&qf)[4]) const { const int g = lane >> 4, lr = lane & 15;
#pragma unroll
        for (int s = 0; s < 4; ++s) { qf[s] = *(const bf16x8*)(qns + (4 * kvh + (lr & 3)) * 128 + 32 * s + 8 * g); if (lr >= 4) qf[s] = (bf16x8){0, 0, 0, 0, 0, 0, 0, 0}; } } };

DI void build_lut(LAS float* lut, const float* rel_bias, int tid) {
    for (int i = tid; i < 129 * 16; i += NTHR) { const int r = i >> 4, hd = i & 15; int bk = r;
        if (r >= 16) { bk = 16 + (int)(__logf((float)r / 16.f) / 2.0794415f * 16.f); bk = bk > 31 ? 31 : bk; }
        lut[i] = rel_bias[bk * 16 + hd]; }
}
#define XB_TMO      128
#define XB_XCNT(j)  (256  + 64 * (j))
#define XB_XSUB(j)  (1280 + 64 * (j))
#define XB_XGEN(j)  (2304 + 64 * (j))
#define XB_TOP      3328
#define XB_TOPGEN   3392
#define XCD_BAR_WORDS 3456
#define XB_SPIN_CAP (1u << 18)

__device__ __forceinline__ unsigned xb_ld(unsigned* p)              { return __hip_atomic_load(p, __ATOMIC_RELAXED, __HIP_MEMORY_SCOPE_AGENT); }
__device__ __forceinline__ unsigned xb_add(unsigned* p, unsigned v) { return __hip_atomic_fetch_add(p, v, __ATOMIC_RELAXED, __HIP_MEMORY_SCOPE_AGENT); }
__device__ __forceinline__ unsigned xb_xcc_id() { return (unsigned)__builtin_amdgcn_s_getreg((3 << 11) | 20) & 0xFu; }
#define XB_SPIN(cond, bar) do { unsigned _sp = 0; while (cond) { __builtin_amdgcn_s_sleep(1); \
    if ((++_sp & 255u) == 0u) { if (xb_ld(&(bar)[XB_TMO])) break; if (_sp > XB_SPIN_CAP) { atomicAdd(&(bar)[XB_TMO], 1u); break; } } } } while (0)

struct XcdBarrier {
    unsigned* bar; unsigned x;
    volatile LAS unsigned* st;
};

__device__ __forceinline__ XcdBarrier xcd_barrier_post(unsigned* bar, volatile LAS unsigned* st, const bool t0  ) {
    XcdBarrier b; b.bar = bar; b.x = xb_xcc_id(); b.st = st;
    if (t0) (void)xb_add(&bar[XB_XCNT(b.x)], 1u);
    return b;
}
__device__ __forceinline__ void xcd_barrier_complete(unsigned* bar, unsigned x, unsigned& nloc, unsigned& nx) {
    const unsigned G = gridDim.x * gridDim.y * gridDim.z;
    unsigned sum, cnt, mine, sp = 0u;
    for (;;) {
        sum = 0u; cnt = 0u; mine = 0u;
#pragma unroll
        for (unsigned j = 0; j < 16; ++j) { const unsigned c = xb_ld(&bar[XB_XCNT(j)]); sum += c; cnt += (c > 0u) ? 1u : 0u; mine = (j == x) ? c : mine; }
        if (sum == G) break;
        __builtin_amdgcn_s_sleep(1);
        if ((++sp & 255u) == 0u) { if (xb_ld(&bar[XB_TMO])) break; if (sp > XB_SPIN_CAP) { atomicAdd(&bar[XB_TMO], 1u); break; } }
    }
    nloc = mine > 0u ? mine : 1u; nx = cnt > 0u ? cnt : 1u;
}

__device__ __forceinline__ void xcd_barrier(const XcdBarrier& b, const bool t0  ) {
    asm volatile("s_waitcnt vmcnt(0)" ::: "memory");
    __syncthreads();
    if (t0) {
        unsigned* bar = b.bar;
        __builtin_amdgcn_s_waitcnt(0);
        unsigned nloc = b.st[0], nx = b.st[1];
        if (nloc == 0u) { xcd_barrier_complete(bar, b.x, nloc, nx); b.st[0] = nloc; b.st[1] = nx; }
        const unsigned old = xb_add(&bar[XB_XSUB(b.x)], 1u);
        const unsigned gen = old / nloc;
        if (old + 1u == (gen + 1u) * nloc) {
            __builtin_amdgcn_fence(__ATOMIC_RELEASE, "agent");
            asm volatile("s_waitcnt vmcnt(0)" ::: "memory");
            const unsigned og = xb_add(&bar[XB_TOP], 1u);
            const unsigned tg = og / nx;
            if (og + 1u == (tg + 1u) * nx) xb_add(&bar[XB_TOPGEN], 1u);
            else XB_SPIN(xb_ld(&bar[XB_TOPGEN]) == tg, bar);
            __builtin_amdgcn_fence(__ATOMIC_ACQUIRE, "agent");
            xb_add(&bar[XB_XGEN(b.x)], 1u);
            asm volatile("s_waitcnt vmcnt(0)" ::: "memory");
        } else {
            XB_SPIN(xb_ld(&bar[XB_XGEN(b.x)]) == gen, bar);
            __builtin_amdgcn_fence(__ATOMIC_ACQUIRE, "agent");
            asm volatile("s_waitcnt vmcnt(0)" ::: "memory");
        }
    }
    __syncthreads();
}

typedef const __attribute__((address_space(4))) Args ArgsK;
DI ArgsK* launder_args() { ArgsK* p = (ArgsK*)__builtin_amdgcn_kernarg_segment_ptr(); asm volatile("" : "+s"(p)); return p; }
__global__ void __launch_bounds__(NTHR, 2) mk_fwd(Args args) {
    extern __shared__ __attribute__((aligned(16))) unsigned char lds_raw[];
    LAS unsigned char* lds = (LAS unsigned char*)lds_raw;
    const int tid0 = threadIdx.x, wave = __builtin_amdgcn_readfirstlane(tid0 >> 6), G = gridDim.x, bid = blockIdx.x;
    const int gw = bid * NWAVES + wave, NGW = G * NWAVES;
    unsigned* ctl = (unsigned*)(args.ws + WS_CTL);
    for (int u = tid0; u < (LDS_BYTES - MISC_OFF) / 4; u += NTHR) ((LAS unsigned*)(lds + MISC_OFF))[u] = 0u;
    __syncthreads();
#if MK_ONE_LAUNCH
    XcdBarrier bar = xcd_barrier_post(ctl + CW_BAR, (volatile LAS unsigned*)(lds + MISC_OFF + 32), tid0 == 0);
#define GRID_BAR() do { int l_; asm volatile("v_mbcnt_lo_u32_b32 %0, -1, 0\n\tv_mbcnt_hi_u32_b32 %0, -1, %0" : "=v"(l_)); xcd_barrier(bar, wave == 0 && l_ == 0); } while (0)
#else
#define GRID_BAR() do {} while (0)
#endif

#define LATE_N (32 * 32 + 32 * 176 + 88 * 32)
#define LATE_TR(L_) do { int r_ = (L_); TrItem t_{}; \
        if (r_ < 32 * 32) t_ = TrItem{b_w_out, WB_OUT, D, D, 0, r_}; \
        else if (r_ < 32 * 32 + 32 * 176) t_ = TrItem{w_gu + (size_t)D * 2 * FF, WGU1, D, 2 * FF, 1, r_ - 32 * 32}; \
        else t_ = TrItem{w_down + (size_t)FF * D, WD1, FF, D, 0, r_ - 32 * 32 - 32 * 176}; \
        f32x4 rr_[16]; tr_load(t_, lane, rr_); tr_store(t_, lane, rr_, (LAS float*)(lds + wave * WSLAB)); } while (0)
    const int lo = args.ph_lo, hi = args.ph_hi;
#ifndef PH_MASK
#define PH_MASK 0x3ffff
#endif
#define IN(k) (((PH_MASK >> (k)) & 1) && lo <= (k) && (k) < hi)
#define BOTH(k) (IN(k) && IN((k) + 1))
#define x_p ((const float*)AP->in[0])
#define x_s ((const float*)AP->in[1])
#define state_in ((const float*)AP->in[2])
#define cache_k ((const float*)AP->in[3])
#define cache_v ((const float*)AP->in[4])
#define cache_ki ((const float*)AP->in[5])
#define page_table ((const int*)AP->in[6])
#define norm_mix ((const float*)AP->in[7])
#define norm_ffn ((const float*)AP->in[8])
#define lb_logits ((const float*)AP->in[9])
#define a_w_in ((const float*)AP->in[10])
#define a_w_out ((const float*)AP->in[11])
#define a_gnorm ((const float*)AP->in[12])
#define b_w_in ((const float*)AP->in[13])
#define b_w_out ((const float*)AP->in[14])
#define b_q_norm ((const float*)AP->in[15])
#define b_k_norm ((const float*)AP->in[16])
#define b_ki_norm ((const float*)AP->in[17])
#define rel_bias ((const float*)AP->in[18])
#define w_gu ((const float*)AP->in[19])
#define w_down ((const float*)AP->in[20])
#define LB0 ((float*)(AP->ws + WS_LB0))
#define LUTG ((float*)(AP->ws + WS_LUT))
#define WA_IN ((bf16*)(AP->ws + WS_WA_IN))
#define WA_OUT ((bf16*)(AP->ws + WS_WA_OUT))
#define WGU0 ((bf16*)(AP->ws + WS_WGU0))
#define WD0 ((bf16*)(AP->ws + WS_WD0))
#define WB_IN ((bf16*)(AP->ws + WS_WB_IN))
#define WB_OUT ((bf16*)(AP->ws + WS_WB_OUT))
#define WGU1 ((bf16*)(AP->ws + WS_WGU1))
#define WD1 ((bf16*)(AP->ws + WS_WD1))
#define HP ((bf16*)(AP->ws + WS_HP))
#define ZQ ((bf16*)(AP->ws + WS_ZQ))
#define ZK ((bf16*)(AP->ws + WS_ZK))
#define ZV ((bf16*)(AP->ws + WS_ZV))
#define ZG ((bf16*)(AP->ws + WS_ZG))
#define LF ((float*)(AP->ws + WS_LF))
#define QG ((bf16*)(AP->ws + WS_QG))
#define OL ((float*)(AP->ws + WS_OL))
#define DS ((float*)(AP->ws + WS_DS))
#define DSC ((float*)(AP->ws + WS_DSC))
#define OG ((bf16*)(AP->ws + WS_OG))
#define Y1 ((bf16*)(AP->ws + WS_Y1))
#define HID ((bf16*)(AP->ws + WS_HID))
#define Y2 ((bf16*)(AP->ws + WS_Y2))
#define Y3 ((bf16*)(AP->ws + WS_Y3))
#define QRAW ((bf16*)(AP->ws + WS_QRAW))
#define QIB ((bf16*)(AP->ws + WS_QIB))
#define KRAW ((float*)(AP->ws + WS_KRAW))
#define KIRAW ((float*)(AP->ws + WS_KIRAW))
#define WI ((float*)(AP->ws + WS_WI))
#define KB ((bf16*)(AP->ws + WS_KB))
#define VB ((bf16*)(AP->ws + WS_VB))
#define KIB ((bf16*)(AP->ws + WS_KIB))
#define SC ((float*)(AP->ws + WS_SC))
#define IDX ((int*)(AP->ws + WS_IDX))
#define OATT ((bf16*)(AP->ws + WS_OATT))
#define HS ((bf16*)(AP->ws + WS_HS))
#define RS1 ((float*)(AP->ws + WS_RS1))
#define OGS ((bf16*)(AP->ws + WS_OGS))
#define Y1S ((float*)(AP->ws + WS_Y1S))
#define HIDS ((bf16*)(AP->ws + WS_HIDS))
#define Y2S ((float*)(AP->ws + WS_Y2S))
#define R5S ((float*)(AP->ws + WS_R5S))
#define QNS ((bf16*)(AP->ws + WS_QNS))
#define SCS ((float*)(AP->ws + WS_SCS))
#define IDXS ((int*)(AP->ws + WS_IDXS))
#define OATTS ((bf16*)(AP->ws + WS_OATTS))
#define Y3S ((float*)(AP->ws + WS_Y3S))
#define out (AP->out)
#define SSQ ((float*)(AP->ws + WS_SSQ))
#define SSQS (SSQ + 3 * T)
    if (IN(0)) {
        const ArgsK* AP = launder_args();
        int lane; asm volatile("v_mbcnt_lo_u32_b32 %0, -1, 0\n\tv_mbcnt_hi_u32_b32 %0, -1, %0" : "=v"(lane)); const int tid = wave * 64 + lane;
        LAS float* scr = (LAS float*)(lds + wave * 16640);
        constexpr int I0 = 32 * 128, I1 = 32 * 32, I2 = 32 * 176, I3 = 88 * 32, I4 = 32 * 83, NIT = I0 + I1 + I2 + I3 + I4;
#define TR_PICK(it_, t_) do { int r_ = (it_); \
            if (r_ < I0) { t_ = TrItem{a_w_in, WA_IN, D, NA, 0, r_}; break; } r_ -= I0; \
            if (r_ < I1) { t_ = TrItem{a_w_out, WA_OUT, D, D, 0, r_}; break; } r_ -= I1; \
            if (r_ < I2) { t_ = TrItem{w_gu, WGU0, D, 2 * FF, 1, r_}; break; } r_ -= I2; \
            if (r_ < I3) { t_ = TrItem{w_down, WD0, FF, D, 0, r_}; break; } r_ -= I3; \
            t_ = TrItem{b_w_in, WB_IN, D, NBR, 0, r_}; } while (0)
        {
            f32x4 ra[16], rb[16]; TrItem ta{}, tb{};
            int it = gw;
            if (it < NIT) { TR_PICK(it, ta); tr_load(ta, lane, ra); }
            while (it < NIT) {
                const int it2 = it + NGW, it3 = it2 + NGW;
                if (it2 < NIT) { TR_PICK(it2, tb); tr_load(tb, lane, rb); }
                tr_store(ta, lane, ra, scr);
                if (it2 >= NIT) break;
                if (it3 < NIT) { TR_PICK(it3, ta); tr_load(ta, lane, ra); }
                tr_store(tb, lane, rb, scr);
                it = it3;
            }
        }
#undef TR_PICK
        for (int m = gw; m < T + BS; m += NGW) { if (m < T) rmsnorm_row(x_p + (size_t)m * D, norm_mix, HP + (size_t)m * D, lane); else rmsnorm_row(x_s + (size_t)(m - T) * D, norm_mix, HS + (size_t)(m - T) * DS_, lane); }
        const int gt = bid * NTHR + tid, NGT = G * NTHR;
        for (int i = gt; i < 2048; i += NGT) { const float a = lb_logits[i], b = lb_logits[2048 + i], c = lb_logits[4096 + i], mx = fmaxf(a, fmaxf(b, c)); const float ea = __expf(a - mx), eb = __expf(b - mx), ec = __expf(c - mx); LB0[i] = ea / (ea + eb + ec); }
        for (int i = gt; i < (NB - 5312) * D / 8; i += NGT) ((v4u*)(WB_IN + (size_t)5312 * D))[i] = (v4u){0u, 0u, 0u, 0u};
        for (int i = gt; i < 3 * T + 3 * BS; i += NGT) SSQ[i] = 0.f;
        if (BOTH(0)) GRID_BAR();
    }
    if (IN(1)) {
        const ArgsK* AP = launder_args();
        int lane; asm volatile("v_mbcnt_lo_u32_b32 %0, -1, 0\n\tv_mbcnt_hi_u32_b32 %0, -1, %0" : "=v"(lane)); const int tid = wave * 64 + lane;
        pg8::Gemm g{HP, WA_IN, T, NA, D}; pg8::StaticOrder S; S.init(T, NA, G, bid);
        EpiA E{ZQ, LF, LB0};
        pg8::gemm_phase<EpiA, pg8::StaticOrder, true, true>(lds, g, S, E, wave);
        skinny_gemm<0, 2, 4, D>(lds, HS, DS_, WA_IN, NA / 64, RS1, nullptr, NA, nullptr, bid, G, tid);
        if (BOTH(1)) GRID_BAR();
    }
    if (IN(2)) {
        const ArgsK* AP = launder_args();
        int lane; asm volatile("v_mbcnt_lo_u32_b32 %0, -1, 0\n\tv_mbcnt_hi_u32_b32 %0, -1, %0" : "=v"(lane)); const int tid = wave * 64 + lane;
        hgrn_passA(lds, ZQ, ZK, ZV, LF, QG, OL, DS, DSC, bid, G, tid);
        for (int su = gw; su < BS * 16; su += NGW) hgrn_sample((LAS float*)(lds + wave * 2048), RS1, LB0, state_in, out + O_SS, a_gnorm, OGS, su >> 4, su & 15, lane);
        if (BOTH(2)) GRID_BAR();
    }
    if (IN(3)) {
        const ArgsK* AP = launder_args();
        int lane; asm volatile("v_mbcnt_lo_u32_b32 %0, -1, 0\n\tv_mbcnt_hi_u32_b32 %0, -1, %0" : "=v"(lane)); const int tid = wave * 64 + lane;
        hgrn_passC(lds, QG, OL, DS, DSC, ZG, a_gnorm, OG, out + O_SP, bid, G, tid);
        skinny_gemm<0, 1, 2, D>(lds, OGS, DS_, WA_OUT, D / 32, Y1S, x_s, D, nullptr, bid, G, tid, 0, SkNorm{nullptr, norm_ffn, HS, SSQS});
        if (BOTH(3)) GRID_BAR();
    }
    if (IN(4)) {
        const ArgsK* AP = launder_args();
        int lane; asm volatile("v_mbcnt_lo_u32_b32 %0, -1, 0\n\tv_mbcnt_hi_u32_b32 %0, -1, %0" : "=v"(lane)); const int tid = wave * 64 + lane;
        pg8::Gemm g{OG, WA_OUT, T, D, D}; pg8::StaticOrder S; S.init(T, D, G, bid);
        EpiRes<false, true> E{x_p, Y1, norm_ffn, HP, SSQ};
        pg8::gemm_phase<EpiRes<false, true>, pg8::StaticOrder, true, true>(lds, g, S, E, wave);
        skinny_gemm<1, 2, 4, D>(lds, HS, DS_, WGU0, FF / 32, nullptr, nullptr, 0, HIDS, bid, G, tid, 0, SkNorm{SSQS, nullptr, nullptr, nullptr});
        if (BOTH(4)) GRID_BAR();
    }
    if (IN(5)) {
        const ArgsK* AP = launder_args();
        int lane; asm volatile("v_mbcnt_lo_u32_b32 %0, -1, 0\n\tv_mbcnt_hi_u32_b32 %0, -1, %0" : "=v"(lane)); const int tid = wave * 64 + lane;
        pg8::Gemm g{HP, WGU0, T, 2 * FF, D}; pg8::StaticOrder S; S.init(T, 2 * FF, G, bid);
        EpiSwiglu E{HID, SSQ};
        pg8::gemm_phase<EpiSwiglu, pg8::StaticOrder, true, true>(lds, g, S, E, wave);
        skinny_gemm<0, 1, 2, FF>(lds, HIDS, FFS_, WD0, D / 32, Y2S, Y1S, D, nullptr, bid, G, tid, (T / 256 * (2 * FF / 256)) % G, SkNorm{nullptr, norm_mix + D, HS, SSQS + BS});
        if (BOTH(5)) GRID_BAR();
    }
    if (IN(6)) {
        const ArgsK* AP = launder_args();
        int lane; asm volatile("v_mbcnt_lo_u32_b32 %0, -1, 0\n\tv_mbcnt_hi_u32_b32 %0, -1, %0" : "=v"(lane)); const int tid = wave * 64 + lane;
        pg8::Gemm g{HID, WD0, T, D, FF}; pg8::StaticOrder S; S.init(T, D, G, bid);
        EpiRes<true, true> E{Y1, Y2, norm_mix + D, HP, SSQ + T};
        pg8::gemm_phase<EpiRes<true, true>, pg8::StaticOrder, true, true>(lds, g, S, E, wave);
        skinny_gemm<0, 2, 4, D>(lds, HS, DS_, WB_IN, NB / 64, R5S, nullptr, NB, nullptr, bid, G, tid, 0, SkNorm{SSQS + BS, nullptr, nullptr, nullptr});
        if (BOTH(6)) GRID_BAR();
    }
    if (IN(7)) {
        const ArgsK* AP = launder_args();
        int lane; asm volatile("v_mbcnt_lo_u32_b32 %0, -1, 0\n\tv_mbcnt_hi_u32_b32 %0, -1, %0" : "=v"(lane)); const int tid = wave * 64 + lane;
        pg8::Gemm g{HP, WB_IN, T, NB, D}; pg8::StaticOrder S; S.init(T, NB, G, bid);
        EpiB E{QRAW, QIB, VB, KRAW, out + O_VP, KIRAW, WI, SSQ + T};
        pg8::gemm_phase<EpiB, pg8::StaticOrder, true, true>(lds, g, S, E, wave);
        for (int b = NGW - 1 - gw; b < BS; b += NGW) dsa_sample_prep(R5S, b_q_norm, b_k_norm, b_ki_norm, QNS, out + O_KS, out + O_VS, out + O_KIS, b, lane);
        { const int c0 = (T / 256 * (NB / 256)) % G;
          for (int u = bid - c0; u >= 0 && u < 2 * BS; u += G - c0) indexer_sample(R5S, cache_ki, page_table, b_ki_norm, SCS, u, tid); }
        if (BOTH(7)) GRID_BAR();
    }
    if (IN(8)) {
        const ArgsK* AP = launder_args();
        int lane; asm volatile("v_mbcnt_lo_u32_b32 %0, -1, 0\n\tv_mbcnt_hi_u32_b32 %0, -1, %0" : "=v"(lane)); const int tid = wave * 64 + lane;
        if (gw < NGW - BS) for (int t = gw; t < T; t += NGW - BS) dsa_post_row(KRAW, KIRAW, b_k_norm, b_ki_norm, out + O_KP, out + O_KIP, KB, KIB, VB, (unsigned char*)(AP->ws + WS_K8), (unsigned char*)(AP->ws + WS_V8), t, lane);
        for (int b = NGW - 1 - gw; b < BS; b += NGW) topk_dispatch(SCS + (size_t)b * SCS_LD, PAST + 1, IDXS + b * TOPK, (LAS unsigned*)(lds + wave * 8192), lane);
        if (gw == 0) { for (int i = lane; i < 129 * 16; i += 64) { const int r = i >> 4, hd = i & 15; int bk = r; if (r >= 16) { bk = 16 + (int)(__logf((float)r / 16.f) / 2.0794415f * 16.f); bk = bk > 31 ? 31 : bk; } LUTG[i] = rel_bias[bk * 16 + hd]; } }
        if (BOTH(8)) GRID_BAR();
    }
    if (IN(9)) {
        const ArgsK* AP = launder_args();
        int lane; asm volatile("v_mbcnt_lo_u32_b32 %0, -1, 0\n\tv_mbcnt_hi_u32_b32 %0, -1, %0" : "=v"(lane)); const int tid = wave * 64 + lane;
        indexer_prompt(lds, QIB, KIB, WI, SC, bid, G, tid);
        if (BOTH(9)) GRID_BAR();
    }
    if (IN(10)) {
        const ArgsK* AP = launder_args();
        int lane; asm volatile("v_mbcnt_lo_u32_b32 %0, -1, 0\n\tv_mbcnt_hi_u32_b32 %0, -1, %0" : "=v"(lane)); const int tid = wave * 64 + lane;
        { int lt = tid; asm volatile("" : "+v"(lt)); for (int i = lt; i < 129 * 16; i += NTHR) ((LAS float*)(lds + LUT_OFF))[i] = LUTG[i]; }
        if (tid == 0) ((volatile LAS int*)(lds + MISC_OFF))[12] = 0;
        __syncthreads();
        for (;;) {
            int it = 0;
            if (lane == 0) it = __hip_atomic_fetch_add((LAS int*)(lds + MISC_OFF) + 12, 1, __ATOMIC_RELAXED, __HIP_MEMORY_SCOPE_WORKGROUP);
            it = __builtin_amdgcn_readfirstlane(it);
            if (it >= 34 + 12) break;
            if (it >= 34) { const int L = bid + G * (it - 34); if (L < LATE_N) LATE_TR(L); continue; }
            if (it < 2) {
                const int su = 2 * bid + it;
                if (su < BS * 4) {
                    const int b = su >> 2, kvh = su & 3, g = lane >> 4, lr = lane & 15;
                    bf16x8 qf[4];
#pragma unroll
                    for (int s = 0; s < 4; ++s) { qf[s] = *(const bf16x8*)(QNS + (size_t)b * D + (4 * kvh + (lr & 3)) * 128 + 32 * s + 8 * g); if (lr >= 4) qf[s] = (bf16x8){0, 0, 0, 0, 0, 0, 0, 0}; }
                    SrcSample src{cache_k, cache_v, out + O_KS + (size_t)b * 512, out + O_VS + (size_t)b * 512, page_table + b * NPAGES};
                    attn_unit<true, SrcSample>(lds + wave * WSLAB, (const LAS float*)(lds + LUT_OFF), qf, IDXS + b * TOPK, TOPK, PAST, kvh, src, OATTS + (size_t)b * DS_, lane);
                }
            } else {
                const int r = it - 2, kq = 3 - (r >> 3), j0 = bid * NWAVES + (r & 7), t = NGW * kq + ((kq & 1) ? NGW - 1 - j0 : j0);
                if (t >= 0 && t < T) topk_dispatch(SC + (size_t)t * T, t + 1, IDX + (size_t)t * TOPK, (LAS unsigned*)(lds + wave * WSLAB), lane);
            }
        }
        if (BOTH(10)) GRID_BAR();
    }
    if (IN(11)) {
        const ArgsK* AP = launder_args();
        int lane; asm volatile("v_mbcnt_lo_u32_b32 %0, -1, 0\n\tv_mbcnt_hi_u32_b32 %0, -1, %0" : "=v"(lane)); const int tid = wave * 64 + lane;
        { int lt = tid; asm volatile("" : "+v"(lt)); for (int i = lt; i < 129 * 16; i += NTHR) ((LAS float*)(lds + LUT_OFF))[i] = LUTG[i] * 1.4426950408889634f; }
        __syncthreads();
        {
            const int kvh = bid & 3, g = lane >> 4, lr = lane & 15, nslots = (G >> 2) * NWAVES;
            const unsigned char* K8 = (const unsigned char*)(AP->ws + WS_K8);
            if (tid == 0) ((volatile LAS int*)(lds + MISC_OFF))[12] = 0;
            __syncthreads();
            constexpr int NATT = 128, NLATE = 26;
            for (;;) {
            int it = 0;
            if (lane == 0) it = __hip_atomic_fetch_add((LAS int*)(lds + MISC_OFF) + 12, 1, __ATOMIC_RELAXED, __HIP_MEMORY_SCOPE_WORKGROUP);
            it = __builtin_amdgcn_readfirstlane(it);
            if (it >= NATT + NLATE) break;
            const int grp = it / 6, pos = it % 6;
            const bool is_tr = (pos == 5 && grp < NLATE) ;
            if (is_tr) { const int L = bid + G * (12 + grp); if (L < LATE_N) LATE_TR(L); continue; }
            const int u = it - (grp < NLATE ? grp : NLATE);
            if (u >= NATT) continue;
            {
                const int t = (bid >> 2) * NWAVES + (u & 7) + nslots * (u >> 3);
                if (t >= T) continue;

                const bf16* qr = QRAW + (size_t)t * D + (4 * kvh + (lr & 3)) * 128;
                float qv[4][8]; float ss = 0.f;
#pragma unroll
                for (int s = 0; s < 4; ++s) { const v4u w = *(const v4u*)(qr + 32 * g + 8 * s);
                    qv[s][0] = bf2f(w.x & 0xffffu); qv[s][1] = bf2f(w.x >> 16); qv[s][2] = bf2f(w.y & 0xffffu); qv[s][3] = bf2f(w.y >> 16);
                    qv[s][4] = bf2f(w.z & 0xffffu); qv[s][5] = bf2f(w.z >> 16); qv[s][6] = bf2f(w.w & 0xffffu); qv[s][7] = bf2f(w.w >> 16);
#pragma unroll
                    for (int e = 0; e < 8; ++e) ss += qv[s][e] * qv[s][e]; }
                ss += __shfl_xor(ss, 16); ss += __shfl_xor(ss, 32);
                const float rs = (lr < 4) ? rsqrtf(ss * (1.f / 128.f) + EPS) : 0.f;
                long qf[4];
#pragma unroll
                for (int s = 0; s < 4; ++s) { const f32x4 g0 = *(const f32x4*)(b_q_norm + 32 * g + 8 * s), g1 = *(const f32x4*)(b_q_norm + 32 * g + 8 * s + 4);
                    const unsigned lo = pk4_fp8(qv[s][0] * rs * g0[0], qv[s][1] * rs * g0[1], qv[s][2] * rs * g0[2], qv[s][3] * rs * g0[3]);
                    const unsigned hi = pk4_fp8(qv[s][4] * rs * g1[0], qv[s][5] * rs * g1[1], qv[s][6] * rs * g1[2], qv[s][7] * rs * g1[3]);
                    qf[s] = (long)(((unsigned long long)hi << 32) | lo); }
                const int cnt = t + 1 < TOPK ? t + 1 : TOPK;
                attn_unit_f8(lds + wave * WSLAB, (const LAS float*)(lds + LUT_OFF), qf, IDX + (size_t)t * TOPK, cnt, t, kvh, K8, VB, OATT + (size_t)t * D, lane);
            }
            }
        }
        __syncthreads();
        skinny_gemm<0, 1, 2, D>(lds, OATTS, DS_, WB_OUT, D / 32, Y3S, Y2S, D, nullptr, bid, G, tid, 0, SkNorm{nullptr, norm_ffn + D, HS, SSQS + 2 * BS});
        if (BOTH(11)) GRID_BAR();
    }
    if (IN(12)) {
        const ArgsK* AP = launder_args();
        int lane; asm volatile("v_mbcnt_lo_u32_b32 %0, -1, 0\n\tv_mbcnt_hi_u32_b32 %0, -1, %0" : "=v"(lane)); const int tid = wave * 64 + lane;
        pg8::Gemm g{OATT, WB_OUT, T, D, D}; pg8::StaticOrder S; S.init(T, D, G, bid);
        EpiRes<true, true> E{Y2, Y3, norm_ffn + D, HP, SSQ + 2 * T};
        pg8::gemm_phase<EpiRes<true, true>, pg8::StaticOrder, true, true>(lds, g, S, E, wave);
        skinny_gemm<1, 2, 4, D>(lds, HS, DS_, WGU1, FF / 32, nullptr, nullptr, 0, HIDS, bid, G, tid, 0, SkNorm{SSQS + 2 * BS, nullptr, nullptr, nullptr});
        if (BOTH(12)) GRID_BAR();
    }
    if (IN(13)) {
        const ArgsK* AP = launder_args();
        int lane; asm volatile("v_mbcnt_lo_u32_b32 %0, -1, 0\n\tv_mbcnt_hi_u32_b32 %0, -1, %0" : "=v"(lane)); const int tid = wave * 64 + lane;
        pg8::Gemm g{HP, WGU1, T, 2 * FF, D}; pg8::StaticOrder S; S.init(T, 2 * FF, G, bid);
        EpiSwiglu E{HID, SSQ + 2 * T};
        pg8::gemm_phase<EpiSwiglu, pg8::StaticOrder, true, true>(lds, g, S, E, wave);
        skinny_gemm<0, 1, 2, FF>(lds, HIDS, FFS_, WD1, D / 32, out + O_YS, Y3S, D, nullptr, bid, G, tid, (T / 256 * (2 * FF / 256)) % G);
        if (BOTH(13)) GRID_BAR();
    }
    if (IN(14)) {
        const ArgsK* AP = launder_args();
        int lane; asm volatile("v_mbcnt_lo_u32_b32 %0, -1, 0\n\tv_mbcnt_hi_u32_b32 %0, -1, %0" : "=v"(lane)); const int tid = wave * 64 + lane;
        pg8::Gemm g{HID, WD1, T, D, FF}; pg8::StaticOrder S; S.init(T, D, G, bid);
        EpiRes<true, false> E{Y3, out + O_YP, nullptr, nullptr, nullptr};
        pg8::gemm_phase<EpiRes<true, false>, pg8::StaticOrder, true, true>(lds, g, S, E, wave);
    }
#undef LATE_TR
#undef LATE_N
#undef IN
#undef BOTH
}
#undef x_p
#undef x_s
#undef state_in
#undef cache_k
#undef cache_v
#undef cache_ki
#undef page_table
#undef norm_mix
#undef norm_ffn
#undef lb_logits
#undef a_w_in
#undef a_w_out
#undef a_gnorm
#undef b_w_in
#undef b_w_out
#undef b_q_norm
#undef b_k_norm
#undef b_ki_norm
#undef rel_bias
#undef w_gu
#undef w_down
#undef LB0
#undef LUTG
#undef WA_IN
#undef WA_OUT
#undef WGU0
#undef WD0
#undef WB_IN
#undef WB_OUT
#undef WGU1
#undef WD1
#undef HP
#undef ZQ
#undef ZK
#undef ZV
#undef ZG
#undef LF
#undef QG
#undef OL
#undef DS
#undef DSC
#undef OG
#undef Y1
#undef HID
#undef Y2
#undef Y3
#undef QRAW
#undef QIB
#undef KRAW
#undef KIRAW
#undef WI
#undef KB
#undef VB
#undef KIB
#undef SC
#undef IDX
#undef OATT
#undef HS
#undef RS1
#undef OGS
#undef Y1S
#undef HIDS
#undef Y2S
#undef R5S
#undef QNS
#undef SCS
#undef IDXS
#undef OATTS
#undef Y3S
#undef out
#undef SSQ
#undef SSQS

extern "C" void kernel_launch(void* const* d_in, const int* in_sizes, int n_in, void* d_out, int out_size, void* d_ws, size_t ws_size, hipStream_t stream) {
    static int grid = 0;
    if (grid == 0) {
        if (n_in != 21 || ws_size < WS_END) { fprintf(stderr, "kernel_launch: unexpected problem (n_in %d, out %d, ws %zu); nothing launched\n", n_in, out_size, ws_size); grid = -1; return; }
        int dev = 0, cus = 0, per_cu = 0;
        if (hipGetDevice(&dev) != hipSuccess || hipDeviceGetAttribute(&cus, hipDeviceAttributeMultiprocessorCount, dev) != hipSuccess) { grid = -1; return; }
        if (hipFuncSetAttribute((const void*)mk_fwd, hipFuncAttributeMaxDynamicSharedMemorySize, LDS_BYTES) != hipSuccess) { fprintf(stderr, "kernel_launch: hipFuncSetAttribute failed\n"); grid = -1; return; }
        if (hipOccupancyMaxActiveBlocksPerMultiprocessor(&per_cu, (const void*)mk_fwd, NTHR, LDS_BYTES) != hipSuccess || per_cu < 1) { fprintf(stderr, "kernel_launch: occupancy query says %d blocks per CU\n", per_cu); }
        (void)hipGetLastError();
        grid = cus;
    }
    if (grid < 0) return;
    (void)hipMemsetAsync((char*)d_ws + WS_CTL, 0, CTL_ZERO_BYTES, stream);
    Args a{};
    for (int i = 0; i < 21; ++i) a.in[i] = d_in[i];
    a.out = (float*)d_out; a.ws = (unsigned char*)d_ws;
#if MK_ONE_LAUNCH
    a.ph_lo = 0; a.ph_hi = NPHASE; a.li = 0;
    hipLaunchKernelGGL(mk_fwd, dim3(grid), dim3(NTHR), LDS_BYTES, stream, a);
#else
    for (int p = 0; p < NPHASE; ++p) { a.ph_lo = p; a.ph_hi = p + 1; a.li = p; hipLaunchKernelGGL(mk_fwd, dim3(grid), dim3(NTHR), LDS_BYTES, stream, a); }
#endif
}
```

```cpp
#include <hip/hip_runtime.h>
#include <cstdio>
#include <cstdint>
namespace pg8 {
#define PG8_LAS __attribute__((address_space(3)))
typedef unsigned short bf16_t;
typedef short bf16x8 __attribute__((ext_vector_type(8)));
typedef float f32x4 __attribute__((ext_vector_type(4)));
typedef unsigned u32x4 __attribute__((ext_vector_type(4)));
constexpr int BM = 256, BK = 64, HALF = 128, HTB = HALF * BK * 2  , STAGE_BYTES = 8 * HTB, NXCD = 8, WGM = 8;

__host__ __device__ __forceinline__ int lds_byte(int r, int c) { const int st = (r >> 4) * 2 + (c >> 5), rr = r & 15, cc = c & 31, ob = rr * 64 + cc * 2; return st * 1024 + (ob ^ (((ob >> 9) & 1) << 5)); }
__host__ __device__ __forceinline__ void stage_rc(int b, int& R, int& C) { const int st = b / 1024, sb = b % 1024, swz = sb ^ (((sb >> 9) & 1) << 5); R = (st >> 1) * 16 + swz / 64; C = (st & 1) * 32 + (swz % 64) / 2; }
__host__ __device__ __forceinline__ int perm32(int rho) { const int n = rho >> 4, i = rho & 15; return 8 * (i >> 2) + 4 * n + (i & 3); }

struct Unit { int pm, pn; };
struct Gemm { const bf16_t* A; const bf16_t* Bt; int M, N, K; };

struct StaticOrder {
    int nM, nN, nwg, G, c;
    __host__ __device__ void init(int M, int N, int G_, int c_) { nM = M / BM; nN = N / BM; nwg = nM * nN; G = G_; c = c_; }
    __host__ __device__ bool next(int i, Unit& u) const {
        const long L = (long)i * G + c; if (L >= nwg) return false;
        int wgid = (int)L; { const int q = nwg / NXCD, r = nwg % NXCD, xcd = wgid % NXCD, off = wgid / NXCD; wgid = (xcd < r ? xcd * (q + 1) : r * (q + 1) + (xcd - r) * q) + off; }
        const int nig = WGM * nN, gid = wgid / nig, fm = gid * WGM, gsz = (nM - fm) < WGM ? (nM - fm) : WGM;
        u.pm = fm + ((wgid % nig) % gsz); u.pn = (wgid % nig) / gsz; return true;
    }
    __device__ __forceinline__ void a_ready(const Unit&) const {}
    __device__ __forceinline__ void done(const Unit&) const {}
};

__device__ __forceinline__ unsigned cvt_pk_bf16(float lo, float hi) { unsigned r; asm volatile("v_cvt_pk_bf16_f32 %0, %1, %2" : "=v"(r) : "v"(lo), "v"(hi)); return r; }
template <class Epi, class Sched, bool ALIGN_EPI = false, bool SP2 = false>
__device__ __forceinline__ void gemm_phase(PG8_LAS unsigned char* lds, const Gemm g, const Sched& S, const Epi& E, const int wid  ) {
    int lane; asm volatile("v_mbcnt_lo_u32_b32 %0, -1, 0\n\tv_mbcnt_hi_u32_b32 %0, -1, %0" : "=v"(lane));
    const int tid = wid * 64 + lane, wr = wid >> 2, wc = wid & 3, fr = lane & 15, fq = lane >> 4;
    const int K = g.K, nt = K / BK;
    unsigned voffA[2], voffB[2];
#pragma unroll
    for (int i = 0; i < 2; ++i) { int R, C; stage_rc(tid * 16 + i * 8192, R, C); const int Rb = Epi::PERM ? ((R & ~31) + perm32(R & 31)) : R;
        voffA[i] = (unsigned)(R * K + C) * 2u; voffB[i] = (unsigned)(Rb * K + C) * 2u; }
    const size_t kstep = (size_t)(BK * 2);
    const size_t hstep = (size_t)HALF * K * 2;
    const size_t tstep = 2 * hstep;
    const unsigned ldsw = (unsigned)wid * 1024u;
    const int aoff = lds_byte(wr * 64 + fr, fq * 8), boff = lds_byte(wc * 32 + fr, fq * 8);
#define PG8_SA(b, h) (((b) * 2 + (h)) * HTB)
#define PG8_SB(b, h) ((4 + (b) * 2 + (h)) * HTB)
#define PG8_STAGE(bufoff, gbase, voff) do { _Pragma("unroll") for (int _i = 0; _i < 2; ++_i) \
        __builtin_amdgcn_global_load_lds((const unsigned*)((const char*)(gbase) + (voff)[_i]), (PG8_LAS unsigned*)(lds + (bufoff) + ldsw + _i * 8192), 16, 0, 0); } while (0)
#define PG8_LDA(dst, b, h) do { _Pragma("unroll") for (int m = 0; m < 4; ++m) _Pragma("unroll") for (int k = 0; k < 2; ++k) dst[m][k] = *(const PG8_LAS bf16x8*)(lds + PG8_SA(b, h) + aoff + m * 2048 + k * 1024); } while (0)
#define PG8_LDB(dst, b, h) do { _Pragma("unroll") for (int n = 0; n < 2; ++n) _Pragma("unroll") for (int k = 0; k < 2; ++k) dst[n][k] = *(const PG8_LAS bf16x8*)(lds + PG8_SB(b, h) + boff + n * 2048 + k * 1024); } while (0)
#define PG8_MMA(ai, bj, At, Bt) do { __builtin_amdgcn_s_setprio(1); _Pragma("unroll") for (int m = 0; m < 4; ++m) _Pragma("unroll") for (int n = 0; n < 2; ++n) _Pragma("unroll") for (int k = 0; k < 2; ++k) \
        acc[ai][bj][m][n] = __builtin_amdgcn_mfma_f32_16x16x32_bf16(Bt[n][k], At[m][k], acc[ai][bj][m][n], 0, 0, 0); __builtin_amdgcn_s_setprio(0); } while (0)
#define PG8_WAIT_V(n) asm volatile("s_waitcnt vmcnt(" #n ")" ::: "memory")
#define PG8_WAIT_L(n) asm volatile("s_waitcnt lgkmcnt(" #n ")" ::: "memory")
#define PG8_BAR __builtin_amdgcn_s_barrier()
#define PG8_SCHED __builtin_amdgcn_sched_barrier(0)
    Unit cur, nxt; int ui = 0;
    if (!S.next(0, cur)) return;
    f32x4 acc[2][2][4][2];
#pragma unroll
    for (int a = 0; a < 2; ++a)
#pragma unroll
        for (int b = 0; b < 2; ++b)
#pragma unroll
            for (int m = 0; m < 4; ++m)
#pragma unroll
                for (int n = 0; n < 2; ++n) acc[a][b][m][n] = (f32x4){0.f, 0.f, 0.f, 0.f};
    bf16x8 At[4][2], B0[2][2], B1[2][2];
    const char* cA = (const char*)g.A + (size_t)cur.pm * tstep; const char* cB = (const char*)g.Bt + (size_t)cur.pn * tstep;
    S.a_ready(cur);
    if constexpr (SP2) {
        PG8_STAGE(PG8_SB(0, 0), cB, voffB); PG8_STAGE(PG8_SB(0, 1), cB + hstep, voffB); PG8_STAGE(PG8_SA(0, 0), cA, voffA); PG8_STAGE(PG8_SA(0, 1), cA + hstep, voffA);
        if (wr == 1) PG8_BAR;
        PG8_WAIT_V(2); PG8_BAR;
        PG8_STAGE(PG8_SB(1, 0), cB + kstep, voffB); PG8_STAGE(PG8_SA(1, 0), cA + kstep, voffA); PG8_STAGE(PG8_SB(1, 1), cB + hstep + kstep, voffB);
        PG8_WAIT_V(6); PG8_BAR;
    } else {
        PG8_STAGE(PG8_SB(0, 0), cB, voffB); PG8_STAGE(PG8_SA(0, 0), cA, voffA); PG8_STAGE(PG8_SB(0, 1), cB + hstep, voffB); PG8_STAGE(PG8_SA(0, 1), cA + hstep, voffA);
        if (wr == 1) PG8_BAR;
        PG8_WAIT_V(4); PG8_BAR;
        PG8_STAGE(PG8_SB(1, 0), cB + kstep, voffB); PG8_STAGE(PG8_SA(1, 0), cA + kstep, voffA); PG8_STAGE(PG8_SB(1, 1), cB + hstep + kstep, voffB);
        PG8_WAIT_V(6); PG8_BAR;
    }
    for (;;) {
        const bool has_next = S.next(ui + 1, nxt);
        const char* nA = has_next ? (const char*)g.A + (size_t)nxt.pm * tstep : cA; const char* nB = has_next ? (const char*)g.Bt + (size_t)nxt.pn * tstep : cB;
        for (int t = 0; t < nt; t += 2) {
            const bool last = (t == nt - 2);
            const char* a1 = cA + (size_t)(t + 1) * kstep;
            const char* a2 = last ? nA : cA + (size_t)(t + 2) * kstep; const char* b2 = last ? nB : cB + (size_t)(t + 2) * kstep;
            const char* a3 = a2 + kstep; const char* b3 = b2 + kstep;
            if (last && has_next) S.a_ready(nxt);
            if constexpr (SP2) {
            PG8_LDB(B0, 0, 0); PG8_LDB(B1, 0, 1); PG8_SCHED; PG8_LDA(At, 0, 0); PG8_STAGE(PG8_SA(1, 1), a1 + hstep, voffA);
            PG8_WAIT_V(8); PG8_WAIT_L(0); PG8_BAR; PG8_MMA(0, 0, At, B0); PG8_MMA(0, 1, At, B1); PG8_BAR; PG8_SCHED;
            PG8_LDA(At, 0, 1); PG8_STAGE(PG8_SB(0, 0), b2, voffB); PG8_STAGE(PG8_SB(0, 1), b2 + hstep, voffB); PG8_STAGE(PG8_SA(0, 0), a2, voffA);
            PG8_WAIT_V(8); PG8_WAIT_L(0); PG8_BAR; PG8_MMA(1, 0, At, B0); PG8_MMA(1, 1, At, B1); PG8_BAR; PG8_SCHED;
            PG8_LDB(B0, 1, 0); PG8_LDB(B1, 1, 1); PG8_SCHED; PG8_LDA(At, 1, 0); PG8_STAGE(PG8_SA(0, 1), a2 + hstep, voffA);
            PG8_WAIT_V(8); PG8_WAIT_L(0); PG8_BAR; PG8_MMA(0, 0, At, B0); PG8_MMA(0, 1, At, B1); PG8_BAR; PG8_SCHED;
            PG8_LDA(At, 1, 1); PG8_STAGE(PG8_SB(1, 0), b3, voffB); PG8_STAGE(PG8_SB(1, 1), b3 + hstep, voffB); PG8_STAGE(PG8_SA(1, 0), a3, voffA);
            PG8_WAIT_V(8); PG8_WAIT_L(0); PG8_BAR; PG8_MMA(1, 0, At, B0); PG8_MMA(1, 1, At, B1); PG8_BAR; PG8_SCHED;
            } else {
            PG8_LDB(B0, 0, 0); PG8_SCHED; PG8_LDA(At, 0, 0); PG8_STAGE(PG8_SA(1, 1), a1 + hstep, voffA);
            PG8_WAIT_L(8); PG8_BAR; PG8_WAIT_L(0); PG8_MMA(0, 0, At, B0); PG8_BAR; PG8_SCHED;
            PG8_LDB(B1, 0, 1); PG8_STAGE(PG8_SB(0, 0), b2, voffB);
            PG8_BAR; PG8_WAIT_L(0); PG8_MMA(0, 1, At, B1); PG8_BAR;
            PG8_LDA(At, 0, 1); PG8_STAGE(PG8_SA(0, 0), a2, voffA);
            PG8_BAR; PG8_WAIT_L(0); PG8_MMA(1, 0, At, B0); PG8_BAR; PG8_SCHED;
            PG8_STAGE(PG8_SB(0, 1), b2 + hstep, voffB);
            PG8_WAIT_V(6); PG8_BAR; PG8_MMA(1, 1, At, B1); PG8_BAR;
            PG8_LDB(B0, 1, 0); PG8_SCHED; PG8_LDA(At, 1, 0); PG8_STAGE(PG8_SA(0, 1), a2 + hstep, voffA);
            PG8_WAIT_L(8); PG8_BAR; PG8_WAIT_L(0); PG8_MMA(0, 0, At, B0); PG8_BAR; PG8_SCHED;
            PG8_LDB(B1, 1, 1); PG8_STAGE(PG8_SB(1, 0), b3, voffB);
            PG8_BAR; PG8_WAIT_L(0); PG8_MMA(0, 1, At, B1); PG8_BAR;
            PG8_LDA(At, 1, 1); PG8_STAGE(PG8_SA(1, 0), a3, voffA);
            PG8_BAR; PG8_WAIT_L(0); PG8_MMA(1, 0, At, B0); PG8_BAR; PG8_SCHED;
            PG8_STAGE(PG8_SB(1, 1), b3 + hstep, voffB);
            PG8_WAIT_V(6); PG8_BAR; PG8_MMA(1, 1, At, B1); PG8_BAR;
            }
        }
        if constexpr (ALIGN_EPI) { if (wr == 0) PG8_BAR; }
        if constexpr (!Epi::AFTER_DRAIN) { E(acc, cur, wr, wc, fr, fq); S.done(cur); }
        if (!has_next) break;
#pragma unroll
        for (int a = 0; a < 2; ++a)
#pragma unroll
            for (int b = 0; b < 2; ++b)
#pragma unroll
                for (int m = 0; m < 4; ++m)
#pragma unroll
                    for (int n = 0; n < 2; ++n) acc[a][b][m][n] = (f32x4){0.f, 0.f, 0.f, 0.f};
        cur = nxt; cA = nA; cB = nB; ++ui;
        if constexpr (ALIGN_EPI) { if (wr == 1) PG8_BAR; }
    }
    PG8_WAIT_V(0);
    if constexpr (!ALIGN_EPI) { if (wr == 0) PG8_BAR; }
    PG8_BAR;
    if constexpr (Epi::AFTER_DRAIN) { E.fused(acc, cur, wr, wc, fr, fq, lds, wid, lane); S.done(cur); }
#undef PG8_SA
#undef PG8_SB
#undef PG8_STAGE
#undef PG8_LDA
#undef PG8_LDB
#undef PG8_MMA
#undef PG8_WAIT_V
#undef PG8_WAIT_L
#undef PG8_BAR
#undef PG8_SCHED
}
}

#define DI __device__ __forceinline__
#define GAS __attribute__((address_space(1)))
#define LAS __attribute__((address_space(3)))
typedef unsigned short bf16;
typedef unsigned v4u __attribute__((ext_vector_type(4)));
typedef unsigned v2u __attribute__((ext_vector_type(2)));
typedef int v4i __attribute__((ext_vector_type(4)));
typedef float f32x4 __attribute__((ext_vector_type(4)));
typedef float f32x2 __attribute__((ext_vector_type(2)));
typedef float f32x16 __attribute__((ext_vector_type(16)));
typedef short bf16x8 __attribute__((ext_vector_type(8)));
typedef short s16x4 __attribute__((ext_vector_type(4)));

constexpr int D = 2048, T = 8192, BS = 128, FF = 5632;
constexpr int NA = 8192;
constexpr int NBR = 5264, NB = 5376;
constexpr int PAST = 2048, PAGE = 128, NPAGES = 16, TOPK = 256;
constexpr int SPAD = 192, DS_ = D + SPAD, FFS_ = FF + SPAD;
constexpr int SCS_LD = 2112;
constexpr float EPS = 1e-6f;
constexpr int NWAVES = 8, NTHR = 512;
constexpr int NPHASE = 15;
#ifndef MK_ONE_LAUNCH
#define MK_ONE_LAUNCH 1
#endif

constexpr size_t MiB = 1u << 20;
constexpr size_t WS_CTL = 0, CTL_ZERO_BYTES = 1 * MiB;
constexpr size_t WS_LB0 = 1 * MiB;
constexpr size_t WS_LUT = 1 * MiB + 65536;
constexpr size_t WS_SSQ = 1 * MiB + 131072;
constexpr size_t WS_WA_IN = 2 * MiB, WS_WA_OUT = 34 * MiB, WS_WGU0 = 42 * MiB, WS_WD0 = 86 * MiB, WS_WB_IN = 108 * MiB, WS_WB_OUT = 130 * MiB, WS_WGU1 = 138 * MiB, WS_WD1 = 182 * MiB;
constexpr size_t WS_HP = 204 * MiB, WS_ZQ = 236 * MiB, WS_ZK = 268 * MiB, WS_ZV = 300 * MiB, WS_ZG = 332 * MiB, WS_LF = 364 * MiB, WS_QG = 428 * MiB, WS_OL = 460 * MiB;
constexpr size_t WS_DS = 524 * MiB, WS_DSC = 540 * MiB, WS_OG = 542 * MiB, WS_Y1 = 574 * MiB, WS_HID = 638 * MiB, WS_Y2 = 726 * MiB, WS_Y3 = 790 * MiB;
constexpr size_t WS_QRAW = 854 * MiB, WS_QIB = 886 * MiB, WS_KRAW = 918 * MiB, WS_KIRAW = 934 * MiB, WS_WI = 938 * MiB, WS_KB = 940 * MiB, WS_VB = 948 * MiB, WS_KIB = 956 * MiB;
constexpr size_t WS_SC = 960 * MiB, WS_IDX = 1216 * MiB, WS_OATT = 1224 * MiB;
constexpr size_t WS_HS = 1256 * MiB, WS_RS1 = 1257 * MiB, WS_OGS = 1261 * MiB, WS_Y1S = 1262 * MiB, WS_HIDS = 1263 * MiB, WS_Y2S = 1265 * MiB, WS_R5S = 1266 * MiB;
constexpr size_t WS_QNS = 1269 * MiB, WS_SCS = 1270 * MiB, WS_IDXS = 1272 * MiB, WS_OATTS = 1273 * MiB, WS_Y3S = 1274 * MiB, WS_K8 = 1276 * MiB, WS_V8 = 1280 * MiB, WS_END = 1284 * MiB;

constexpr size_t O_YP = 0, O_YS = O_YP + (size_t)T * D, O_SP = O_YS + (size_t)BS * D, O_SS = O_SP + 16 * 128 * 128, O_KP = O_SS + (size_t)BS * 16 * 128 * 128;
constexpr size_t O_VP = O_KP + (size_t)T * 512, O_KIP = O_VP + (size_t)T * 512, O_KS = O_KIP + (size_t)T * 128, O_VS = O_KS + BS * 512, O_KIS = O_VS + BS * 512, O_END = O_KIS + BS * 128;

constexpr int CW_TMO = 0, CW_BAR = 4096;

constexpr int RING_BYTES = 131072, WSLAB = 16640  , LUT_OFF = NWAVES * WSLAB  , LUT_BYTES = 129 * 16 * 4  , MISC_OFF = 141440, LDS_BYTES = 147456;
static_assert(LUT_OFF >= RING_BYTES && LUT_OFF + LUT_BYTES <= MISC_OFF && MISC_OFF + 256 <= LDS_BYTES, "LDS map");

struct Args { const void* in[21]; float* out; unsigned char* ws; int ph_lo, ph_hi, li, pad; };

DI float bf2f(unsigned b) { return __uint_as_float(b << 16); }
typedef __bf16 bf16x2_t __attribute__((ext_vector_type(2)));
DI unsigned pk2(float lo, float hi) { const f32x2 v = {lo, hi}; return __builtin_bit_cast(unsigned, __builtin_convertvector(v, bf16x2_t)); }
DI float wave_sum(float v) {
#pragma unroll
    for (int o = 1; o < 64; o <<= 1) v += __shfl_xor(v, o);
    return v;
}
DI float grp16_sum(float v) {
#pragma unroll
    for (int o = 1; o < 16; o <<= 1) v += __shfl_xor(v, o);
    return v;
}
DI float sigm(float x) { return 1.f / (1.f + __expf(-x)); }
DI float silu(float x) { return x / (1.f + __expf(-x)); }
#define LDS_WAIT() asm volatile("s_waitcnt lgkmcnt(0)" ::: "memory")
#define VM_WAIT() asm volatile("s_waitcnt vmcnt(0)" ::: "memory")
#define MFMA16(a, b, c) __builtin_amdgcn_mfma_f32_16x16x32_bf16((a), (b), (c), 0, 0, 0)
#define MFMA32(a, b, c) __builtin_amdgcn_mfma_f32_32x32x16_bf16((a), (b), (c), 0, 0, 0)
DI bf16x8 pack8(const f32x4& a, const f32x4& b) { v4u w; w.x = pk2(a[0], a[1]); w.y = pk2(a[2], a[3]); w.z = pk2(b[0], b[1]); w.w = pk2(b[2], b[3]); return __builtin_bit_cast(bf16x8, w); }
DI bf16x8 pack8f(const float* p) { v4u w; w.x = pk2(p[0], p[1]); w.y = pk2(p[2], p[3]); w.z = pk2(p[4], p[5]); w.w = pk2(p[6], p[7]); return __builtin_bit_cast(bf16x8, w); }
static_assert(WS_ZK - WS_ZQ == (size_t)T * D * 2 && WS_ZV - WS_ZK == (size_t)T * D * 2 && WS_ZG - WS_ZV == (size_t)T * D * 2, "ZQ|ZK|ZV|ZG consecutive");

DI void rmsnorm_row(const float* x, const float* g, bf16* o, int lane) {
    const f32x4* xr = (const f32x4*)x + lane; const f32x4* gr = (const f32x4*)g + lane;
    f32x4 v[8]; float s = 0.f;
#pragma unroll
    for (int j = 0; j < 8; ++j) { v[j] = xr[64 * j]; s += (v[j].x * v[j].x + v[j].y * v[j].y) + (v[j].z * v[j].z + v[j].w * v[j].w); }
    const float rs = rsqrtf(wave_sum(s) * (1.f / D) + EPS);
    v2u* o8 = (v2u*)o + lane;
#pragma unroll
    for (int j = 0; j < 8; ++j) { const f32x4 gg = gr[64 * j]; v2u w; w.x = pk2(v[j].x * rs * gg.x, v[j].y * rs * gg.y); w.y = pk2(v[j].z * rs * gg.z, v[j].w * rs * gg.w); o8[64 * j] = w; }
}

struct TrItem { const float* W; bf16* WT; int K, N, mode, item; };
DI void tr_load(const TrItem& t, int lane, f32x4 (&r)[16]) {
    const int nblk = (t.N + 63) / 64, kb = t.item / nblk, nb = t.item % nblk, k0 = 64 * kb, n0 = 64 * nb, nq = lane & 15;
    const bool ok = n0 + 4 * nq < t.N;
    const float* p = t.W + (size_t)(k0 + (lane >> 4)) * t.N + n0 + 4 * nq;
#pragma unroll
    for (int i = 0; i < 16; ++i) r[i] = ok ? __builtin_nontemporal_load((const f32x4*)(p + (size_t)(4 * i) * t.N)) : (f32x4){0.f, 0.f, 0.f, 0.f};
}
DI void tr_store(const TrItem& t, int lane, const f32x4 (&r)[16], LAS float* scr) {
    const int nblk = (t.N + 63) / 64, kb = t.item / nblk, nb = t.item % nblk, k0 = 64 * kb, n0 = 64 * nb, nq = lane & 15;
#pragma unroll
    for (int i = 0; i < 16; ++i) { LAS float* d = scr + (4 * i + (lane >> 4)) * 65 + 4 * nq; d[0] = r[i][0]; d[1] = r[i][1]; d[2] = r[i][2]; d[3] = r[i][3]; }
    LDS_WAIT(); asm volatile("" ::: "memory");
    int row0 = n0;
    if (t.mode == 1) { row0 = (n0 < FF) ? 256 * (n0 / 128) + (n0 % 128) : 256 * ((n0 - FF) / 128) + 128 + ((n0 - FF) % 128); }
    const int c = lane & 7;
#pragma unroll
    for (int j = 0; j < 8; ++j) { const int n = (lane >> 3) + 8 * j; const LAS float* s = scr + (8 * c) * 65 + n;
        v4u o; o.x = pk2(s[0 * 65], s[1 * 65]); o.y = pk2(s[2 * 65], s[3 * 65]); o.z = pk2(s[4 * 65], s[5 * 65]); o.w = pk2(s[6 * 65], s[7 * 65]);
        *(v4u*)(t.WT + (size_t)(row0 + n) * t.K + k0 + 8 * c) = o; }
    LDS_WAIT(); asm volatile("" ::: "memory");
}

#define EPI_LOOP_BEGIN  _Pragma("unroll") for (int ai = 0; ai < 2; ++ai) _Pragma("unroll") for (int m = 0; m < 4; ++m) { const int row = u.pm * 256 + ai * 128 + wr * 64 + m * 16 + fr;
#define EPI_LOOP_END }

struct EpiA {
    static constexpr bool PERM = true, AFTER_DRAIN = false;
    bf16* zq; float* lf; const float* lb0;
    DI void operator()(const f32x4 (&acc)[2][2][4][2], const pg8::Unit& u, int wr, int wc, int fr, int fq) const {
        const int ty = u.pn >> 3, cbase = (u.pn & 7) * 256 + wc * 32 + 8 * fq;
        if (ty == 1) {
            f32x4 lbv[2][2];
#pragma unroll
            for (int bj = 0; bj < 2; ++bj) { lbv[bj][0] = *(const f32x4*)(lb0 + cbase + bj * 128); lbv[bj][1] = *(const f32x4*)(lb0 + cbase + bj * 128 + 4); }
            EPI_LOOP_BEGIN
#pragma unroll
                for (int bj = 0; bj < 2; ++bj) { const size_t o = (size_t)row * D + cbase + bj * 128; f32x4 lg[2], kk[2];
#pragma unroll
                    for (int n = 0; n < 2; ++n)
#pragma unroll
                        for (int e = 0; e < 4; ++e) { const float f = fminf(fmaxf(acc[ai][bj][m][n][e], -30.f), 30.f), lb = lbv[bj][n][e], ef = __expf(-f), sg = 1.f / (1.f + ef), sgn = ef / (1.f + ef);
                            lg[n][e] = __logf(lb + (1.f - lb) * sg); kk[n][e] = (1.f - lb) * sgn; }
                    *(f32x4*)(lf + o) = lg[0]; *(f32x4*)(lf + o + 4) = lg[1]; *(bf16x8*)(zq + (size_t)T * D + o) = pack8(kk[0], kk[1]); }
            EPI_LOOP_END
        } else {
            bf16* dst = zq + (size_t)ty * T * D;
            EPI_LOOP_BEGIN
#pragma unroll
                for (int bj = 0; bj < 2; ++bj) { const size_t o = (size_t)row * D + cbase + bj * 128; f32x4 a = acc[ai][bj][m][0], b = acc[ai][bj][m][1];
                    if (ty != 2) {
#pragma unroll
                        for (int e = 0; e < 4; ++e) { a[e] = silu(a[e]); b[e] = silu(b[e]); } }
                    *(bf16x8*)(dst + o) = pack8(a, b); }
            EPI_LOOP_END
        }
    }
};
template <bool RESB, bool OUTB>
struct EpiRes {
    static constexpr bool PERM = true, AFTER_DRAIN = false;
    const void* res; void* out; const float* gain; bf16* hp; float* ssq;
    DI void operator()(const f32x4 (&acc)[2][2][4][2], const pg8::Unit& u, int wr, int wc, int fr, int fq) const {
        const int cbase = u.pn * 256 + wc * 32 + 8 * fq;
        f32x4 gv[2][2];
        if (gain) {
#pragma unroll
            for (int bj = 0; bj < 2; ++bj) { gv[bj][0] = *(const f32x4*)(gain + cbase + bj * 128); gv[bj][1] = *(const f32x4*)(gain + cbase + bj * 128 + 4); } }
#pragma unroll
        for (int ai = 0; ai < 2; ++ai) {
            f32x4 rr[4][2][2];
#pragma unroll
            for (int m = 0; m < 4; ++m)
#pragma unroll
                for (int bj = 0; bj < 2; ++bj) { const size_t o = (size_t)(u.pm * 256 + ai * 128 + wr * 64 + m * 16 + fr) * D + cbase + bj * 128;
                    if (RESB) { const v4u w = *(const v4u*)((const bf16*)res + o);
                        rr[m][bj][0] = (f32x4){bf2f(w.x & 0xffffu), bf2f(w.x >> 16), bf2f(w.y & 0xffffu), bf2f(w.y >> 16)}; rr[m][bj][1] = (f32x4){bf2f(w.z & 0xffffu), bf2f(w.z >> 16), bf2f(w.w & 0xffffu), bf2f(w.w >> 16)}; }
                    else { rr[m][bj][0] = *(const f32x4*)((const float*)res + o); rr[m][bj][1] = *(const f32x4*)((const float*)res + o + 4); } }
#pragma unroll
            for (int m = 0; m < 4; ++m) { const int row = u.pm * 256 + ai * 128 + wr * 64 + m * 16 + fr;
                float sq = 0.f;
#pragma unroll
                for (int bj = 0; bj < 2; ++bj) { const size_t o = (size_t)row * D + cbase + bj * 128;
                    const f32x4 y0 = acc[ai][bj][m][0] + rr[m][bj][0], y1 = acc[ai][bj][m][1] + rr[m][bj][1];
                    if (OUTB) *(bf16x8*)((bf16*)out + o) = pack8(y0, y1); else { __builtin_nontemporal_store(y0, (f32x4*)((float*)out + o)); __builtin_nontemporal_store(y1, (f32x4*)((float*)out + o + 4)); }
                    if (gain) { *(bf16x8*)(hp + o) = pack8(y0 * gv[bj][0], y1 * gv[bj][1]);
                        sq += (y0[0] * y0[0] + y0[1] * y0[1]) + (y0[2] * y0[2] + y0[3] * y0[3]) + (y1[0] * y1[0] + y1[1] * y1[1]) + (y1[2] * y1[2] + y1[3] * y1[3]); } }
                if (gain) { sq += __shfl_xor(sq, 16); sq += __shfl_xor(sq, 32); if (fq == 0) atomicAdd(ssq + row, sq); }
            }
        }
    }
};
struct EpiSwiglu {
    static constexpr bool PERM = true, AFTER_DRAIN = false;
    bf16* hid; const float* ssq;
    DI void operator()(const f32x4 (&acc)[2][2][4][2], const pg8::Unit& u, int wr, int wc, int fr, int fq) const {
        const int cbase = u.pn * 128 + wc * 32 + 8 * fq;
        EPI_LOOP_BEGIN
            const float rs = rsqrtf(ssq[row] * (1.f / D) + EPS);
            f32x4 a = acc[ai][0][m][0], b = acc[ai][0][m][1]; const f32x4 ua = acc[ai][1][m][0], ub = acc[ai][1][m][1];
#pragma unroll
            for (int e = 0; e < 4; ++e) { a[e] = silu(a[e] * rs) * (ua[e] * rs); b[e] = silu(b[e] * rs) * (ub[e] * rs); }
            *(bf16x8*)(hid + (size_t)row * FF + cbase) = pack8(a, b);
        EPI_LOOP_END
    }
};
struct EpiB {
    static constexpr bool PERM = true, AFTER_DRAIN = false;
    bf16 *qraw, *qib, *vb; float *kraw, *vout, *kiraw, *wi; const float* ssq;
    DI void operator()(const f32x4 (&acc_)[2][2][4][2], const pg8::Unit& u, int wr, int wc, int fr, int fq) const {
        const int pn = u.pn, ct = wc * 32 + 8 * fq;
        f32x4 acc[2][2][4][2];
#pragma unroll
        for (int ai = 0; ai < 2; ++ai)
#pragma unroll
            for (int m = 0; m < 4; ++m) { const float rs = rsqrtf(ssq[u.pm * 256 + ai * 128 + wr * 64 + m * 16 + fr] * (1.f / D) + EPS);
#pragma unroll
                for (int bj = 0; bj < 2; ++bj) { acc[ai][bj][m][0] = acc_[ai][bj][m][0] * rs; acc[ai][bj][m][1] = acc_[ai][bj][m][1] * rs; } }
        if (pn < 8 || (pn >= 12 && pn < 20)) {
            bf16* dst = pn < 8 ? qraw : qib; const int cbase = (pn < 8 ? pn : pn - 12) * 256 + ct;
            EPI_LOOP_BEGIN
#pragma unroll
                for (int bj = 0; bj < 2; ++bj) *(bf16x8*)(dst + (size_t)row * D + cbase + bj * 128) = pack8(acc[ai][bj][m][0], acc[ai][bj][m][1]);
            EPI_LOOP_END
        } else if (pn < 10) {
            const int cbase = (pn - 8) * 256 + ct;
            EPI_LOOP_BEGIN
#pragma unroll
                for (int bj = 0; bj < 2; ++bj) { float* p = kraw + (size_t)row * 512 + cbase + bj * 128; *(f32x4*)p = acc[ai][bj][m][0]; *(f32x4*)(p + 4) = acc[ai][bj][m][1]; }
            EPI_LOOP_END
        } else if (pn < 12) {
            const int cbase = (pn - 10) * 256 + ct;
            EPI_LOOP_BEGIN
#pragma unroll
                for (int bj = 0; bj < 2; ++bj) { const size_t o = (size_t)row * 512 + cbase + bj * 128; __builtin_nontemporal_store(acc[ai][bj][m][0], (f32x4*)(vout + o)); __builtin_nontemporal_store(acc[ai][bj][m][1], (f32x4*)(vout + o + 4));
                    *(bf16x8*)(vb + o) = pack8(acc[ai][bj][m][0], acc[ai][bj][m][1]); }
            EPI_LOOP_END
        } else {
            const float wsc = 0.25f * 0.08838834764831845f;
            EPI_LOOP_BEGIN
                { float* p = kiraw + (size_t)row * 128 + ct; *(f32x4*)p = acc[ai][0][m][0]; *(f32x4*)(p + 4) = acc[ai][0][m][1]; }
                if (ct < 16) { float* p = wi + (size_t)row * 16 + ct; *(f32x4*)p = acc[ai][1][m][0] * wsc; *(f32x4*)(p + 4) = acc[ai][1][m][1] * wsc; }
            EPI_LOOP_END
        }
    }
};

template <int V> struct IntC { static constexpr int value = V; };
template <int S, int E, class LF> DI void skg_prime(const LF& L) { if constexpr (S < E) { L(IntC<S>{}); skg_prime<S + 1, E>(L); } }
template <int S, int NST, int NS, class LF, class MF>
DI void skg_stages(const LF& L, const MF& M) {
    if constexpr (S == 0) { skg_prime<0, (NS - 1 < NST ? NS - 1 : NST)>(L); }
    if constexpr (S < NST) {
        if constexpr (S + NS - 1 < NST) L(IntC<S + NS - 1>{});
        __builtin_amdgcn_sched_barrier(0);
        M(IntC<S>{});
        __builtin_amdgcn_sched_barrier(0);
        skg_stages<S + 1, NST, NS>(L, M);
    }
}
struct SkNorm { const float* ssq_in; const float* gain; bf16* hs; float* ssq_out; };
template <int MODE, int RT, int CT, int K>
DI void skinny_gemm(LAS unsigned char* lds, const bf16* A, int lda, const bf16* Bt, int ncb, float* out, const float* res, int ldo, bf16* hid, int bid, int G, int tid, int c0 = 0  , const SkNorm nrm = SkNorm{nullptr, nullptr, nullptr, nullptr}) {
    constexpr int R = 32 * RT, NRB = 128 / R, C = 16 * CT, LP = 36;
    constexpr int KSN = 8, RTW = 2 * RT, NPASS = CT / 2;
    static_assert(CT % 2 == 0 && 8 * R * LP * 4 <= 80 * 1024, "skinny_gemm: unit shape");
    const int wave = __builtin_amdgcn_readfirstlane(tid >> 6), lane = tid & 63, ks = wave, rh = 0, g = lane >> 4, lr = lane & 15;
    constexpr int Ks = K / KSN; const int nunits = ncb * NRB;
    LAS float* red = (LAS float*)lds;
    for (int u = bid - c0; u < nunits; u += G - c0) {
        if (u < 0) break;
        const int x8 = u & 7, j8 = u >> 3; const bool xo = (ncb & 7) == 0;
        const int cb = xo ? (j8 / NRB) * 8 + x8 : u / NRB, rb = xo ? j8 % NRB : u % NRB;
        int brow[CT];
#pragma unroll
        for (int ct = 0; ct < CT; ++ct) {
            if (MODE == 0) brow[ct] = C * cb + 16 * ct;
            else { const int h0 = (C / 2) * cb, pn = h0 >> 7, off = h0 & 127; brow[ct] = 256 * pn + off + (ct < CT / 2 ? 16 * ct : 128 + 16 * (ct - CT / 2)); }
        }
        f32x4 acc[RTW][CT];
#pragma unroll
        for (int rt = 0; rt < RTW; ++rt)
#pragma unroll
            for (int ct = 0; ct < CT; ++ct) acc[rt][ct] = (f32x4){0.f, 0.f, 0.f, 0.f};
        const bf16* ap = A + (size_t)(rb * R + rh * 16 * RTW + lr) * lda + 64 * ks + 16 * g;
        const bf16* bp = Bt + (size_t)lr * K + 64 * ks + 16 * g;
        constexpr int SK = 2, NST = Ks / (32 * SK), LPS = (RTW + CT) * SK, NS = (LPS * 4 <= 36) ? 4 : ((LPS * 3 <= 40) ? 3 : 2);
        static_assert(Ks % (32 * SK) == 0, "skinny_gemm: K quarter must be a whole number of stages");
        bf16x8 rga[NS][SK][RTW], rgb[NS][SK][CT];
#define SKG_LOAD(st) do { constexpr int s0_ = (st) * 32 * KSN * SK, sl_ = (st) % NS; _Pragma("unroll") for (int k_ = 0; k_ < SK; ++k_) { \
            _Pragma("unroll") for (int rt = 0; rt < RTW; ++rt) rga[sl_][k_][rt] = *(const bf16x8*)(ap + (size_t)(16 * rt) * lda + s0_ + 64 * KSN * (k_ >> 1) + 8 * (k_ & 1)); \
            _Pragma("unroll") for (int ct = 0; ct < CT; ++ct) rgb[sl_][k_][ct] = *(const bf16x8*)(bp + (size_t)brow[ct] * K + s0_ + 64 * KSN * (k_ >> 1) + 8 * (k_ & 1)); } } while (0)
#define SKG_MMA(st) do { constexpr int sl_ = (st) % NS; _Pragma("unroll") for (int k_ = 0; k_ < SK; ++k_) _Pragma("unroll") for (int rt = 0; rt < RTW; ++rt) _Pragma("unroll") for (int ct = 0; ct < CT; ++ct) \
            acc[rt][ct] = MFMA16(rga[sl_][k_][rt], rgb[sl_][k_][ct], acc[rt][ct]); } while (0)
        skg_stages<0, NST, NS>([&](auto st_) { constexpr int st = decltype(st_)::value; SKG_LOAD(st); }, [&](auto st_) { constexpr int st = decltype(st_)::value; SKG_MMA(st); });
#undef SKG_LOAD
#undef SKG_MMA
#pragma unroll
        for (int ps = 0; ps < NPASS; ++ps) {
            const int t0 = MODE == 0 ? 2 * ps : ps, t1 = MODE == 0 ? 2 * ps + 1 : ps + CT / 2;
#pragma unroll
            for (int rt = 0; rt < RTW; ++rt)
#pragma unroll
                for (int i = 0; i < 4; ++i) { red[(ks * R + 16 * rt + 4 * g + i) * LP + lr] = acc[rt][t0][i]; red[(ks * R + 16 * rt + 4 * g + i) * LP + 16 + lr] = acc[rt][t1][i]; }
            __syncthreads();
            if (MODE == 0) {
                for (int it = tid; it < R * 4; it += NTHR) {
                    const int rl = it >> 2, q = it & 3, row = rb * R + rl;
                    f32x4 s0 = (f32x4){0.f, 0.f, 0.f, 0.f}, s1 = s0;
#pragma unroll
                    for (int k = 0; k < KSN; ++k) { const LAS float* p = red + (k * R + rl) * LP + 8 * q; s0 += *(const LAS f32x4*)p; s1 += *(const LAS f32x4*)(p + 4); }
                    const int col = C * cb + 32 * ps + 8 * q; const size_t o = (size_t)row * ldo + col;
                    if (nrm.ssq_in) { const float rs = rsqrtf(nrm.ssq_in[row] * (1.f / D) + EPS); s0 = s0 * rs; s1 = s1 * rs; }
                    if (res) { s0 += *(const f32x4*)(res + o); s1 += *(const f32x4*)(res + o + 4); }
                    *(f32x4*)(out + o) = s0; *(f32x4*)(out + o + 4) = s1;
                    if (nrm.gain) { const f32x4 g0 = *(const f32x4*)(nrm.gain + col), g1 = *(const f32x4*)(nrm.gain + col + 4);
                        *(bf16x8*)(nrm.hs + (size_t)row * DS_ + col) = pack8(s0 * g0, s1 * g1);
                        float sq = (s0[0] * s0[0] + s0[1] * s0[1]) + (s0[2] * s0[2] + s0[3] * s0[3]) + (s1[0] * s1[0] + s1[1] * s1[1]) + (s1[2] * s1[2] + s1[3] * s1[3]);
                        sq += __shfl_xor(sq, 1); sq += __shfl_xor(sq, 2);
                        if (q == 0) atomicAdd(nrm.ssq_out + row, sq); }
                }
            } else {
                for (int it = tid; it < R * 2; it += NTHR) {
                    const int rl = it >> 1, q = it & 1, row = rb * R + rl;
                    f32x4 g0 = (f32x4){0.f, 0.f, 0.f, 0.f}, g1 = g0, u0 = g0, u1 = g0;
#pragma unroll
                    for (int k = 0; k < KSN; ++k) { const LAS float* p = red + (k * R + rl) * LP + 8 * q; g0 += *(const LAS f32x4*)p; g1 += *(const LAS f32x4*)(p + 4); u0 += *(const LAS f32x4*)(p + 16); u1 += *(const LAS f32x4*)(p + 20); }
                    const float rs = nrm.ssq_in ? rsqrtf(nrm.ssq_in[row] * (1.f / D) + EPS) : 1.f;
#pragma unroll
                    for (int e = 0; e < 4; ++e) { g0[e] = silu(g0[e] * rs) * (u0[e] * rs); g1[e] = silu(g1[e] * rs) * (u1[e] * rs); }
                    *(bf16x8*)(hid + (size_t)row * FFS_ + (C / 2) * cb + 16 * ps + 8 * q) = pack8(g0, g1);
                }
            }
            __syncthreads();
        }
    }
}

constexpr int HA_QS = 0, HA_KS = 16 * 272, HA_KE = 2 * 16 * 272, HA_DEC = HA_KE + 128 * 32, HA_BUF = HA_DEC + 512;
DI void hgrn_passA(LAS unsigned char* lds, const bf16* ZQ, const bf16* ZK, const bf16* ZV, const float* LF, bf16* QG, float* OL, float* DS, float* DSC, int bid, int G, int tid) {
    const int wave = __builtin_amdgcn_readfirstlane(tid >> 6), lane = tid & 63, g = lane >> 4, lr = lane & 15;
    for (int u = bid; u < 256; u += G) {
        const int h = u >> 4, sc = u & 15, t0 = sc * 512, col = h * 128 + 16 * wave + lr;
        float gbase = 0.f;
        f32x4 S[8];
#pragma unroll
        for (int j = 0; j < 8; ++j) S[j] = (f32x4){0.f, 0.f, 0.f, 0.f};
        unsigned short aq[4], ak[4], av[4], bq[4], bk[4], bv[4]; float al[4], bl[4];
#define HA_FETCH(q_, k_, v_, l_, cc) do { _Pragma("unroll") for (int j = 0; j < 4; ++j) { const size_t o_ = (size_t)(t0 + 16 * (cc) + 4 * g + j) * D + col; q_[j] = ZQ[o_]; k_[j] = ZK[o_]; v_[j] = ZV[o_]; l_[j] = LF[o_]; } } while (0)
        HA_FETCH(aq, ak, av, al, 0); HA_FETCH(bq, bk, bv, bl, 1);
#pragma unroll 2
        for (int c = 0; c < 32; ++c) {
            LAS unsigned char* B = lds + (c & 1) * HA_BUF;
            float q[4], k[4], lfv[4]; unsigned short vv[4];
            if ((c & 1) == 0) {
#pragma unroll
                for (int j = 0; j < 4; ++j) { q[j] = bf2f(aq[j]); k[j] = bf2f(ak[j]); lfv[j] = al[j]; vv[j] = av[j]; }
                if (c + 2 < 32) HA_FETCH(aq, ak, av, al, c + 2);
            } else {
#pragma unroll
                for (int j = 0; j < 4; ++j) { q[j] = bf2f(bq[j]); k[j] = bf2f(bk[j]); lfv[j] = bl[j]; vv[j] = bv[j]; }
                if (c + 2 < 32) HA_FETCH(bq, bk, bv, bl, c + 2);
            }
            float cs[4]; cs[0] = lfv[0]; cs[1] = cs[0] + lfv[1]; cs[2] = cs[1] + lfv[2]; cs[3] = cs[2] + lfv[3];
            const float t1 = __shfl(cs[3], (lane + 48) & 63), t2 = __shfl(cs[3], (lane + 32) & 63), t3 = __shfl(cs[3], (lane + 16) & 63);
            const float pre = (g >= 1 ? t1 : 0.f) + (g >= 2 ? t2 : 0.f) + (g >= 3 ? t3 : 0.f);
            const float gend = __shfl(pre + cs[3], lr + 48);
            float ke[4];
#pragma unroll
            for (int j = 0; j < 4; ++j) {
                const float G_ = pre + cs[j], eg = __expf(G_), qs = q[j] * eg;
                const int t = 4 * g + j;
                *(LAS unsigned short*)(B + HA_QS + t * 272 + 2 * (16 * wave + lr)) = (unsigned short)(pk2(qs, 0.f) & 0xffffu);
                *(LAS unsigned short*)(B + HA_KS + t * 272 + 2 * (16 * wave + lr)) = (unsigned short)(pk2(k[j] * __expf(-G_), 0.f) & 0xffffu);
                ke[j] = k[j] * __expf(gend - G_);
                QG[(size_t)(t0 + 16 * c + t) * D + col] = (unsigned short)(pk2(qs * __expf(gbase), 0.f) & 0xffffu);
            }
            { v2u w; w.x = pk2(ke[0], ke[1]); w.y = pk2(ke[2], ke[3]); *(LAS v2u*)(B + HA_KE + (16 * wave + lr) * 32 + 8 * g) = w; }
            if (g == 0) *(LAS float*)(B + HA_DEC + 4 * (16 * wave + lr)) = __expf(gend);
            gbase += gend;
            LDS_WAIT(); __builtin_amdgcn_s_barrier(); asm volatile("" ::: "memory");
            bf16x8 vreg; { v4u w; w.x = (unsigned)vv[0] | ((unsigned)vv[1] << 16); w.y = (unsigned)vv[2] | ((unsigned)vv[3] << 16); w.z = 0u; w.w = 0u; vreg = __builtin_bit_cast(bf16x8, w); }
            f32x4 am = (f32x4){0.f, 0.f, 0.f, 0.f};
#pragma unroll
            for (int s = 0; s < 4; ++s) { const bf16x8 fa = *(const LAS bf16x8*)(B + HA_KS + lr * 272 + 64 * s + 16 * g), fb = *(const LAS bf16x8*)(B + HA_QS + lr * 272 + 64 * s + 16 * g); am = MFMA16(fa, fb, am); }
#pragma unroll
            for (int i = 0; i < 4; ++i) am[i] = (4 * g + i <= lr) ? am[i] : 0.f;
            bf16x8 afrag; { v4u w; w.x = pk2(am[0], am[1]); w.y = pk2(am[2], am[3]); w.z = 0u; w.w = 0u; afrag = __builtin_bit_cast(bf16x8, w); }
            f32x4 o = MFMA16(afrag, vreg, ((f32x4){0.f, 0.f, 0.f, 0.f}));
#pragma unroll
            for (int s = 0; s < 4; ++s) {
                const v2u lo = *(const LAS v2u*)(B + HA_QS + lr * 272 + 2 * (32 * s + 4 * g)), hi = *(const LAS v2u*)(B + HA_QS + lr * 272 + 2 * (32 * s + 16 + 4 * g));
                v4u w; w.x = lo.x; w.y = lo.y; w.z = hi.x; w.w = hi.y;
                o = MFMA16(__builtin_bit_cast(bf16x8, w), pack8(S[2 * s], S[2 * s + 1]), o);
            }
            *(f32x4*)(OL + ((((size_t)(h * 16 + sc) * 32 + c) * 8 + wave) * 64 + lane) * 4) = o;
#pragma unroll
            for (int j = 0; j < 8; ++j) {
                const f32x4 dj = *(const LAS f32x4*)(B + HA_DEC + 4 * (16 * j + 4 * g));
                const v2u kf = *(const LAS v2u*)(B + HA_KE + (16 * j + lr) * 32 + 8 * g);
                v4u w; w.x = kf.x; w.y = kf.y; w.z = 0u; w.w = 0u;
                S[j] = MFMA16(__builtin_bit_cast(bf16x8, w), vreg, S[j] * dj);
            }
        }
#undef HA_FETCH
#pragma unroll
        for (int j = 0; j < 8; ++j)
#pragma unroll
            for (int i = 0; i < 4; ++i) DS[((size_t)(h * 16 + sc) * 128 + 16 * j + 4 * g + i) * 128 + 16 * wave + lr] = S[j][i];
        if (g == 0) DSC[(h * 16 + sc) * 128 + 16 * wave + lr] = __expf(gbase);
        LDS_WAIT(); __builtin_amdgcn_s_barrier(); asm volatile("" ::: "memory");
    }
}

constexpr int HC_SINT = 0, HC_STG = 128 * 272  , HC_STG_W = 16 * 528;
DI void hgrn_passC(LAS unsigned char* lds, const bf16* QG, const float* OL, const float* DS, const float* DSC, const bf16* ZG, const float* gnorm, bf16* OG, float* state_out, int bid, int G, int tid) {
    const int wave = __builtin_amdgcn_readfirstlane(tid >> 6), lane = tid & 63, g = lane >> 4, lr = lane & 15;
    for (int u = bid; u < 256; u += G) {
        const int h = u >> 4, sc = u & 15, t0 = sc * 512, cb = h * 128;
        f32x4 S[8];
#pragma unroll
        for (int j = 0; j < 8; ++j) S[j] = (f32x4){0.f, 0.f, 0.f, 0.f};
        const int nprev = (sc == 15) ? 16 : sc;
        for (int p = 0; p < nprev; ++p) {
#pragma unroll
            for (int j = 0; j < 8; ++j) {
                const f32x4 d = *(const f32x4*)(DSC + (h * 16 + p) * 128 + 16 * j + 4 * g);
#pragma unroll
                for (int i = 0; i < 4; ++i) S[j][i] = S[j][i] * d[i] + DS[((size_t)(h * 16 + p) * 128 + 16 * j + 4 * g + i) * 128 + 16 * wave + lr];
            }
            if (p == 14 && sc == 15) {
#pragma unroll
                for (int j = 0; j < 8; ++j) { v2u w; w.x = pk2(S[j][0], S[j][1]); w.y = pk2(S[j][2], S[j][3]); *(LAS v2u*)(lds + HC_SINT + (16 * wave + lr) * 272 + 2 * (16 * j + 4 * g)) = w; }
            }
        }
        if (sc == 15) {
#pragma unroll
            for (int j = 0; j < 8; ++j)
#pragma unroll
                for (int i = 0; i < 4; ++i) state_out[((size_t)h * 128 + 16 * j + 4 * g + i) * 128 + 16 * wave + lr] = S[j][i];
        } else {
#pragma unroll
            for (int j = 0; j < 8; ++j) { v2u w; w.x = pk2(S[j][0], S[j][1]); w.y = pk2(S[j][2], S[j][3]); *(LAS v2u*)(lds + HC_SINT + (16 * wave + lr) * 272 + 2 * (16 * j + 4 * g)) = w; }
        }
        LDS_WAIT(); __builtin_amdgcn_s_barrier(); asm volatile("" ::: "memory");
        LAS float* stg = (LAS float*)(lds + HC_STG + wave * HC_STG_W);
        for (int c = wave; c < 32; c += 8) {
            bf16x8 a[4];
#pragma unroll
            for (int s = 0; s < 4; ++s) a[s] = *(const bf16x8*)(QG + (size_t)(t0 + 16 * c + lr) * D + cb + 32 * s + 8 * g);
            f32x4 o[8]; float ssq[4] = {0.f, 0.f, 0.f, 0.f};
#pragma unroll
            for (int vt = 0; vt < 8; ++vt) {
                f32x4 acc = *(const f32x4*)(OL + ((((size_t)(h * 16 + sc) * 32 + c) * 8 + vt) * 64 + lane) * 4);
#pragma unroll
                for (int s = 0; s < 4; ++s) acc = MFMA16(a[s], *(const LAS bf16x8*)(lds + HC_SINT + (16 * vt + lr) * 272 + 64 * s + 16 * g), acc);
                o[vt] = acc;
#pragma unroll
                for (int i = 0; i < 4; ++i) ssq[i] += acc[i] * acc[i];
            }
            float rs[4];
#pragma unroll
            for (int i = 0; i < 4; ++i) rs[i] = rsqrtf(grp16_sum(ssq[i]) * (1.f / 128.f) + EPS);
#pragma unroll
            for (int vt = 0; vt < 8; ++vt) { const float gn = gnorm[16 * vt + lr];
#pragma unroll
                for (int i = 0; i < 4; ++i) stg[(4 * g + i) * 132 + 16 * vt + lr] = o[vt][i] * rs[i] * gn; }
            LDS_WAIT(); asm volatile("" ::: "memory");
#pragma unroll
            for (int it = 0; it < 4; ++it) {
                const int ci = lane + 64 * it, r = ci >> 4, ch = ci & 15; const size_t go = (size_t)(t0 + 16 * c + r) * D + cb + 8 * ch;
                const f32x4 x0 = *(const LAS f32x4*)(stg + r * 132 + 8 * ch), x1 = *(const LAS f32x4*)(stg + r * 132 + 8 * ch + 4);
                const v4u gt = *(const v4u*)(ZG + go);
                f32x4 y0, y1; y0[0] = x0[0] * bf2f(gt.x & 0xffffu); y0[1] = x0[1] * bf2f(gt.x >> 16); y0[2] = x0[2] * bf2f(gt.y & 0xffffu); y0[3] = x0[3] * bf2f(gt.y >> 16);
                y1[0] = x1[0] * bf2f(gt.z & 0xffffu); y1[1] = x1[1] * bf2f(gt.z >> 16); y1[2] = x1[2] * bf2f(gt.w & 0xffffu); y1[3] = x1[3] * bf2f(gt.w >> 16);
                *(bf16x8*)(OG + go) = pack8(y0, y1);
            }
            LDS_WAIT(); asm volatile("" ::: "memory");
        }
        LDS_WAIT(); __builtin_amdgcn_s_barrier(); asm volatile("" ::: "memory");
    }
}

DI void hgrn_sample(LAS float* wsc, const float* RS1, const float* LB0, const float* st_in, float* st_out, const float* gnorm, bf16* OGS, int b, int h, int lane) {
    { const float* r = RS1 + (size_t)b * NA + h * 128 + 2 * lane;
      const f32x2 qr = *(const f32x2*)r, fr_ = *(const f32x2*)(r + 2048), lb = *(const f32x2*)(LB0 + h * 128 + 2 * lane);
#pragma unroll
      for (int e = 0; e < 2; ++e) { const float f = fminf(fmaxf(fr_[e], -30.f), 30.f), ef = __expf(-f), sg = 1.f / (1.f + ef), sgn = ef / (1.f + ef);
          wsc[2 * lane + e] = lb[e] + (1.f - lb[e]) * sg; wsc[128 + 2 * lane + e] = (1.f - lb[e]) * sgn; wsc[256 + 2 * lane + e] = silu(qr[e]); } }
    LDS_WAIT(); asm volatile("" ::: "memory");
    const int half = lane >> 5, c4 = lane & 31;
    const f32x4 iv = *(const f32x4*)(RS1 + (size_t)b * NA + 4096 + h * 128 + 4 * c4), gr = *(const f32x4*)(RS1 + (size_t)b * NA + 6144 + h * 128 + 4 * c4);
    const float* S0 = st_in + ((size_t)(b * 16 + h) * 128 + half) * 128 + 4 * c4; float* So = st_out + ((size_t)(b * 16 + h) * 128 + half) * 128 + 4 * c4;
    f32x4 o = (f32x4){0.f, 0.f, 0.f, 0.f};
    f32x4 ra[8], rb[8];
#define HS_LOAD(r_, bt) do { _Pragma("unroll") for (int i_ = 0; i_ < 8; ++i_) r_[i_] = __builtin_nontemporal_load((const f32x4*)(S0 + (size_t)(2 * (8 * (bt) + i_)) * 128)); } while (0)
#define HS_STEP(r_, bt) do { _Pragma("unroll") for (int i_ = 0; i_ < 8; ++i_) { const int k_ = 2 * (8 * (bt) + i_) + half; const float fg = wsc[k_], kk = wsc[128 + k_], qk = wsc[256 + k_]; \
        const f32x4 sn = r_[i_] * fg + iv * kk; o += sn * qk; __builtin_nontemporal_store(sn, (f32x4*)(So + (size_t)(2 * (8 * (bt) + i_)) * 128)); } } while (0)
    HS_LOAD(ra, 0);
#pragma unroll 1
    for (int bt = 0; bt < 8; bt += 2) {
        HS_LOAD(rb, bt + 1);
        __builtin_amdgcn_sched_barrier(0);
        HS_STEP(ra, bt);
        __builtin_amdgcn_sched_barrier(0);
        if (bt + 2 < 8) HS_LOAD(ra, bt + 2);
        __builtin_amdgcn_sched_barrier(0);
        HS_STEP(rb, bt + 1);
        __builtin_amdgcn_sched_barrier(0);
    }
#undef HS_LOAD
#undef HS_STEP
#pragma unroll
    for (int e = 0; e < 4; ++e) o[e] += __shfl_xor(o[e], 32);
    float ss = (o[0] * o[0] + o[1] * o[1]) + (o[2] * o[2] + o[3] * o[3]);
#pragma unroll
    for (int x = 1; x < 32; x <<= 1) ss += __shfl_xor(ss, x);
    const float rs = rsqrtf(ss * (1.f / 128.f) + EPS);
    const f32x4 gn = *(const f32x4*)(gnorm + 4 * c4);
    if (half == 0) { v2u w; w.x = pk2(o[0] * rs * gn[0] * silu(gr[0]), o[1] * rs * gn[1] * silu(gr[1])); w.y = pk2(o[2] * rs * gn[2] * silu(gr[2]), o[3] * rs * gn[3] * silu(gr[3]));
        *(v2u*)(OGS + (size_t)b * DS_ + h * 128 + 4 * c4) = w; }
    LDS_WAIT(); asm volatile("" ::: "memory");
}

DI unsigned pk4_fp8(float a, float b, float c, float d) { int p = __builtin_amdgcn_cvt_pk_fp8_f32(a, b, 0, false); p = __builtin_amdgcn_cvt_pk_fp8_f32(c, d, p, true); return (unsigned)p; }
DI void dsa_post_row(const float* KRAW, const float* KIRAW, const float* knorm, const float* kinorm, float* kout, float* kiout, bf16* KB, bf16* KIB, const bf16* VB, unsigned char* K8, unsigned char* V8, int t, int lane) {
    { const float* p = KRAW + (size_t)t * 512 + 8 * lane; f32x4 a = *(const f32x4*)p, b = *(const f32x4*)(p + 4);
      const float rs = rsqrtf(grp16_sum((a.x * a.x + a.y * a.y) + (a.z * a.z + a.w * a.w) + (b.x * b.x + b.y * b.y) + (b.z * b.z + b.w * b.w)) * (1.f / 128.f) + EPS);
      const float* gp = knorm + ((8 * lane) & 127); const f32x4 g0 = *(const f32x4*)gp, g1 = *(const f32x4*)(gp + 4);
      a = a * rs * g0; b = b * rs * g1; float* o = kout + (size_t)t * 512 + 8 * lane; __builtin_nontemporal_store(a, (f32x4*)o); __builtin_nontemporal_store(b, (f32x4*)(o + 4)); *(bf16x8*)(KB + (size_t)t * 512 + 8 * lane) = pack8(a, b);
      *(v2u*)(K8 + (size_t)t * 512 + 8 * lane) = (v2u){pk4_fp8(a[0], a[1], a[2], a[3]), pk4_fp8(b[0], b[1], b[2], b[3])};
      const v4u vw = *(const v4u*)(VB + (size_t)t * 512 + 8 * lane);
      *(v2u*)(V8 + (size_t)t * 512 + 8 * lane) = (v2u){pk4_fp8(bf2f(vw.x & 0xffffu), bf2f(vw.x >> 16), bf2f(vw.y & 0xffffu), bf2f(vw.y >> 16)), pk4_fp8(bf2f(vw.z & 0xffffu), bf2f(vw.z >> 16), bf2f(vw.w & 0xffffu), bf2f(vw.w >> 16))}; }
    { const f32x2 a = *(const f32x2*)(KIRAW + (size_t)t * 128 + 2 * lane); const float rs = rsqrtf(wave_sum(a.x * a.x + a.y * a.y) * (1.f / 128.f) + EPS);
      const f32x2 gk = *(const f32x2*)(kinorm + 2 * lane); const float x = a.x * rs * gk.x, y = a.y * rs * gk.y;
      *(f32x2*)(kiout + (size_t)t * 128 + 2 * lane) = (f32x2){x, y}; *(unsigned*)(KIB + (size_t)t * 128 + 2 * lane) = pk2(x, y); }
}
DI void dsa_sample_prep(const float* R5S, const float* qnorm, const float* knorm, const float* kinorm, bf16* QNS, float* kout, float* vout, float* kiout, int b, int lane) {
    const float* r = R5S + (size_t)b * NB;
#pragma unroll
    for (int it = 0; it < 4; ++it) {
        const int c = it * 512 + 8 * lane; f32x4 a = *(const f32x4*)(r + c), bb = *(const f32x4*)(r + c + 4);
        const float rs = rsqrtf(grp16_sum((a.x * a.x + a.y * a.y) + (a.z * a.z + a.w * a.w) + (bb.x * bb.x + bb.y * bb.y) + (bb.z * bb.z + bb.w * bb.w)) * (1.f / 128.f) + EPS) * 0.08838834764831845f;
        const float* gp = qnorm + (c & 127); a = a * rs * *(const f32x4*)gp; bb = bb * rs * *(const f32x4*)(gp + 4);
        *(bf16x8*)(QNS + (size_t)b * D + c) = pack8(a, bb);
    }
    { const int c = 8 * lane; f32x4 a = *(const f32x4*)(r + 2048 + c), bb = *(const f32x4*)(r + 2048 + c + 4);
      const float rs = rsqrtf(grp16_sum((a.x * a.x + a.y * a.y) + (a.z * a.z + a.w * a.w) + (bb.x * bb.x + bb.y * bb.y) + (bb.z * bb.z + bb.w * bb.w)) * (1.f / 128.f) + EPS);
      const float* gp = knorm + (c & 127); a = a * rs * *(const f32x4*)gp; bb = bb * rs * *(const f32x4*)(gp + 4);
      float* o = kout + (size_t)b * 512 + c; *(f32x4*)o = a; *(f32x4*)(o + 4) = bb;
      float* ov = vout + (size_t)b * 512 + c; *(f32x4*)ov = *(const f32x4*)(r + 2560 + c); *(f32x4*)(ov + 4) = *(const f32x4*)(r + 2560 + c + 4); }
    { const f32x2 a = *(const f32x2*)(r + 5120 + 2 * lane); const float rs = rsqrtf(wave_sum(a.x * a.x + a.y * a.y) * (1.f / 128.f) + EPS);
      const f32x2 gk = *(const f32x2*)(kinorm + 2 * lane); *(f32x2*)(kiout + (size_t)b * 128 + 2 * lane) = (f32x2){a.x * rs * gk.x, a.y * rs * gk.y}; }
}

constexpr int IX_W = 0, IX_ST0 = 4096, IX_STB = 128 * 272;
__device__ const int IXTAB[257] = {0, 15, 30, 46, 62, 78, 94, 110, 126, 142, 158, 174, 190, 206, 222, 238, 254, 270, 286, 302, 318, 334, 350, 366, 382, 399, 415, 431, 447, 463, 480, 496, 512, 529, 546, 562, 578, 595, 611, 627, 644, 660, 676, 693, 709, 726, 742, 758, 775, 791, 808, 824, 841, 858, 874, 891, 907, 924, 940, 957, 973, 990, 1006, 1023, 1039, 1056, 1073, 1089, 1106, 1122, 1139, 1156, 1173, 1190, 1207, 1224, 1240, 1257, 1273, 1290, 1306, 1323, 1339, 1356, 1372, 1389, 1406, 1423, 1440, 1456, 1473, 1489, 1506, 1522, 1539, 1556, 1572, 1589, 1605, 1622, 1639, 1655, 1672, 1688, 1705, 1722, 1739, 1756, 1772, 1789, 1806, 1823, 1840, 1856, 1873, 1890, 1906, 1923, 1939, 1956, 1973, 1989, 2006, 2023, 2039, 2056, 2072, 2089, 2106, 2122, 2139, 2156, 2172, 2189, 2206, 2222, 2239, 2256, 2273, 2290, 2306, 2323, 2340, 2356, 2373, 2390, 2406, 2423, 2440, 2456, 2473, 2490, 2506, 2523, 2540, 2556, 2573, 2590, 2606, 2623, 2640, 2656, 2673, 2690, 2706, 2723, 2740, 2756, 2773, 2790, 2807, 2823, 2840, 2857, 2873, 2890, 2907, 2923, 2940, 2957, 2973, 2990, 3007, 3024, 3040, 3057, 3074, 3090, 3107, 3124, 3140, 3157, 3174, 3191, 3207, 3224, 3241, 3257, 3274, 3291, 3307, 3324, 3341, 3358, 3374, 3391, 3408, 3424, 3441, 3458, 3475, 3491, 3508, 3525, 3541, 3558, 3575, 3592, 3608, 3625, 3642, 3659, 3675, 3692, 3709, 3725, 3742, 3759, 3776, 3792, 3809, 3826, 3843, 3859, 3876, 3893, 3909, 3926, 3943, 3960, 3976, 3993, 4010, 4027, 4043, 4060, 4077, 4094, 4110, 4127, 4144, 4160, 4160, 4160, 4160, 4160, 4160};
DI void indexer_prompt(LAS unsigned char* lds, const bf16* QIB, const bf16* KIB, const float* WI, float* SC, int bid, int G, int tid_) {
    const int wave = __builtin_amdgcn_readfirstlane(tid_ >> 6);
    constexpr int NITEMS = 4160, IX_W2 = IX_ST0 + 2 * IX_STB;
    const int per = NITEMS / G, extra = NITEMS % G;
    int lo = bid * per + (bid < extra ? bid : extra), hi = lo + per + (bid < extra ? 1 : 0);
    if (G == 256) { lo = IXTAB[bid]; hi = IXTAB[bid + 1]; }
    int p = 0; while ((p + 1) * (p + 2) <= lo) ++p;
    int qb = 2 * p, s = lo - p * (p + 1); if (s > p) { qb += 1; s -= p + 1; }
    int wsel = 0; bool newq = true;
    if (lo < hi) {
        int tid = tid_; asm volatile("" : "+v"(tid));
        *(LAS f32x2*)(lds + IX_W + 8 * tid) = *(const f32x2*)(WI + (size_t)(64 * qb) * 16 + 2 * tid);
        v4u st[4];
#pragma unroll
        for (int it = 0; it < 4; ++it) { const int ci = tid + 512 * it, row = ci >> 4, ch = ci & 15; st[it] = *(const v4u*)(KIB + (size_t)(128 * s + row) * 128 + 8 * ch); }
#pragma unroll
        for (int it = 0; it < 4; ++it) { const int ci = tid + 512 * it, row = ci >> 4, ch = ci & 15; *(LAS v4u*)(lds + IX_ST0 + row * 272 + 16 * ch) = st[it]; }
    }
    __syncthreads();
    bf16x8 af[4][8];
    for (int item = lo; item < hi; ++item) {
        int tid = tid_; asm volatile("" : "+v"(tid));
        const int lane = tid & 63, hh = lane >> 5, m = lane & 31;
        const int q0 = 64 * qb, k0s = 128 * s;
        if (newq) {
#pragma unroll
            for (int a = 0; a < 4; ++a) { const int qq = q0 + 8 * wave + 2 * a + ((m >> 2) & 1), hd = 4 * (m >> 3) + (m & 3);
#pragma unroll
                for (int s_ = 0; s_ < 8; ++s_) af[a][s_] = *(const bf16x8*)(QIB + (size_t)qq * D + hd * 128 + 16 * s_ + 8 * hh); }
        }
        int nqb = qb, ns = s + 1; if (ns > (qb >> 1)) { nqb = qb + 1; ns = 0; }
        const bool more = item + 1 < hi;
        v4u st[2];
        LAS unsigned char* NBUF = lds + IX_ST0 + (((item - lo) & 1) ^ 1) * IX_STB;
#define IX_PF_LOAD(h_) do { if (more) { _Pragma("unroll") for (int it = 0; it < 2; ++it) { const int ci = tid + 512 * (2 * (h_) + it), row = ci >> 4, ch = ci & 15; st[it] = *(const v4u*)(KIB + (size_t)(128 * ns + row) * 128 + 8 * ch); } } } while (0)
#define IX_PF_STORE(h_) do { if (more) { _Pragma("unroll") for (int it = 0; it < 2; ++it) { const int ci = tid + 512 * (2 * (h_) + it), row = ci >> 4, ch = ci & 15; *(LAS v4u*)(NBUF + row * 272 + 16 * ch) = st[it]; } } } while (0)
        IX_PF_LOAD(0);
        f32x2 wn = (f32x2){0.f, 0.f};
        if (more && nqb != qb) wn = *(const f32x2*)(WI + (size_t)(64 * nqb) * 16 + 2 * tid);
        const int qlast_w = q0 + 8 * wave + 7;
        const int par = (item - lo) & 1;
        LAS unsigned char* SB = lds + IX_ST0 + par * IX_STB;
        LAS unsigned char* WBUF = lds + (wsel ? IX_W2 : IX_W);
#pragma unroll
        for (int bt = 0; bt < 4; ++bt) {
            const int key0 = k0s + 32 * bt;
            if (bt == 2) { IX_PF_STORE(0); IX_PF_LOAD(1); }
            if (key0 <= qlast_w) {
            bf16x8 bfr[8];
#pragma unroll
            for (int s_ = 0; s_ < 8; ++s_) bfr[s_] = *(const LAS bf16x8*)(SB + (32 * bt + m) * 272 + 32 * s_ + 16 * hh);
            f32x16 accA;
#define IX_CHAIN(acc_, a_) do { _Pragma("unroll") for (int i_ = 0; i_ < 16; ++i_) acc_[i_] = 0.f; __builtin_amdgcn_s_setprio(1); _Pragma("unroll") for (int s_ = 0; s_ < 8; ++s_) acc_ = MFMA32(af[a_][s_], bfr[s_], acc_); __builtin_amdgcn_s_setprio(0); } while (0)
#define IX_EPI(acc_, a_) do { const LAS f32x4* wp = (const LAS f32x4*)(WBUF + 64 * (8 * wave + 2 * (a_) + hh)); float s2[2] = {0.f, 0.f}; \
                const float big = __builtin_bit_cast(float, __builtin_amdgcn_readfirstlane(0x7f7fffff)); \
                _Pragma("unroll") for (int i4 = 0; i4 < 4; ++i4) { const f32x4 w4 = wp[i4]; _Pragma("unroll") for (int e = 0; e < 4; ++e) s2[e & 1] += w4[e] * __builtin_amdgcn_fmed3f(acc_[4 * i4 + e], 0.f, big); } \
                SC[(size_t)(q0 + 8 * wave + 2 * (a_) + hh) * T + key0 + m] = s2[0] + s2[1]; } while (0)
            IX_CHAIN(accA, 0); IX_EPI(accA, 0);
            IX_CHAIN(accA, 1); IX_EPI(accA, 1);
            IX_CHAIN(accA, 2); IX_EPI(accA, 2);
            IX_CHAIN(accA, 3); IX_EPI(accA, 3);
#undef IX_CHAIN
#undef IX_EPI
            }
        }
        IX_PF_STORE(1);
#undef IX_PF_LOAD
#undef IX_PF_STORE
        if (more) {
            if (nqb != qb) *(LAS f32x2*)(lds + (wsel ? IX_W : IX_W2) + 8 * tid) = wn;
        }
        __syncthreads();
        newq = nqb != qb; if (newq) wsel ^= 1;
        qb = nqb; s = ns;
    }
}

DI unsigned mono_key(float v) { const unsigned u = __float_as_uint(v); return (u & 0x80000000u) ? ~u : (u | 0x80000000u); }
DI int wave_sum_i(int v) {
#pragma unroll
    for (int o = 1; o < 64; o <<= 1) v += __shfl_xor(v, o);
    return v;
}
template <int NPL>
DI void topk_row(const float* sc, int n, int* idx_out, int lane_) {
    int lane = lane_; asm volatile("" : "+v"(lane));
    unsigned key[NPL];
    { const float* p = sc + lane;
#pragma unroll
    for (int j = 0; j < NPL; ++j) key[j] = __float_as_uint(p[64 * j]);
#pragma unroll
    for (int j = 0; j + 8 <= NPL; j += 8) asm volatile("" : "+v"(key[j]), "+v"(key[j + 1]), "+v"(key[j + 2]), "+v"(key[j + 3]), "+v"(key[j + 4]), "+v"(key[j + 5]), "+v"(key[j + 6]), "+v"(key[j + 7]));
#pragma unroll
    for (int j = NPL & ~7; j < NPL; ++j) asm volatile("" : "+v"(key[j]));
    const int ns = __builtin_amdgcn_readfirstlane(n);
#pragma unroll
    for (int j = 0; j < NPL; ++j) key[j] = (lane < ns - 64 * j) ? mono_key(__uint_as_float(key[j])) : 0u; }
    unsigned Tk = 0u;
#pragma unroll 1
    for (int bit = 31; bit >= 0; --bit) {
        const unsigned cand = __builtin_amdgcn_readfirstlane(Tk | (1u << bit)); int cnt = 0;
#pragma unroll
        for (int j = 0; j < NPL; ++j) asm volatile("v_cmp_le_u32 vcc, %2, %1\n\tv_addc_co_u32 %0, vcc, 0, %0, vcc" : "+v"(cnt) : "v"(key[j]), "s"(cand) : "vcc");
        cnt = wave_sum_i(cnt);
        if (cnt >= TOPK) Tk = cand;
    }
    int cgt = 0;
    { const unsigned tks = __builtin_amdgcn_readfirstlane(Tk);
#pragma unroll
    for (int j = 0; j < NPL; ++j) asm volatile("v_cmp_lt_u32 vcc, %2, %1\n\tv_addc_co_u32 %0, vcc, 0, %0, vcc" : "+v"(cgt) : "v"(key[j]), "s"(tks) : "vcc"); }
    cgt = wave_sum_i(cgt);
    const int need_eq = TOPK - cgt; int base = 0, eqb = 0;
    int lane2 = lane_; asm volatile("" : "+v"(lane2));
    const unsigned long long below = (1ull << lane2) - 1ull;
#pragma unroll
    for (int j = 0; j < NPL; ++j) {
        const bool ge = key[j] >= Tk;
        if (__ballot(ge) != 0ull) {
            const bool gt = key[j] > Tk, eq = key[j] == Tk;
            const unsigned long long mg = __ballot(gt), me = __ballot(eq);
            if (gt) idx_out[base + __builtin_popcountll(mg & below)] = lane2 + 64 * j;
            const int re = eqb + __builtin_popcountll(me & below);
            if (eq && re < need_eq) idx_out[cgt + re] = lane2 + 64 * j;
            base += __builtin_popcountll(mg); eqb += __builtin_popcountll(me);
        }
        __builtin_amdgcn_sched_barrier(0);
    }
}
constexpr int TK_CAP = 1024, TK_CPL = TK_CAP / 64;
template <int NPL>
DI void topk_row2(const float* sc, int n, int* idx_out, LAS unsigned* cbuf  , int lane_) {
    int lane = lane_; asm volatile("" : "+v"(lane));
    unsigned key[NPL];
    { const float* p = sc + lane;
#pragma unroll
    for (int j = 0; j < NPL; ++j) key[j] = __float_as_uint(p[64 * j]);
#pragma unroll
    for (int j = 0; j + 8 <= NPL; j += 8) asm volatile("" : "+v"(key[j]), "+v"(key[j + 1]), "+v"(key[j + 2]), "+v"(key[j + 3]), "+v"(key[j + 4]), "+v"(key[j + 5]), "+v"(key[j + 6]), "+v"(key[j + 7]));
#pragma unroll
    for (int j = NPL & ~7; j < NPL; ++j) asm volatile("" : "+v"(key[j]));
    const int ns = __builtin_amdgcn_readfirstlane(n);
#pragma unroll
    for (int j = 0; j < NPL; ++j) key[j] = (lane < ns - 64 * j) ? mono_key(__uint_as_float(key[j])) : 0u; }
    unsigned a0 = 0u, a1 = 0u, a2 = 0u, a3 = 0u;
#pragma unroll
    for (int j = 0; j < NPL; ++j) { unsigned x = key[j]; const unsigned n0 = a0 > x ? a0 : x; x = a0 < x ? a0 : x; a0 = n0; const unsigned n1 = a1 > x ? a1 : x; x = a1 < x ? a1 : x; a1 = n1;
        const unsigned n2 = a2 > x ? a2 : x; x = a2 < x ? a2 : x; a2 = n2; a3 = a3 > x ? a3 : x; }
    unsigned t0 = a3;
#pragma unroll
    for (int o = 1; o < 64; o <<= 1) { const unsigned y = (unsigned)__shfl_xor((int)t0, o); t0 = y < t0 ? y : t0; }
    const unsigned T0 = __builtin_amdgcn_readfirstlane(t0);
    int base = 0;
    int lane2 = lane_; asm volatile("" : "+v"(lane2));
    const unsigned long long below = (1ull << lane2) - 1ull;
#pragma unroll
    for (int j = 0; j < NPL; ++j) {
        const bool c = key[j] >= T0; const unsigned long long mk = __ballot(c);
        if (mk != 0ull) { const int pos = base + __builtin_popcountll(mk & below); if (c && pos < TK_CAP) { cbuf[pos] = key[j]; cbuf[TK_CAP + pos] = (unsigned)(lane2 + 64 * j); } base += __builtin_popcountll(mk); }
        __builtin_amdgcn_sched_barrier(0);
    }
    const int ncand = __builtin_amdgcn_readfirstlane(base);
    if (ncand > TK_CAP) { topk_row<NPL>(sc, n, idx_out, lane_); return; }
    LDS_WAIT(); asm volatile("" ::: "memory");
    unsigned ck[TK_CPL], ci[TK_CPL];
#pragma unroll
    for (int c = 0; c < TK_CPL; ++c) { const int q = lane2 + 64 * c; const bool v = q < ncand; ck[c] = v ? cbuf[q] : 0u; ci[c] = v ? cbuf[TK_CAP + q] : 0u; }
    unsigned Tk = 0u;
#pragma unroll 1
    for (int bit = 31; bit >= 0; --bit) {
        const unsigned cand = __builtin_amdgcn_readfirstlane(Tk | (1u << bit)); int cnt = 0;
#pragma unroll
        for (int c = 0; c < TK_CPL; ++c) asm volatile("v_cmp_le_u32 vcc, %2, %1\n\tv_addc_co_u32 %0, vcc, 0, %0, vcc" : "+v"(cnt) : "v"(ck[c]), "s"(cand) : "vcc");
        cnt = wave_sum_i(cnt);
        if (cnt >= TOPK) Tk = cand;
    }
    int cgt = 0;
    { const unsigned tks = __builtin_amdgcn_readfirstlane(Tk);
#pragma unroll
    for (int c = 0; c < TK_CPL; ++c) asm volatile("v_cmp_lt_u32 vcc, %2, %1\n\tv_addc_co_u32 %0, vcc, 0, %0, vcc" : "+v"(cgt) : "v"(ck[c]), "s"(tks) : "vcc"); }
    cgt = wave_sum_i(cgt);
    const int need_eq = TOPK - cgt; int ob = 0, eqb = 0;
#pragma unroll
    for (int c = 0; c < TK_CPL; ++c) {
        const bool gt = ck[c] > Tk, eq = ck[c] == Tk && ck[c] != 0u;
        const unsigned long long mg = __ballot(gt), me = __ballot(eq);
        if (gt) idx_out[ob + __builtin_popcountll(mg & below)] = (int)ci[c];
        const int re = eqb + __builtin_popcountll(me & below);
        if (eq && re < need_eq) idx_out[cgt + re] = (int)ci[c];
        ob += __builtin_popcountll(mg); eqb += __builtin_popcountll(me);
        __builtin_amdgcn_sched_barrier(0);
    }
    LDS_WAIT(); asm volatile("" ::: "memory");
}
DI void topk_dispatch(const float* sc, int n, int* idx_out, LAS unsigned* cbuf, int lane) {
    if (n <= TOPK) { for (int i = lane; i < TOPK; i += 64) idx_out[i] = i < n ? i : 0; return; }
    if (n <= 2112) topk_row2<33>(sc, n, idx_out, cbuf, lane);
    else if (n <= 4096) topk_row2<64>(sc, n, idx_out, cbuf, lane);
    else if (n <= 6144) topk_row2<96>(sc, n, idx_out, cbuf, lane);
    else topk_row2<128>(sc, n, idx_out, cbuf, lane);
}

template <bool F32SRC, class SRC>
DI void attn_unit(LAS unsigned char* vbuf  , const LAS float* lut, const bf16x8 (&qf)[4], const int* idx, int cnt_, int qpos_, int kvh, const SRC& src, bf16* orow, int lane_) {
    constexpr int NL = F32SRC ? 8 : 4, DEPTH = F32SRC ? 2 : 4;
    int lane = lane_; asm volatile("" : "+v"(lane));
    const int cnt = __builtin_amdgcn_readfirstlane(cnt_), qpos = __builtin_amdgcn_readfirstlane(qpos_);
    const int g = lane >> 4, lr = lane & 15;
    const unsigned vb_addr = (unsigned)(size_t)vbuf;
    const unsigned q_ = (unsigned)lr >> 2, p_ = (unsigned)lr & 3u;
    const unsigned wbase = 512u * ((unsigned)lr >> 2) + 64u * (unsigned)g;
    const unsigned rbase = vb_addr + 2048u * (unsigned)g + 64u * q_ + 8u * (p_ & 1u);
    v4u ring[DEPTH][NL];
    int R[16], RP[16];
#pragma unroll
    for (int kt = 0; kt < 16; ++kt) R[kt] = idx[16 * kt + lr];
#pragma unroll
    for (int kt = 0; kt < 16; ++kt) RP[kt] = src.rowid(R[kt]);
#define AT_ISSUE_K(slot, kt) do { const char* kr_ = src.kptr(RP[kt], kvh); _Pragma("unroll") for (int s_ = 0; s_ < 4; ++s_) { \
        if (F32SRC) { ring[slot][2 * s_] = __builtin_nontemporal_load((const v4u*)(kr_ + 4 * (32 * s_ + 8 * g))); ring[slot][2 * s_ + 1] = __builtin_nontemporal_load((const v4u*)(kr_ + 4 * (32 * s_ + 8 * g) + 16)); } \
        else ring[slot][s_] = *(const v4u*)(kr_ + 2 * (32 * s_ + 8 * g)); } } while (0)
#define AT_ISSUE_V(slot, hc) do { _Pragma("unroll") for (int q2_ = 0; q2_ < 4; ++q2_) { const int rid_ = __shfl(RP[hc], 4 * q2_ + g); const char* vr_ = src.vptr(rid_, kvh); \
        if (F32SRC) { ring[slot][2 * q2_] = __builtin_nontemporal_load((const v4u*)(vr_ + 32 * lr)); ring[slot][2 * q2_ + 1] = __builtin_nontemporal_load((const v4u*)(vr_ + 32 * lr + 16)); } \
        else ring[slot][q2_] = *(const v4u*)(vr_ + 16 * lr); } } while (0)
#pragma unroll
    for (int i = 0; i < DEPTH; ++i) AT_ISSUE_K(i, i);
    f32x4 lg[16]; f32x4 o[8]; bf16x8 pf[8]; float inv = 0.f;
#pragma unroll
    for (int i = 0; i < 16; ++i) {
        asm volatile("" ::: "memory");
        const int slot = i % DEPTH;
        {
            f32x4 acc = (f32x4){0.f, 0.f, 0.f, 0.f};
#pragma unroll
            for (int s = 0; s < 4; ++s) { bf16x8 kf; if (F32SRC) kf = pack8(__builtin_bit_cast(f32x4, ring[slot][2 * s]), __builtin_bit_cast(f32x4, ring[slot][2 * s + 1])); else kf = __builtin_bit_cast(bf16x8, ring[slot][s]);
                acc = MFMA16(kf, qf[s], acc); }
#pragma unroll
            for (int e = 0; e < 4; ++e) { const int kp = __shfl(R[i], 4 * g + e), rel = qpos - kp; const bool ok = (4 * g + e < cnt - 16 * i) && rel >= 0; const int rc = rel < 0 ? 0 : (rel > 128 ? 128 : rel);
                acc[e] = ok ? acc[e] + lut[rc * 16 + 4 * kvh + (lr & 3)] : -3.0e38f; }
            lg[i] = acc;
        }
        { const int ni = i + DEPTH;
          if (ni < 16) AT_ISSUE_K(slot, ni);
          else AT_ISSUE_V(slot, ni - 16); }
    }
    {
        {
            float mx = -3.0e38f;
#pragma unroll
            for (int kt = 0; kt < 16; ++kt) mx = fmaxf(fmaxf(fmaxf(lg[kt][0], lg[kt][1]), fmaxf(lg[kt][2], lg[kt][3])), mx);
            mx = fmaxf(mx, __shfl_xor(mx, 16)); mx = fmaxf(mx, __shfl_xor(mx, 32));
            float sum = 0.f;
#pragma unroll
            for (int kt = 0; kt < 16; ++kt)
#pragma unroll
                for (int e = 0; e < 4; ++e) { const float p = lg[kt][e] > -1.0e38f ? __expf(lg[kt][e] - mx) : 0.f; lg[kt][e] = p; sum += p; }
            sum += __shfl_xor(sum, 16); sum += __shfl_xor(sum, 32);
            inv = 1.f / sum;
#pragma unroll
            for (int ks = 0; ks < 8; ++ks) pf[ks] = pack8(lg[2 * ks], lg[2 * ks + 1]);
        }
    }
#pragma unroll
    for (int dt = 0; dt < 8; ++dt) o[dt] = (f32x4){0.f, 0.f, 0.f, 0.f};
#pragma unroll
    for (int i = 16; i < 32; ++i) {
        asm volatile("" ::: "memory");
        const int slot = i % DEPTH;
        {
            const int hc = i - 16, ks = hc >> 1, par = hc & 1;
            unsigned wb = wbase; asm volatile("" : "+v"(wb));
#pragma unroll
            for (int q2 = 0; q2 < 4; ++q2) { const unsigned off = wb + (unsigned)((ks & 1) * 8192 + 2048 * q2 + 256 * par) + 16u * (((unsigned)lr & 3u) ^ (unsigned)((par + 2 * q2) & 3));
                if (F32SRC) *(LAS bf16x8*)(vbuf + off) = pack8(__builtin_bit_cast(f32x4, ring[slot][2 * q2]), __builtin_bit_cast(f32x4, ring[slot][2 * q2 + 1]));
                else *(LAS v4u*)(vbuf + off) = ring[slot][q2]; }
            if (par == 1) {
                LDS_WAIT(); asm volatile("" ::: "memory");
#pragma unroll
                for (int dt = 0; dt < 8; dt += 2) {
                    s16x4 r0, r1, r2, r3;
                    unsigned rb = rbase; asm volatile("" : "+v"(rb));
                    const unsigned kso = (unsigned)((ks & 1) * 8192 + 512 * (dt >> 1));
                    const unsigned x0 = (unsigned)(2 * g) & 3u, x1 = (unsigned)(2 * g + 1) & 3u, c0 = 2u * (unsigned)(dt & 1) + (p_ >> 1), c2 = 2u * (unsigned)((dt + 1) & 1) + (p_ >> 1);
                    const unsigned a0 = rb + kso + 16u * (c0 ^ x0), a1 = rb + kso + 256u + 16u * (c0 ^ x1);
                    const unsigned a2 = rb + (unsigned)((ks & 1) * 8192 + 512 * ((dt + 1) >> 1)) + 16u * (c2 ^ x0), a3 = rb + (unsigned)((ks & 1) * 8192 + 512 * ((dt + 1) >> 1)) + 256u + 16u * (c2 ^ x1);
                    asm volatile("ds_read_b64_tr_b16 %0, %4\n\tds_read_b64_tr_b16 %1, %5\n\tds_read_b64_tr_b16 %2, %6\n\tds_read_b64_tr_b16 %3, %7\n\ts_waitcnt lgkmcnt(0)"
                                 : "=&v"(r0), "=&v"(r1), "=&v"(r2), "=&v"(r3) : "v"(a0), "v"(a1), "v"(a2), "v"(a3) : "memory");
                    bf16x8 va, vb2;
                    va[0] = r0[0]; va[1] = r0[1]; va[2] = r0[2]; va[3] = r0[3]; va[4] = r1[0]; va[5] = r1[1]; va[6] = r1[2]; va[7] = r1[3];
                    vb2[0] = r2[0]; vb2[1] = r2[1]; vb2[2] = r2[2]; vb2[3] = r2[3]; vb2[4] = r3[0]; vb2[5] = r3[1]; vb2[6] = r3[2]; vb2[7] = r3[3];
                    o[dt] = MFMA16(va, pf[ks], o[dt]); o[dt + 1] = MFMA16(vb2, pf[ks], o[dt + 1]);
                }
            }
        }
        { const int ni = i + DEPTH;
          if (ni < 32) AT_ISSUE_V(slot, ni - 16); }
    }
    if (lr < 4) {
#pragma unroll
        for (int dt = 0; dt < 8; ++dt) { v2u w; w.x = pk2(o[dt][0] * inv, o[dt][1] * inv); w.y = pk2(o[dt][2] * inv, o[dt][3] * inv); *(v2u*)(orow + (4 * kvh + lr) * 128 + 16 * dt + 4 * g) = w; } }
#undef AT_ISSUE_K
#undef AT_ISSUE_V
}

#define A8_TR4(ADDR0, ADDR1, OFF) asm volatile("ds_read_b64_tr_b16 %0, %4 offset:" #OFF "\n\tds_read_b64_tr_b16 %1, %5 offset:" #OFF "\n\tds_read_b64_tr_b16 %2, %6 offset:" #OFF "\n\tds_read_b64_tr_b16 %3, %7 offset:" #OFF "\n\ts_waitcnt lgkmcnt(0)" \
        : "=&v"(r0), "=&v"(r1), "=&v"(r2), "=&v"(r3) : "v"(ADDR0), "v"(ADDR1), "v"(ADDR0##b), "v"(ADDR1##b) : "memory")
DI void attn_unit_f8(LAS unsigned char* vbuf  , const LAS float* lut2  , const long (&qf)[4], const int* idx, int cnt_, int qpos_, int kvh, const unsigned char* K8, const bf16* VB, bf16* orow, int lane_) {
    int lane = lane_; asm volatile("" : "+v"(lane));
    const int cnt = __builtin_amdgcn_readfirstlane(cnt_), qpos = __builtin_amdgcn_readfirstlane(qpos_);
    const int g = lane >> 4, lr = lane & 15;
    const unsigned vb_addr = (unsigned)(size_t)vbuf;
    const unsigned q_ = (unsigned)lr >> 2, p_ = (unsigned)lr & 3u;
    const unsigned rb0 = vb_addr + 2048u * (unsigned)g + 64u * q_ + 8u * (p_ & 1u);
    const unsigned x0 = (unsigned)(2 * g) & 3u, x1 = (unsigned)(2 * g + 1) & 3u;
    const unsigned te = rb0 + 16u * ((p_ >> 1) ^ x0), teb = rb0 + 256u + 16u * ((p_ >> 1) ^ x1), to = rb0 + 16u * ((2u + (p_ >> 1)) ^ x0), tob = rb0 + 256u + 16u * ((2u + (p_ >> 1)) ^ x1);
    const unsigned wb = 512u * ((unsigned)lr >> 2) + 64u * (unsigned)g;
    const unsigned wx0 = wb + 16u * (((unsigned)lr & 3u) ^ 0u), wx1 = wb + 16u * (((unsigned)lr & 3u) ^ 1u), wx2 = wb + 16u * (((unsigned)lr & 3u) ^ 2u), wx3 = wb + 16u * (((unsigned)lr & 3u) ^ 3u);
    v4u ring[16];
    int R[16];
#pragma unroll
    for (int kt = 0; kt < 16; ++kt) R[kt] = idx[16 * kt + lr];
#define A8_ISSUE_K(kt) do { const char* kr_ = (const char*)K8 + (unsigned)(R[kt] * 512 + kvh * 128 + 32 * g); ring[(2 * (kt)) & 15] = *(const v4u*)kr_; ring[(2 * (kt) + 1) & 15] = *(const v4u*)(kr_ + 16); } while (0)
#define A8_ISSUE_V(hc) do { _Pragma("unroll") for (int q2_ = 0; q2_ < 4; ++q2_) { const int rid_ = __shfl(R[hc], 4 * q2_ + g); \
        ring[(4 * (hc) + q2_) & 15] = *(const v4u*)((const char*)VB + (unsigned)(rid_ * 1024 + kvh * 256 + 16 * lr)); } } while (0)
#pragma unroll
    for (int i = 0; i < 8; ++i) A8_ISSUE_K(i);
    f32x4 lg[16]; f32x4 o[8]; bf16x8 pf[8]; float inv = 0.f;
    const int hcol = 4 * kvh + (lr & 3);
#pragma unroll
    for (int i = 0; i < 16; ++i) {
        asm volatile("" ::: "memory");
        {
            int kp4[4];
#pragma unroll
            for (int e = 0; e < 4; ++e) kp4[e] = __shfl(R[i], 4 * g + e);
            f32x4 acc = (f32x4){0.f, 0.f, 0.f, 0.f};
#pragma unroll
            for (int s = 0; s < 4; ++s) { const v4u w = ring[(2 * i + (s >> 1)) & 15]; const unsigned long long ka = (s & 1) ? ((unsigned long long)w.w << 32 | w.z) : ((unsigned long long)w.y << 32 | w.x);
                acc = __builtin_amdgcn_mfma_f32_16x16x32_fp8_fp8((long)ka, qf[s], acc, 0, 0, 0); }
            float bs[4]; bool okv[4];
#pragma unroll
            for (int e = 0; e < 4; ++e) { const int rel = qpos - kp4[e]; okv[e] = (4 * g + e < cnt - 16 * i) && rel >= 0; const int rc = rel > 128 ? 128 : (rel < 0 ? 0 : rel); bs[e] = lut2[rc * 16 + hcol]; }
            asm volatile("" : "+v"(bs[0]), "+v"(bs[1]), "+v"(bs[2]), "+v"(bs[3]));
#pragma unroll
            for (int e = 0; e < 4; ++e) acc[e] = okv[e] ? acc[e] * (0.08838834764831845f * 1.4426950408889634f) + bs[e] : -3.0e38f;
            lg[i] = acc;
        }
        if (i + 8 < 16) A8_ISSUE_K(i + 8);
        else if ((i & 1) == 1) A8_ISSUE_V((i - 9) / 2);
    }
    {
        float mx = -3.0e38f;
#pragma unroll
        for (int kt = 0; kt < 16; ++kt) mx = fmaxf(fmaxf(fmaxf(lg[kt][0], lg[kt][1]), fmaxf(lg[kt][2], lg[kt][3])), mx);
        mx = fmaxf(mx, __shfl_xor(mx, 16)); mx = fmaxf(mx, __shfl_xor(mx, 32));
        float sum = 0.f;
#pragma unroll
        for (int kt = 0; kt < 16; ++kt)
#pragma unroll
            for (int e = 0; e < 4; ++e) { const float p = __builtin_amdgcn_exp2f(lg[kt][e] - mx); lg[kt][e] = p; sum += p; }
        sum += __shfl_xor(sum, 16); sum += __shfl_xor(sum, 32);
        inv = 1.f / sum;
#pragma unroll
        for (int ks = 0; ks < 8; ++ks) pf[ks] = pack8(lg[2 * ks], lg[2 * ks + 1]);
    }
#pragma unroll
    for (int dt = 0; dt < 8; ++dt) o[dt] = (f32x4){0.f, 0.f, 0.f, 0.f};
#pragma unroll
    for (int hc = 0; hc < 16; ++hc) {
        asm volatile("" ::: "memory");
        const int ks = hc >> 1, par = hc & 1;
        {
            unsigned w0 = wx0, w1 = wx1, w2 = wx2, w3 = wx3; asm volatile("" : "+v"(w0), "+v"(w1), "+v"(w2), "+v"(w3));
#pragma unroll
            for (int q2 = 0; q2 < 4; ++q2) { const int xr = (par + 2 * q2) & 3; const unsigned bs = xr == 0 ? w0 : (xr == 1 ? w1 : (xr == 2 ? w2 : w3));
                *(LAS v4u*)(vbuf + bs + (unsigned)((ks & 1) * 8192 + 2048 * q2 + 256 * par)) = ring[(4 * hc + q2) & 15]; }
        }
        if (par == 1) {
            LDS_WAIT(); asm volatile("" ::: "memory");
            s16x4 r0, r1, r2, r3; bf16x8 va, vb2;
#define A8_PV(dt) do { va[0] = r0[0]; va[1] = r0[1]; va[2] = r0[2]; va[3] = r0[3]; va[4] = r1[0]; va[5] = r1[1]; va[6] = r1[2]; va[7] = r1[3]; \
                vb2[0] = r2[0]; vb2[1] = r2[1]; vb2[2] = r2[2]; vb2[3] = r2[3]; vb2[4] = r3[0]; vb2[5] = r3[1]; vb2[6] = r3[2]; vb2[7] = r3[3]; \
                o[dt] = MFMA16(va, pf[ks], o[dt]); o[(dt) + 1] = MFMA16(vb2, pf[ks], o[(dt) + 1]); } while (0)
            unsigned tE = te, tEb = teb, tO = to, tOb = tob; asm volatile("" : "+v"(tE), "+v"(tEb), "+v"(tO), "+v"(tOb));
#define A8_TRP(OFF) asm volatile("ds_read_b64_tr_b16 %0, %4 offset:" #OFF "\n\tds_read_b64_tr_b16 %1, %5 offset:" #OFF "\n\tds_read_b64_tr_b16 %2, %6 offset:" #OFF "\n\tds_read_b64_tr_b16 %3, %7 offset:" #OFF "\n\ts_waitcnt lgkmcnt(0)" \
                : "=&v"(r0), "=&v"(r1), "=&v"(r2), "=&v"(r3) : "v"(tE), "v"(tEb), "v"(tO), "v"(tOb) : "memory")
            if ((ks & 1) == 0) { A8_TRP(0); A8_PV(0); A8_TRP(512); A8_PV(2); A8_TRP(1024); A8_PV(4); A8_TRP(1536); A8_PV(6); }
            else { A8_TRP(8192); A8_PV(0); A8_TRP(8704); A8_PV(2); A8_TRP(9216); A8_PV(4); A8_TRP(9728); A8_PV(6); }
#undef A8_TRP
#undef A8_PV
        }
        if (hc + 4 < 16) A8_ISSUE_V(hc + 4);
    }
    if (lr < 4) {
#pragma unroll
        for (int dt = 0; dt < 8; ++dt) { v2u w; w.x = pk2(o[dt][0] * inv, o[dt][1] * inv); w.y = pk2(o[dt][2] * inv, o[dt][3] * inv); *(v2u*)(orow + (4 * kvh + lr) * 128 + 16 * dt + 4 * g) = w; } }
#undef A8_ISSUE_K
#undef A8_ISSUE_V
}
#undef A8_TR4

DI void indexer_sample(const float* R5S, const float* cache_kidx, const int* page_table, const float* kinorm, float* SCS, int u, int tid) {
    const int wave = __builtin_amdgcn_readfirstlane(tid >> 6), lane = tid & 63, g = lane >> 4, lr = lane & 15, b = u >> 1, half = u & 1;
    const float wsc = 0.25f * 0.08838834764831845f;
    const float* qi = R5S + (size_t)b * NB + 3072 + lr * 128;
    bf16x8 qf[4];
#pragma unroll
    for (int s = 0; s < 4; ++s) qf[s] = pack8(*(const f32x4*)(qi + 32 * s + 8 * g), *(const f32x4*)(qi + 32 * s + 8 * g + 4));
    const float w = R5S[(size_t)b * NB + 5248 + lr] * wsc;
    const int phys = page_table[b * NPAGES + ((half * 1024 + wave * 128) >> 7)];
    const float* rbase = cache_kidx + ((size_t)phys * PAGE + ((wave * 128) & 127) + lr) * 128 + 8 * g;
    f32x4 rg[3][8];
#define IS_LOAD(kt_) do { const float* row_ = rbase + (size_t)(16 * (kt_)) * 128; _Pragma("unroll") for (int s_ = 0; s_ < 4; ++s_) { \
        rg[(kt_) % 3][2 * s_] = __builtin_nontemporal_load((const f32x4*)(row_ + 32 * s_)); rg[(kt_) % 3][2 * s_ + 1] = __builtin_nontemporal_load((const f32x4*)(row_ + 32 * s_ + 4)); } } while (0)
    IS_LOAD(0); IS_LOAD(1);
#pragma unroll
    for (int kt = 0; kt < 8; ++kt) {
        if (kt + 2 < 8) IS_LOAD(kt + 2);
        __builtin_amdgcn_sched_barrier(0);
        const int key0 = half * 1024 + wave * 128 + 16 * kt;
        f32x4 acc = (f32x4){0.f, 0.f, 0.f, 0.f};
#pragma unroll
        for (int s = 0; s < 4; ++s) acc = MFMA16(pack8(rg[kt % 3][2 * s], rg[kt % 3][2 * s + 1]), qf[s], acc);
        f32x4 v;
#pragma unroll
        for (int i = 0; i < 4; ++i) v[i] = grp16_sum(w * fmaxf(acc[i], 0.f));
        if (lr == 0) *(f32x4*)(SCS + (size_t)b * SCS_LD + key0 + 4 * g) = v;
        __builtin_amdgcn_sched_barrier(0);
    }
#undef IS_LOAD
    if (half == 1 && wave == 7) {
        const float* kr = R5S + (size_t)b * NB + 5120; const f32x2 a = *(const f32x2*)(kr + 2 * lane);
        const float rs = rsqrtf(wave_sum(a.x * a.x + a.y * a.y) * (1.f / 128.f) + EPS);
        const int hd = lane >> 2, part = lane & 3; const float* qh = R5S + (size_t)b * NB + 3072 + hd * 128 + 32 * part;
        float dot = 0.f;
#pragma unroll 8
        for (int d = 0; d < 32; ++d) dot += qh[d] * (kr[32 * part + d] * rs * kinorm[32 * part + d]);
        dot += __shfl_xor(dot, 1); dot += __shfl_xor(dot, 2);
        float sc = (R5S[(size_t)b * NB + 5248 + hd] * wsc) * fmaxf(dot, 0.f);
        sc += __shfl_xor(sc, 4); sc += __shfl_xor(sc, 8); sc += __shfl_xor(sc, 16); sc += __shfl_xor(sc, 32);
        if (lane == 0) SCS[(size_t)b * SCS_LD + 2048] = sc;
    }
}

struct SrcPrompt { const bf16* KB; const bf16* VB;
    DI int rowid(int pos) const { return pos; }
    DI const char* kptr(int rid, int kvh) const { return (const char*)KB + (unsigned)(rid * 1024 + kvh * 256); }
    DI const char* vptr(int rid, int kvh) const { return (const char*)VB + (unsigned)(rid * 1024 + kvh * 256); } };
struct SrcSample { const float* ck; const float* cv; const float* knew; const float* vnew; const int* pt;
    DI int rowid(int pos) const { return pos < PAST ? pt[pos >> 7] * PAGE + (pos & 127) : -1; }
    DI const char* kptr(int rid, int kvh) const { return rid >= 0 ? (const char*)ck + (unsigned)(rid * 2048 + kvh * 512) : (const char*)knew + kvh * 512; }
    DI const char* vptr(int rid, int kvh) const { return rid >= 0 ? (const char*)cv + (unsigned)(rid * 2048 + kvh * 512) : (const char*)vnew + kvh * 512; } };
struct UnitsPrompt { const int* IDX; const bf16* QRAW; const float* qnorm; bf16* OATT; int t0, stride, kvh, lane;
    DI int n() const { return t0 < T ? (T - t0 + stride - 1) / stride : 0; }
    DI const int* idx(int u) const { return IDX + (size_t)(t0 + u * stride) * TOPK; }
    DI int cnt(int u) const { const int t = t0 + u * stride; return t + 1 < TOPK ? t + 1 : TOPK; }
    DI int qpos(int u) const { return t0 + u * stride; }
    DI bf16* orow(int u) const { return OATT + (size_t)(t0 + u * stride) * D; }
    DI void qfrag(int u, bf16x8 (&qf)[4]) const {
        const int g = lane >> 4, lr = lane & 15; const bf16* qr = QRAW + (size_t)(t0 + u * stride) * D + (4 * kvh + (lr & 3)) * 128;
        float qv[4][8]; float ss = 0.f;
#pragma unroll
        for (int s = 0; s < 4; ++s) { const v4u w = *(const v4u*)(qr + 32 * s + 8 * g);
            qv[s][0] = bf2f(w.x & 0xffffu); qv[s][1] = bf2f(w.x >> 16); qv[s][2] = bf2f(w.y & 0xffffu); qv[s][3] = bf2f(w.y >> 16);
            qv[s][4] = bf2f(w.z & 0xffffu); qv[s][5] = bf2f(w.z >> 16); qv[s][6] = bf2f(w.w & 0xffffu); qv[s][7] = bf2f(w.w >> 16);
#pragma unroll
            for (int e = 0; e < 8; ++e) ss += qv[s][e] * qv[s][e]; }
        ss += __shfl_xor(ss, 16); ss += __shfl_xor(ss, 32);
        const float rs = (lr < 4) ? rsqrtf(ss * (1.f / 128.f) + EPS) * 0.08838834764831845f : 0.f;
#pragma unroll
        for (int s = 0; s < 4; ++s) { const f32x4 g0 = *(const f32x4*)(qnorm + 32 * s + 8 * g), g1 = *(const f32x4*)(qnorm + 32 * s + 8 * g + 4);
            f32x4 a, b; a[0] = qv[s][0] * rs * g0[0]; a[1] = qv[s][1] * rs * g0[1]; a[2] = qv[s][2] * rs * g0[2]; a[3] = qv[s][3] * rs * g0[3];
            b[0] = qv[s][4] * rs * g1[0]; b[1] = qv[s][5] * rs * g1[1]; b[2] = qv[s][6] * rs * g1[2]; b[3] = qv[s][7] * rs * g1[3]; qf[s] = pack8(a, b); }
    } };
struct UnitsSample { const int* idxs; const bf16* qns; bf16* orow_; int valid, kvh, lane;
    DI int n() const { return valid; }
    DI const int* idx(int) const { return idxs; }
    DI int cnt(int) const { return TOPK; }
    DI int qpos(int) const { return PAST; }
    DI bf16* orow(int) const { return orow_; }
    DI void qfrag(int, bf16x8 (&qf)[4]) const { const int g = lane >> 4, lr = lane & 15;
#pragma unroll
        for (int s = 0; s < 4; ++s) { qf[s] = *(const bf16x8*)(qns + (4 * kvh + (lr & 3)) * 128 + 32 * s + 8 * g); if (lr >= 4) qf[s] = (bf16x8){0, 0, 0, 0, 0, 0, 0, 0}; } } };

DI void build_lut(LAS float* lut, const float* rel_bias, int tid) {
    for (int i = tid; i < 129 * 16; i += NTHR) { const int r = i >> 4, hd = i & 15; int bk = r;
        if (r >= 16) { bk = 16 + (int)(__logf((float)r / 16.f) / 2.0794415f * 16.f); bk = bk > 31 ? 31 : bk; }
        lut[i] = rel_bias[bk * 16 + hd]; }
}
#define XB_TMO      128
#define XB_XCNT(j)  (256  + 64 * (j))
#define XB_XSUB(j)  (1280 + 64 * (j))
#define XB_XGEN(j)  (2304 + 64 * (j))
#define XB_TOP      3328
#define XB_TOPGEN   3392
#define XCD_BAR_WORDS 3456
#define XB_SPIN_CAP (1u << 18)

__device__ __forceinline__ unsigned xb_ld(unsigned* p)              { return __hip_atomic_load(p, __ATOMIC_RELAXED, __HIP_MEMORY_SCOPE_AGENT); }
__device__ __forceinline__ unsigned xb_add(unsigned* p, unsigned v) { return __hip_atomic_fetch_add(p, v, __ATOMIC_RELAXED, __HIP_MEMORY_SCOPE_AGENT); }
__device__ __forceinline__ unsigned xb_xcc_id() { return (unsigned)__builtin_amdgcn_s_getreg((3 << 11) | 20) & 0xFu; }
#define XB_SPIN(cond, bar) do { unsigned _sp = 0; while (cond) { __builtin_amdgcn_s_sleep(1); \
    if ((++_sp & 255u) == 0u) { if (xb_ld(&(bar)[XB_TMO])) break; if (_sp > XB_SPIN_CAP) { atomicAdd(&(bar)[XB_TMO], 1u); break; } } } } while (0)

struct XcdBarrier {
    unsigned* bar; unsigned x;
    volatile LAS unsigned* st;
};

__device__ __forceinline__ XcdBarrier xcd_barrier_post(unsigned* bar, volatile LAS unsigned* st, const bool t0  ) {
    XcdBarrier b; b.bar = bar; b.x = xb_xcc_id(); b.st = st;
    if (t0) (void)xb_add(&bar[XB_XCNT(b.x)], 1u);
    return b;
}
__device__ __forceinline__ void xcd_barrier_complete(unsigned* bar, unsigned x, unsigned& nloc, unsigned& nx) {
    const unsigned G = gridDim.x * gridDim.y * gridDim.z;
    unsigned sum, cnt, mine, sp = 0u;
    for (;;) {
        sum = 0u; cnt = 0u; mine = 0u;
#pragma unroll
        for (unsigned j = 0; j < 16; ++j) { const unsigned c = xb_ld(&bar[XB_XCNT(j)]); sum += c; cnt += (c > 0u) ? 1u : 0u; mine = (j == x) ? c : mine; }
        if (sum == G) break;
        __builtin_amdgcn_s_sleep(1);
        if ((++sp & 255u) == 0u) { if (xb_ld(&bar[XB_TMO])) break; if (sp > XB_SPIN_CAP) { atomicAdd(&bar[XB_TMO], 1u); break; } }
    }
    nloc = mine > 0u ? mine : 1u; nx = cnt > 0u ? cnt : 1u;
}

__device__ __forceinline__ void xcd_barrier(const XcdBarrier& b, const bool t0  ) {
    asm volatile("s_waitcnt vmcnt(0)" ::: "memory");
    __syncthreads();
    if (t0) {
        unsigned* bar = b.bar;
        __builtin_amdgcn_s_waitcnt(0);
        unsigned nloc = b.st[0], nx = b.st[1];
        if (nloc == 0u) { xcd_barrier_complete(bar, b.x, nloc, nx); b.st[0] = nloc; b.st[1] = nx; }
        const unsigned old = xb_add(&bar[XB_XSUB(b.x)], 1u);
        const unsigned gen = old / nloc;
        if (old + 1u == (gen + 1u) * nloc) {
            __builtin_amdgcn_fence(__ATOMIC_RELEASE, "agent");
            asm volatile("s_waitcnt vmcnt(0)" ::: "memory");
            const unsigned og = xb_add(&bar[XB_TOP], 1u);
            const unsigned tg = og / nx;
            if (og + 1u == (tg + 1u) * nx) xb_add(&bar[XB_TOPGEN], 1u);
            else XB_SPIN(xb_ld(&bar[XB_TOPGEN]) == tg, bar);
            __builtin_amdgcn_fence(__ATOMIC_ACQUIRE, "agent");
            xb_add(&bar[XB_XGEN(b.x)], 1u);
            asm volatile("s_waitcnt vmcnt(0)" ::: "memory");
        } else {
            XB_SPIN(xb_ld(&bar[XB_XGEN(b.x)]) == gen, bar);
            __builtin_amdgcn_fence(__ATOMIC_ACQUIRE, "agent");
            asm volatile("s_waitcnt vmcnt(0)" ::: "memory");
        }
    }
    __syncthreads();
}

typedef const __attribute__((address_space(4))) Args ArgsK;
DI ArgsK* launder_args() { ArgsK* p = (ArgsK*)__builtin_amdgcn_kernarg_segment_ptr(); asm volatile("" : "+s"(p)); return p; }
__global__ void __launch_bounds__(NTHR, 2) mk_fwd(Args args) {
    extern __shared__ __attribute__((aligned(16))) unsigned char lds_raw[];
    LAS unsigned char* lds = (LAS unsigned char*)lds_raw;
    const int tid0 = threadIdx.x, wave = __builtin_amdgcn_readfirstlane(tid0 >> 6), G = gridDim.x, bid = blockIdx.x;
    const int gw = bid * NWAVES + wave, NGW = G * NWAVES;
    unsigned* ctl = (unsigned*)(args.ws + WS_CTL);
    for (int u = tid0; u < (LDS_BYTES - MISC_OFF) / 4; u += NTHR) ((LAS unsigned*)(lds + MISC_OFF))[u] = 0u;
    __syncthreads();
#if MK_ONE_LAUNCH
    XcdBarrier bar = xcd_barrier_post(ctl + CW_BAR, (volatile LAS unsigned*)(lds + MISC_OFF + 32), tid0 == 0);
#define GRID_BAR() do { int l_; asm volatile("v_mbcnt_lo_u32_b32 %0, -1, 0\n\tv_mbcnt_hi_u32_b32 %0, -1, %0" : "=v"(l_)); xcd_barrier(bar, wave == 0 && l_ == 0); } while (0)
#else
#define GRID_BAR() do {} while (0)
#endif

#define LATE_N (32 * 32 + 32 * 176 + 88 * 32)
#define LATE_TR(L_) do { int r_ = (L_); TrItem t_{}; \
        if (r_ < 32 * 32) t_ = TrItem{b_w_out, WB_OUT, D, D, 0, r_}; \
        else if (r_ < 32 * 32 + 32 * 176) t_ = TrItem{w_gu + (size_t)D * 2 * FF, WGU1, D, 2 * FF, 1, r_ - 32 * 32}; \
        else t_ = TrItem{w_down + (size_t)FF * D, WD1, FF, D, 0, r_ - 32 * 32 - 32 * 176}; \
        f32x4 rr_[16]; tr_load(t_, lane, rr_); tr_store(t_, lane, rr_, (LAS float*)(lds + wave * WSLAB)); } while (0)
    const int lo = args.ph_lo, hi = args.ph_hi;
#ifndef PH_MASK
#define PH_MASK 0x3ffff
#endif
#define IN(k) (((PH_MASK >> (k)) & 1) && lo <= (k) && (k) < hi)
#define BOTH(k) (IN(k) && IN((k) + 1))
#define x_p ((const float*)AP->in[0])
#define x_s ((const float*)AP->in[1])
#define state_in ((const float*)AP->in[2])
#define cache_k ((const float*)AP->in[3])
#define cache_v ((const float*)AP->in[4])
#define cache_ki ((const float*)AP->in[5])
#define page_table ((const int*)AP->in[6])
#define norm_mix ((const float*)AP->in[7])
#define norm_ffn ((const float*)AP->in[8])
#define lb_logits ((const float*)AP->in[9])
#define a_w_in ((const float*)AP->in[10])
#define a_w_out ((const float*)AP->in[11])
#define a_gnorm ((const float*)AP->in[12])
#define b_w_in ((const float*)AP->in[13])
#define b_w_out ((const float*)AP->in[14])
#define b_q_norm ((const float*)AP->in[15])
#define b_k_norm ((const float*)AP->in[16])
#define b_ki_norm ((const float*)AP->in[17])
#define rel_bias ((const float*)AP->in[18])
#define w_gu ((const float*)AP->in[19])
#define w_down ((const float*)AP->in[20])
#define LB0 ((float*)(AP->ws + WS_LB0))
#define LUTG ((float*)(AP->ws + WS_LUT))
#define WA_IN ((bf16*)(AP->ws + WS_WA_IN))
#define WA_OUT ((bf16*)(AP->ws + WS_WA_OUT))
#define WGU0 ((bf16*)(AP->ws + WS_WGU0))
#define WD0 ((bf16*)(AP->ws + WS_WD0))
#define WB_IN ((bf16*)(AP->ws + WS_WB_IN))
#define WB_OUT ((bf16*)(AP->ws + WS_WB_OUT))
#define WGU1 ((bf16*)(AP->ws + WS_WGU1))
#define WD1 ((bf16*)(AP->ws + WS_WD1))
#define HP ((bf16*)(AP->ws + WS_HP))
#define ZQ ((bf16*)(AP->ws + WS_ZQ))
#define ZK ((bf16*)(AP->ws + WS_ZK))
#define ZV ((bf16*)(AP->ws + WS_ZV))
#define ZG ((bf16*)(AP->ws + WS_ZG))
#define LF ((float*)(AP->ws + WS_LF))
#define QG ((bf16*)(AP->ws + WS_QG))
#define OL ((float*)(AP->ws + WS_OL))
#define DS ((float*)(AP->ws + WS_DS))
#define DSC ((float*)(AP->ws + WS_DSC))
#define OG ((bf16*)(AP->ws + WS_OG))
#define Y1 ((bf16*)(AP->ws + WS_Y1))
#define HID ((bf16*)(AP->ws + WS_HID))
#define Y2 ((bf16*)(AP->ws + WS_Y2))
#define Y3 ((bf16*)(AP->ws + WS_Y3))
#define QRAW ((bf16*)(AP->ws + WS_QRAW))
#define QIB ((bf16*)(AP->ws + WS_QIB))
#define KRAW ((float*)(AP->ws + WS_KRAW))
#define KIRAW ((float*)(AP->ws + WS_KIRAW))
#define WI ((float*)(AP->ws + WS_WI))
#define KB ((bf16*)(AP->ws + WS_KB))
#define VB ((bf16*)(AP->ws + WS_VB))
#define KIB ((bf16*)(AP->ws + WS_KIB))
#define SC ((float*)(AP->ws + WS_SC))
#define IDX ((int*)(AP->ws + WS_IDX))
#define OATT ((bf16*)(AP->ws + WS_OATT))
#define HS ((bf16*)(AP->ws + WS_HS))
#define RS1 ((float*)(AP->ws + WS_RS1))
#define OGS ((bf16*)(AP->ws + WS_OGS))
#define Y1S ((float*)(AP->ws + WS_Y1S))
#define HIDS ((bf16*)(AP->ws + WS_HIDS))
#define Y2S ((float*)(AP->ws + WS_Y2S))
#define R5S ((float*)(AP->ws + WS_R5S))
#define QNS ((bf16*)(AP->ws + WS_QNS))
#define SCS ((float*)(AP->ws + WS_SCS))
#define IDXS ((int*)(AP->ws + WS_IDXS))
#define OATTS ((bf16*)(AP->ws + WS_OATTS))
#define Y3S ((float*)(AP->ws + WS_Y3S))
#define out (AP->out)
#define SSQ ((float*)(AP->ws + WS_SSQ))
#define SSQS (SSQ + 3 * T)
    if (IN(0)) {
        const ArgsK* AP = launder_args();
        int lane; asm volatile("v_mbcnt_lo_u32_b32 %0, -1, 0\n\tv_mbcnt_hi_u32_b32 %0, -1, %0" : "=v"(lane)); const int tid = wave * 64 + lane;
        LAS float* scr = (LAS float*)(lds + wave * 16640);
        constexpr int I0 = 32 * 128, I1 = 32 * 32, I2 = 32 * 176, I3 = 88 * 32, I4 = 32 * 83, NIT = I0 + I1 + I2 + I3 + I4;
#define TR_PICK(it_, t_) do { int r_ = (it_); \
            if (r_ < I0) { t_ = TrItem{a_w_in, WA_IN, D, NA, 0, r_}; break; } r_ -= I0; \
            if (r_ < I1) { t_ = TrItem{a_w_out, WA_OUT, D, D, 0, r_}; break; } r_ -= I1; \
            if (r_ < I2) { t_ = TrItem{w_gu, WGU0, D, 2 * FF, 1, r_}; break; } r_ -= I2; \
            if (r_ < I3) { t_ = TrItem{w_down, WD0, FF, D, 0, r_}; break; } r_ -= I3; \
            t_ = TrItem{b_w_in, WB_IN, D, NBR, 0, r_}; } while (0)
        {
            f32x4 ra[16], rb[16]; TrItem ta{}, tb{};
            int it = gw;
            if (it < NIT) { TR_PICK(it, ta); tr_load(ta, lane, ra); }
            while (it < NIT) {
                const int it2 = it + NGW, it3 = it2 + NGW;
                if (it2 < NIT) { TR_PICK(it2, tb); tr_load(tb, lane, rb); }
                tr_store(ta, lane, ra, scr);
                if (it2 >= NIT) break;
                if (it3 < NIT) { TR_PICK(it3, ta); tr_load(ta, lane, ra); }
                tr_store(tb, lane, rb, scr);
                it = it3;
            }
        }
#undef TR_PICK
        for (int m = gw; m < T + BS; m += NGW) { if (m < T) rmsnorm_row(x_p + (size_t)m * D, norm_mix, HP + (size_t)m * D, lane); else rmsnorm_row(x_s + (size_t)(m - T) * D, norm_mix, HS + (size_t)(m - T) * DS_, lane); }
        const int gt = bid * NTHR + tid, NGT = G * NTHR;
        for (int i = gt; i < 2048; i += NGT) { const float a = lb_logits[i], b = lb_logits[2048 + i], c = lb_logits[4096 + i], mx = fmaxf(a, fmaxf(b, c)); const float ea = __expf(a - mx), eb = __expf(b - mx), ec = __expf(c - mx); LB0[i] = ea / (ea + eb + ec); }
        for (int i = gt; i < (NB - 5312) * D / 8; i += NGT) ((v4u*)(WB_IN + (size_t)5312 * D))[i] = (v4u){0u, 0u, 0u, 0u};
        for (int i = gt; i < 3 * T + 3 * BS; i += NGT) SSQ[i] = 0.f;
        if (BOTH(0)) GRID_BAR();
    }
    if (IN(1)) {
        const ArgsK* AP = launder_args();
        int lane; asm volatile("v_mbcnt_lo_u32_b32 %0, -1, 0\n\tv_mbcnt_hi_u32_b32 %0, -1, %0" : "=v"(lane)); const int tid = wave * 64 + lane;
        pg8::Gemm g{HP, WA_IN, T, NA, D}; pg8::StaticOrder S; S.init(T, NA, G, bid);
        EpiA E{ZQ, LF, LB0};
        pg8::gemm_phase<EpiA, pg8::StaticOrder, true, true>(lds, g, S, E, wave);
        skinny_gemm<0, 2, 4, D>(lds, HS, DS_, WA_IN, NA / 64, RS1, nullptr, NA, nullptr, bid, G, tid);
        if (BOTH(1)) GRID_BAR();
    }
    if (IN(2)) {
        const ArgsK* AP = launder_args();
        int lane; asm volatile("v_mbcnt_lo_u32_b32 %0, -1, 0\n\tv_mbcnt_hi_u32_b32 %0, -1, %0" : "=v"(lane)); const int tid = wave * 64 + lane;
        if (bid & 1) {
            for (int su = gw; su < BS * 16; su += NGW) hgrn_sample((LAS float*)(lds + wave * 2048), RS1, LB0, state_in, out + O_SS, a_gnorm, OGS, su >> 4, su & 15, lane);
            __syncthreads();
            hgrn_passA(lds, ZQ, ZK, ZV, LF, QG, OL, DS, DSC, bid, G, tid);
        } else {
            hgrn_passA(lds, ZQ, ZK, ZV, LF, QG, OL, DS, DSC, bid, G, tid);
            __syncthreads();
            for (int su = gw; su < BS * 16; su += NGW) hgrn_sample((LAS float*)(lds + wave * 2048), RS1, LB0, state_in, out + O_SS, a_gnorm, OGS, su >> 4, su & 15, lane);
        }
        if (BOTH(2)) GRID_BAR();
    }
    if (IN(3)) {
        const ArgsK* AP = launder_args();
        int lane; asm volatile("v_mbcnt_lo_u32_b32 %0, -1, 0\n\tv_mbcnt_hi_u32_b32 %0, -1, %0" : "=v"(lane)); const int tid = wave * 64 + lane;
        hgrn_passC(lds, QG, OL, DS, DSC, ZG, a_gnorm, OG, out + O_SP, bid, G, tid);
        skinny_gemm<0, 1, 2, D>(lds, OGS, DS_, WA_OUT, D / 32, Y1S, x_s, D, nullptr, bid, G, tid, 0, SkNorm{nullptr, norm_ffn, HS, SSQS});
        if (BOTH(3)) GRID_BAR();
    }
    if (IN(4)) {
        const ArgsK* AP = launder_args();
        int lane; asm volatile("v_mbcnt_lo_u32_b32 %0, -1, 0\n\tv_mbcnt_hi_u32_b32 %0, -1, %0" : "=v"(lane)); const int tid = wave * 64 + lane;
        pg8::Gemm g{OG, WA_OUT, T, D, D}; pg8::StaticOrder S; S.init(T, D, G, bid);
        EpiRes<false, true> E{x_p, Y1, norm_ffn, HP, SSQ};
        pg8::gemm_phase<EpiRes<false, true>, pg8::StaticOrder, true, true>(lds, g, S, E, wave);
        skinny_gemm<1, 2, 4, D>(lds, HS, DS_, WGU0, FF / 32, nullptr, nullptr, 0, HIDS, bid, G, tid, 0, SkNorm{SSQS, nullptr, nullptr, nullptr});
        if (BOTH(4)) GRID_BAR();
    }
    if (IN(5)) {
        const ArgsK* AP = launder_args();
        int lane; asm volatile("v_mbcnt_lo_u32_b32 %0, -1, 0\n\tv_mbcnt_hi_u32_b32 %0, -1, %0" : "=v"(lane)); const int tid = wave * 64 + lane;
        pg8::Gemm g{HP, WGU0, T, 2 * FF, D}; pg8::StaticOrder S; S.init(T, 2 * FF, G, bid);
        EpiSwiglu E{HID, SSQ};
        pg8::gemm_phase<EpiSwiglu, pg8::StaticOrder, true, true>(lds, g, S, E, wave);
        skinny_gemm<0, 1, 2, FF>(lds, HIDS, FFS_, WD0, D / 32, Y2S, Y1S, D, nullptr, bid, G, tid, (T / 256 * (2 * FF / 256)) % G, SkNorm{nullptr, norm_mix + D, HS, SSQS + BS});
        if (BOTH(5)) GRID_BAR();
    }
    if (IN(6)) {
        const ArgsK* AP = launder_args();
        int lane; asm volatile("v_mbcnt_lo_u32_b32 %0, -1, 0\n\tv_mbcnt_hi_u32_b32 %0, -1, %0" : "=v"(lane)); const int tid = wave * 64 + lane;
        pg8::Gemm g{HID, WD0, T, D, FF}; pg8::StaticOrder S; S.init(T, D, G, bid);
        EpiRes<true, true> E{Y1, Y2, norm_mix + D, HP, SSQ + T};
        pg8::gemm_phase<EpiRes<true, true>, pg8::StaticOrder, true, true>(lds, g, S, E, wave);
        skinny_gemm<0, 2, 4, D>(lds, HS, DS_, WB_IN, NB / 64, R5S, nullptr, NB, nullptr, bid, G, tid, 0, SkNorm{SSQS + BS, nullptr, nullptr, nullptr});
        if (BOTH(6)) GRID_BAR();
    }
    if (IN(7)) {
        const ArgsK* AP = launder_args();
        int lane; asm volatile("v_mbcnt_lo_u32_b32 %0, -1, 0\n\tv_mbcnt_hi_u32_b32 %0, -1, %0" : "=v"(lane)); const int tid = wave * 64 + lane;
        pg8::Gemm g{HP, WB_IN, T, NB, D}; pg8::StaticOrder S; S.init(T, NB, G, bid);
        EpiB E{QRAW, QIB, VB, KRAW, out + O_VP, KIRAW, WI, SSQ + T};
        pg8::gemm_phase<EpiB, pg8::StaticOrder, true, true>(lds, g, S, E, wave);
        for (int b = NGW - 1 - gw; b < BS; b += NGW) dsa_sample_prep(R5S, b_q_norm, b_k_norm, b_ki_norm, QNS, out + O_KS, out + O_VS, out + O_KIS, b, lane);
        { const int c0 = (T / 256 * (NB / 256)) % G;
          for (int u = bid - c0; u >= 0 && u < 2 * BS; u += G - c0) indexer_sample(R5S, cache_ki, page_table, b_ki_norm, SCS, u, tid); }
        if (BOTH(7)) GRID_BAR();
    }
    if (IN(8)) {
        const ArgsK* AP = launder_args();
        int lane; asm volatile("v_mbcnt_lo_u32_b32 %0, -1, 0\n\tv_mbcnt_hi_u32_b32 %0, -1, %0" : "=v"(lane)); const int tid = wave * 64 + lane;
        if (gw < NGW - BS) for (int t = gw; t < T; t += NGW - BS) dsa_post_row(KRAW, KIRAW, b_k_norm, b_ki_norm, out + O_KP, out + O_KIP, KB, KIB, VB, (unsigned char*)(AP->ws + WS_K8), (unsigned char*)(AP->ws + WS_V8), t, lane);
        for (int b = NGW - 1 - gw; b < BS; b += NGW) topk_dispatch(SCS + (size_t)b * SCS_LD, PAST + 1, IDXS + b * TOPK, (LAS unsigned*)(lds + wave * 8192), lane);
        if (gw == 0) { for (int i = lane; i < 129 * 16; i += 64) { const int r = i >> 4, hd = i & 15; int bk = r; if (r >= 16) { bk = 16 + (int)(__logf((float)r / 16.f) / 2.0794415f * 16.f); bk = bk > 31 ? 31 : bk; } LUTG[i] = rel_bias[bk * 16 + hd]; } }
        if (BOTH(8)) GRID_BAR();
    }
    if (IN(9)) {
        const ArgsK* AP = launder_args();
        int lane; asm volatile("v_mbcnt_lo_u32_b32 %0, -1, 0\n\tv_mbcnt_hi_u32_b32 %0, -1, %0" : "=v"(lane)); const int tid = wave * 64 + lane;
        indexer_prompt(lds, QIB, KIB, WI, SC, bid, G, tid);
        if (BOTH(9)) GRID_BAR();
    }
    if (IN(10)) {
        const ArgsK* AP = launder_args();
        int lane; asm volatile("v_mbcnt_lo_u32_b32 %0, -1, 0\n\tv_mbcnt_hi_u32_b32 %0, -1, %0" : "=v"(lane)); const int tid = wave * 64 + lane;
        { int lt = tid; asm volatile("" : "+v"(lt)); for (int i = lt; i < 129 * 16; i += NTHR) ((LAS float*)(lds + LUT_OFF))[i] = LUTG[i]; }
        if (tid == 0) ((volatile LAS int*)(lds + MISC_OFF))[12] = 0;
        __syncthreads();
        for (;;) {
            int it = 0;
            if (lane == 0) it = __hip_atomic_fetch_add((LAS int*)(lds + MISC_OFF) + 12, 1, __ATOMIC_RELAXED, __HIP_MEMORY_SCOPE_WORKGROUP);
            it = __builtin_amdgcn_readfirstlane(it);
            if (it >= 34 + 12) break;
            if (it >= 34) { const int L = bid + G * (it - 34); if (L < LATE_N) LATE_TR(L); continue; }
            if (it < 2) {
                const int su = 2 * bid + it;
                if (su < BS * 4) {
                    const int b = su >> 2, kvh = su & 3, g = lane >> 4, lr = lane & 15;
                    bf16x8 qf[4];
#pragma unroll
                    for (int s = 0; s < 4; ++s) { qf[s] = *(const bf16x8*)(QNS + (size_t)b * D + (4 * kvh + (lr & 3)) * 128 + 32 * s + 8 * g); if (lr >= 4) qf[s] = (bf16x8){0, 0, 0, 0, 0, 0, 0, 0}; }
                    SrcSample src{cache_k, cache_v, out + O_KS + (size_t)b * 512, out + O_VS + (size_t)b * 512, page_table + b * NPAGES};
                    attn_unit<true, SrcSample>(lds + wave * WSLAB, (const LAS float*)(lds + LUT_OFF), qf, IDXS + b * TOPK, TOPK, PAST, kvh, src, OATTS + (size_t)b * DS_, lane);
                }
            } else {
                const int r = it - 2, kq = 3 - (r >> 3), j0 = bid * NWAVES + (r & 7), t = NGW * kq + ((kq & 1) ? NGW - 1 - j0 : j0);
                if (t >= 0 && t < T) topk_dispatch(SC + (size_t)t * T, t + 1, IDX + (size_t)t * TOPK, (LAS unsigned*)(lds + wave * WSLAB), lane);
            }
        }
        if (BOTH(10)) GRID_BAR();
    }
    if (IN(11)) {
        const ArgsK* AP = launder_args();
        int lane; asm volatile("v_mbcnt_lo_u32_b32 %0, -1, 0\n\tv_mbcnt_hi_u32_b32 %0, -1, %0" : "=v"(lane)); const int tid = wave * 64 + lane;
        { int lt = tid; asm volatile("" : "+v"(lt)); for (int i = lt; i < 129 * 16; i += NTHR) ((LAS float*)(lds + LUT_OFF))[i] = LUTG[i] * 1.4426950408889634f; }
        __syncthreads();
        {
            const int kvh = bid & 3, g = lane >> 4, lr = lane & 15, nslots = (G >> 2) * NWAVES;
            const unsigned char* K8 = (const unsigned char*)(AP->ws + WS_K8);
            if (tid == 0) ((volatile LAS int*)(lds + MISC_OFF))[12] = 0;
            __syncthreads();
            constexpr int NATT = 128, NLATE = 26;
            for (;;) {
            int it = 0;
            if (lane == 0) it = __hip_atomic_fetch_add((LAS int*)(lds + MISC_OFF) + 12, 1, __ATOMIC_RELAXED, __HIP_MEMORY_SCOPE_WORKGROUP);
            it = __builtin_amdgcn_readfirstlane(it);
            if (it >= NATT + NLATE) break;
            const int grp = it / 6, pos = it % 6;
            const bool is_tr = (pos == 5 && grp < NLATE) ;
            if (is_tr) { const int L = bid + G * (12 + grp); if (L < LATE_N) LATE_TR(L); continue; }
            const int u = it - (grp < NLATE ? grp : NLATE);
            if (u >= NATT) continue;
            {
                const int t = (bid >> 2) * NWAVES + (u & 7) + nslots * (u >> 3);
                if (t >= T) continue;

                const bf16* qr = QRAW + (size_t)t * D + (4 * kvh + (lr & 3)) * 128;
                float qv[4][8]; float ss = 0.f;
#pragma unroll
                for (int s = 0; s < 4; ++s) { const v4u w = *(const v4u*)(qr + 32 * g + 8 * s);
                    qv[s][0] = bf2f(w.x & 0xffffu); qv[s][1] = bf2f(w.x >> 16); qv[s][2] = bf2f(w.y & 0xffffu); qv[s][3] = bf2f(w.y >> 16);
                    qv[s][4] = bf2f(w.z & 0xffffu); qv[s][5] = bf2f(w.z >> 16); qv[s][6] = bf2f(w.w & 0xffffu); qv[s][7] = bf2f(w.w >> 16);
#pragma unroll
                    for (int e = 0; e < 8; ++e) ss += qv[s][e] * qv[s][e]; }
                ss += __shfl_xor(ss, 16); ss += __shfl_xor(ss, 32);
                const float rs = (lr < 4) ? rsqrtf(ss * (1.f / 128.f) + EPS) : 0.f;
                long qf[4];
#pragma unroll
                for (int s = 0; s < 4; ++s) { const f32x4 g0 = *(const f32x4*)(b_q_norm + 32 * g + 8 * s), g1 = *(const f32x4*)(b_q_norm + 32 * g + 8 * s + 4);
                    const unsigned lo = pk4_fp8(qv[s][0] * rs * g0[0], qv[s][1] * rs * g0[1], qv[s][2] * rs * g0[2], qv[s][3] * rs * g0[3]);
                    const unsigned hi = pk4_fp8(qv[s][4] * rs * g1[0], qv[s][5] * rs * g1[1], qv[s][6] * rs * g1[2], qv[s][7] * rs * g1[3]);
                    qf[s] = (long)(((unsigned long long)hi << 32) | lo); }
                const int cnt = t + 1 < TOPK ? t + 1 : TOPK;
                attn_unit_f8(lds + wave * WSLAB, (const LAS float*)(lds + LUT_OFF), qf, IDX + (size_t)t * TOPK, cnt, t, kvh, K8, VB, OATT + (size_t)t * D, lane);
            }
            }
        }
        __syncthreads();
        skinny_gemm<0, 1, 2, D>(lds, OATTS, DS_, WB_OUT, D / 32, Y3S, Y2S, D, nullptr, bid, G, tid, 0, SkNorm{nullptr, norm_ffn + D, HS, SSQS + 2 * BS});
        if (BOTH(11)) GRID_BAR();
    }
    if (IN(12)) {
        const ArgsK* AP = launder_args();
        int lane; asm volatile("v_mbcnt_lo_u32_b32 %0, -1, 0\n\tv_mbcnt_hi_u32_b32 %0, -1, %0" : "=v"(lane)); const int tid = wave * 64 + lane;
        pg8::Gemm g{OATT, WB_OUT, T, D, D}; pg8::StaticOrder S; S.init(T, D, G, bid);
        EpiRes<true, true> E{Y2, Y3, norm_ffn + D, HP, SSQ + 2 * T};
        pg8::gemm_phase<EpiRes<true, true>, pg8::StaticOrder, true, true>(lds, g, S, E, wave);
        skinny_gemm<1, 2, 4, D>(lds, HS, DS_, WGU1, FF / 32, nullptr, nullptr, 0, HIDS, bid, G, tid, 0, SkNorm{SSQS + 2 * BS, nullptr, nullptr, nullptr});
        if (BOTH(12)) GRID_BAR();
    }
    if (IN(13)) {
        const ArgsK* AP = launder_args();
        int lane; asm volatile("v_mbcnt_lo_u32_b32 %0, -1, 0\n\tv_mbcnt_hi_u32_b32 %0, -1, %0" : "=v"(lane)); const int tid = wave * 64 + lane;
        pg8::Gemm g{HP, WGU1, T, 2 * FF, D}; pg8::StaticOrder S; S.init(T, 2 * FF, G, bid);
        EpiSwiglu E{HID, SSQ + 2 * T};
        pg8::gemm_phase<EpiSwiglu, pg8::StaticOrder, true, true>(lds, g, S, E, wave);
        skinny_gemm<0, 1, 2, FF>(lds, HIDS, FFS_, WD1, D / 32, out + O_YS, Y3S, D, nullptr, bid, G, tid, (T / 256 * (2 * FF / 256)) % G);
        if (BOTH(13)) GRID_BAR();
    }
    if (IN(14)) {
        const ArgsK* AP = launder_args();
        int lane; asm volatile("v_mbcnt_lo_u32_b32 %0, -1, 0\n\tv_mbcnt_hi_u32_b32 %0, -1, %0" : "=v"(lane)); const int tid = wave * 64 + lane;
        pg8::Gemm g{HID, WD1, T, D, FF}; pg8::StaticOrder S; S.init(T, D, G, bid);
        EpiRes<true, false> E{Y3, out + O_YP, nullptr, nullptr, nullptr};
        pg8::gemm_phase<EpiRes<true, false>, pg8::StaticOrder, true, true>(lds, g, S, E, wave);
    }
#undef LATE_TR
#undef LATE_N
#undef IN
#undef BOTH
}
#undef x_p
#undef x_s
#undef state_in
#undef cache_k
#undef cache_v
#undef cache_ki
#undef page_table
#undef norm_mix
#undef norm_ffn
#undef lb_logits
#undef a_w_in
#undef a_w_out
#undef a_gnorm
#undef b_w_in
#undef b_w_out
#undef b_q_norm
#undef b_k_norm
#undef b_ki_norm
#undef rel_bias
#undef w_gu
#undef w_down
#undef LB0
#undef LUTG
#undef WA_IN
#undef WA_OUT
#undef WGU0
#undef WD0
#undef WB_IN
#undef WB_OUT
#undef WGU1
#undef WD1
#undef HP
#undef ZQ
#undef ZK
#undef ZV
#undef ZG
#undef LF
#undef QG
#undef OL
#undef DS
#undef DSC
#undef OG
#undef Y1
#undef HID
#undef Y2
#undef Y3
#undef QRAW
#undef QIB
#undef KRAW
#undef KIRAW
#undef WI
#undef KB
#undef VB
#undef KIB
#undef SC
#undef IDX
#undef OATT
#undef HS
#undef RS1
#undef OGS
#undef Y1S
#undef HIDS
#undef Y2S
#undef R5S
#undef QNS
#undef SCS
#undef IDXS
#undef OATTS
#undef Y3S
#undef out
#undef SSQ
#undef SSQS

extern "C" void kernel_launch(void* const* d_in, const int* in_sizes, int n_in, void* d_out, int out_size, void* d_ws, size_t ws_size, hipStream_t stream) {
    static int grid = 0;
    if (grid == 0) {
        if (n_in != 21 || ws_size < WS_END) { fprintf(stderr, "kernel_launch: unexpected problem (n_in %d, out %d, ws %zu); nothing launched\n", n_in, out_size, ws_size); grid = -1; return; }
        int dev = 0, cus = 0, per_cu = 0;
        if (hipGetDevice(&dev) != hipSuccess || hipDeviceGetAttribute(&cus, hipDeviceAttributeMultiprocessorCount, dev) != hipSuccess) { grid = -1; return; }
        if (hipFuncSetAttribute((const void*)mk_fwd, hipFuncAttributeMaxDynamicSharedMemorySize, LDS_BYTES) != hipSuccess) { fprintf(stderr, "kernel_launch: hipFuncSetAttribute failed\n"); grid = -1; return; }
        if (hipOccupancyMaxActiveBlocksPerMultiprocessor(&per_cu, (const void*)mk_fwd, NTHR, LDS_BYTES) != hipSuccess || per_cu < 1) { fprintf(stderr, "kernel_launch: occupancy query says %d blocks per CU\n", per_cu); }
        (void)hipGetLastError();
        grid = cus;
    }
    if (grid < 0) return;
    (void)hipMemsetAsync((char*)d_ws + WS_CTL, 0, CTL_ZERO_BYTES, stream);
    Args a{};
    for (int i = 0; i < 21; ++i) a.in[i] = d_in[i];
    a.out = (float*)d_out; a.ws = (unsigned char*)d_ws;
#if MK_ONE_LAUNCH
    a.ph_lo = 0; a.ph_hi = NPHASE; a.li = 0;
    hipLaunchKernelGGL(mk_fwd, dim3(grid), dim3(NTHR), LDS_BYTES, stream, a);
#else
    for (int p = 0; p < NPHASE; ++p) { a.ph_lo = p; a.ph_hi = p + 1; a.li = p; hipLaunchKernelGGL(mk_fwd, dim3(grid), dim3(NTHR), LDS_BYTES, stream, a); }
#endif
}
```

```cpp
#include <hip/hip_runtime.h>
#include <cstdio>
#include <cstdint>
namespace pg8 {
#define PG8_LAS __attribute__((address_space(3)))
typedef unsigned short bf16_t;
typedef short bf16x8 __attribute__((ext_vector_type(8)));
typedef float f32x4 __attribute__((ext_vector_type(4)));
typedef unsigned u32x4 __attribute__((ext_vector_type(4)));
constexpr int BM = 256, BK = 64, HALF = 128, HTB = HALF * BK * 2  , STAGE_BYTES = 8 * HTB, NXCD = 8, WGM = 8;

__host__ __device__ __forceinline__ int lds_byte(int r, int c) { const int st = (r >> 4) * 2 + (c >> 5), rr = r & 15, cc = c & 31, ob = rr * 64 + cc * 2; return st * 1024 + (ob ^ (((ob >> 9) & 1) << 5)); }
__host__ __device__ __forceinline__ void stage_rc(int b, int& R, int& C) { const int st = b / 1024, sb = b % 1024, swz = sb ^ (((sb >> 9) & 1) << 5); R = (st >> 1) * 16 + swz / 64; C = (st & 1) * 32 + (swz % 64) / 2; }
__host__ __device__ __forceinline__ int perm32(int rho) { const int n = rho >> 4, i = rho & 15; return 8 * (i >> 2) + 4 * n + (i & 3); }

struct Unit { int pm, pn; };
struct Gemm { const bf16_t* A; const bf16_t* Bt; int M, N, K; };

struct StaticOrder {
    int nM, nN, nwg, G, c;
    __host__ __device__ void init(int M, int N, int G_, int c_) { nM = M / BM; nN = N / BM; nwg = nM * nN; G = G_; c = c_; }
    __host__ __device__ bool next(int i, Unit& u) const {
        const long L = (long)i * G + c; if (L >= nwg) return false;
        int wgid = (int)L; { const int q = nwg / NXCD, r = nwg % NXCD, xcd = wgid % NXCD, off = wgid / NXCD; wgid = (xcd < r ? xcd * (q + 1) : r * (q + 1) + (xcd - r) * q) + off; }
        const int nig = WGM * nN, gid = wgid / nig, fm = gid * WGM, gsz = (nM - fm) < WGM ? (nM - fm) : WGM;
        u.pm = fm + ((wgid % nig) % gsz); u.pn = (wgid % nig) / gsz; return true;
    }
    __device__ __forceinline__ void a_ready(const Unit&) const {}
    __device__ __forceinline__ void done(const Unit&) const {}
};

__device__ __forceinline__ unsigned cvt_pk_bf16(float lo, float hi) { unsigned r; asm volatile("v_cvt_pk_bf16_f32 %0, %1, %2" : "=v"(r) : "v"(lo), "v"(hi)); return r; }
template <class Epi, class Sched, bool ALIGN_EPI = false, bool SP2 = false>
__device__ __forceinline__ void gemm_phase(PG8_LAS unsigned char* lds, const Gemm g, const Sched& S, const Epi& E, const int wid  ) {
    int lane; asm volatile("v_mbcnt_lo_u32_b32 %0, -1, 0\n\tv_mbcnt_hi_u32_b32 %0, -1, %0" : "=v"(lane));
    const int tid = wid * 64 + lane, wr = wid >> 2, wc = wid & 3, fr = lane & 15, fq = lane >> 4;
    const int K = g.K, nt = K / BK;
    unsigned voffA[2], voffB[2];
#pragma unroll
    for (int i = 0; i < 2; ++i) { int R, C; stage_rc(tid * 16 + i * 8192, R, C); const int Rb = Epi::PERM ? ((R & ~31) + perm32(R & 31)) : R;
        voffA[i] = (unsigned)(R * K + C) * 2u; voffB[i] = (unsigned)(Rb * K + C) * 2u; }
    const size_t kstep = (size_t)(BK * 2);
    const size_t hstep = (size_t)HALF * K * 2;
    const size_t tstep = 2 * hstep;
    const unsigned ldsw = (unsigned)wid * 1024u;
    const int aoff = lds_byte(wr * 64 + fr, fq * 8), boff = lds_byte(wc * 32 + fr, fq * 8);
#define PG8_SA(b, h) (((b) * 2 + (h)) * HTB)
#define PG8_SB(b, h) ((4 + (b) * 2 + (h)) * HTB)
#define PG8_STAGE(bufoff, gbase, voff) do { _Pragma("unroll") for (int _i = 0; _i < 2; ++_i) \
        __builtin_amdgcn_global_load_lds((const unsigned*)((const char*)(gbase) + (voff)[_i]), (PG8_LAS unsigned*)(lds + (bufoff) + ldsw + _i * 8192), 16, 0, 0); } while (0)
#define PG8_LDA(dst, b, h) do { _Pragma("unroll") for (int m = 0; m < 4; ++m) _Pragma("unroll") for (int k = 0; k < 2; ++k) dst[m][k] = *(const PG8_LAS bf16x8*)(lds + PG8_SA(b, h) + aoff + m * 2048 + k * 1024); } while (0)
#define PG8_LDB(dst, b, h) do { _Pragma("unroll") for (int n = 0; n < 2; ++n) _Pragma("unroll") for (int k = 0; k < 2; ++k) dst[n][k] = *(const PG8_LAS bf16x8*)(lds + PG8_SB(b, h) + boff + n * 2048 + k * 1024); } while (0)
#define PG8_MMA(ai, bj, At, Bt) do { __builtin_amdgcn_s_setprio(1); _Pragma("unroll") for (int m = 0; m < 4; ++m) _Pragma("unroll") for (int n = 0; n < 2; ++n) _Pragma("unroll") for (int k = 0; k < 2; ++k) \
        acc[ai][bj][m][n] = __builtin_amdgcn_mfma_f32_16x16x32_bf16(Bt[n][k], At[m][k], acc[ai][bj][m][n], 0, 0, 0); __builtin_amdgcn_s_setprio(0); } while (0)
#define PG8_WAIT_V(n) asm volatile("s_waitcnt vmcnt(" #n ")" ::: "memory")
#define PG8_WAIT_L(n) asm volatile("s_waitcnt lgkmcnt(" #n ")" ::: "memory")
#define PG8_BAR __builtin_amdgcn_s_barrier()
#define PG8_SCHED __builtin_amdgcn_sched_barrier(0)
    Unit cur, nxt; int ui = 0;
    if (!S.next(0, cur)) return;
    f32x4 acc[2][2][4][2];
#pragma unroll
    for (int a = 0; a < 2; ++a)
#pragma unroll
        for (int b = 0; b < 2; ++b)
#pragma unroll
            for (int m = 0; m < 4; ++m)
#pragma unroll
                for (int n = 0; n < 2; ++n) acc[a][b][m][n] = (f32x4){0.f, 0.f, 0.f, 0.f};
    bf16x8 At[4][2], B0[2][2], B1[2][2];
    const char* cA = (const char*)g.A + (size_t)cur.pm * tstep; const char* cB = (const char*)g.Bt + (size_t)cur.pn * tstep;
    S.a_ready(cur);
    if constexpr (SP2) {
        PG8_STAGE(PG8_SB(0, 0), cB, voffB); PG8_STAGE(PG8_SB(0, 1), cB + hstep, voffB); PG8_STAGE(PG8_SA(0, 0), cA, voffA); PG8_STAGE(PG8_SA(0, 1), cA + hstep, voffA);
        if (wr == 1) PG8_BAR;
        PG8_WAIT_V(2); PG8_BAR;
        PG8_STAGE(PG8_SB(1, 0), cB + kstep, voffB); PG8_STAGE(PG8_SA(1, 0), cA + kstep, voffA); PG8_STAGE(PG8_SB(1, 1), cB + hstep + kstep, voffB);
        PG8_WAIT_V(6); PG8_BAR;
    } else {
        PG8_STAGE(PG8_SB(0, 0), cB, voffB); PG8_STAGE(PG8_SA(0, 0), cA, voffA); PG8_STAGE(PG8_SB(0, 1), cB + hstep, voffB); PG8_STAGE(PG8_SA(0, 1), cA + hstep, voffA);
        if (wr == 1) PG8_BAR;
        PG8_WAIT_V(4); PG8_BAR;
        PG8_STAGE(PG8_SB(1, 0), cB + kstep, voffB); PG8_STAGE(PG8_SA(1, 0), cA + kstep, voffA); PG8_STAGE(PG8_SB(1, 1), cB + hstep + kstep, voffB);
        PG8_WAIT_V(6); PG8_BAR;
    }
    for (;;) {
        const bool has_next = S.next(ui + 1, nxt);
        const char* nA = has_next ? (const char*)g.A + (size_t)nxt.pm * tstep : cA; const char* nB = has_next ? (const char*)g.Bt + (size_t)nxt.pn * tstep : cB;
        for (int t = 0; t < nt; t += 2) {
            const bool last = (t == nt - 2);
            const char* a1 = cA + (size_t)(t + 1) * kstep;
            const char* a2 = last ? nA : cA + (size_t)(t + 2) * kstep; const char* b2 = last ? nB : cB + (size_t)(t + 2) * kstep;
            const char* a3 = a2 + kstep; const char* b3 = b2 + kstep;
            if (last && has_next) S.a_ready(nxt);
            if constexpr (SP2) {
            PG8_LDB(B0, 0, 0); PG8_LDB(B1, 0, 1); PG8_SCHED; PG8_LDA(At, 0, 0); PG8_STAGE(PG8_SA(1, 1), a1 + hstep, voffA);
            PG8_WAIT_V(8); PG8_WAIT_L(0); PG8_BAR; PG8_MMA(0, 0, At, B0); PG8_MMA(0, 1, At, B1); PG8_BAR; PG8_SCHED;
            PG8_LDA(At, 0, 1); PG8_STAGE(PG8_SB(0, 0), b2, voffB); PG8_STAGE(PG8_SB(0, 1), b2 + hstep, voffB); PG8_STAGE(PG8_SA(0, 0), a2, voffA);
            PG8_WAIT_V(8); PG8_WAIT_L(0); PG8_BAR; PG8_MMA(1, 0, At, B0); PG8_MMA(1, 1, At, B1); PG8_BAR; PG8_SCHED;
            PG8_LDB(B0, 1, 0); PG8_LDB(B1, 1, 1); PG8_SCHED; PG8_LDA(At, 1, 0); PG8_STAGE(PG8_SA(0, 1), a2 + hstep, voffA);
            PG8_WAIT_V(8); PG8_WAIT_L(0); PG8_BAR; PG8_MMA(0, 0, At, B0); PG8_MMA(0, 1, At, B1); PG8_BAR; PG8_SCHED;
            PG8_LDA(At, 1, 1); PG8_STAGE(PG8_SB(1, 0), b3, voffB); PG8_STAGE(PG8_SB(1, 1), b3 + hstep, voffB); PG8_STAGE(PG8_SA(1, 0), a3, voffA);
            PG8_WAIT_V(8); PG8_WAIT_L(0); PG8_BAR; PG8_MMA(1, 0, At, B0); PG8_MMA(1, 1, At, B1); PG8_BAR; PG8_SCHED;
            } else {
            PG8_LDB(B0, 0, 0); PG8_SCHED; PG8_LDA(At, 0, 0); PG8_STAGE(PG8_SA(1, 1), a1 + hstep, voffA);
            PG8_WAIT_L(8); PG8_BAR; PG8_WAIT_L(0); PG8_MMA(0, 0, At, B0); PG8_BAR; PG8_SCHED;
            PG8_LDB(B1, 0, 1); PG8_STAGE(PG8_SB(0, 0), b2, voffB);
            PG8_BAR; PG8_WAIT_L(0); PG8_MMA(0, 1, At, B1); PG8_BAR;
            PG8_LDA(At, 0, 1); PG8_STAGE(PG8_SA(0, 0), a2, voffA);
            PG8_BAR; PG8_WAIT_L(0); PG8_MMA(1, 0, At, B0); PG8_BAR; PG8_SCHED;
            PG8_STAGE(PG8_SB(0, 1), b2 + hstep, voffB);
            PG8_WAIT_V(6); PG8_BAR; PG8_MMA(1, 1, At, B1); PG8_BAR;
            PG8_LDB(B0, 1, 0); PG8_SCHED; PG8_LDA(At, 1, 0); PG8_STAGE(PG8_SA(0, 1), a2 + hstep, voffA);
            PG8_WAIT_L(8); PG8_BAR; PG8_WAIT_L(0); PG8_MMA(0, 0, At, B0); PG8_BAR; PG8_SCHED;
            PG8_LDB(B1, 1, 1); PG8_STAGE(PG8_SB(1, 0), b3, voffB);
            PG8_BAR; PG8_WAIT_L(0); PG8_MMA(0, 1, At, B1); PG8_BAR;
            PG8_LDA(At, 1, 1); PG8_STAGE(PG8_SA(1, 0), a3, voffA);
            PG8_BAR; PG8_WAIT_L(0); PG8_MMA(1, 0, At, B0); PG8_BAR; PG8_SCHED;
            PG8_STAGE(PG8_SB(1, 1), b3 + hstep, voffB);
            PG8_WAIT_V(6); PG8_BAR; PG8_MMA(1, 1, At, B1); PG8_BAR;
            }
        }
        if constexpr (ALIGN_EPI) { if (wr == 0) PG8_BAR; }
        if constexpr (!Epi::AFTER_DRAIN) { E(acc, cur, wr, wc, fr, fq); S.done(cur); }
        if (!has_next) break;
#pragma unroll
        for (int a = 0; a < 2; ++a)
#pragma unroll
            for (int b = 0; b < 2; ++b)
#pragma unroll
                for (int m = 0; m < 4; ++m)
#pragma unroll
                    for (int n = 0; n < 2; ++n) acc[a][b][m][n] = (f32x4){0.f, 0.f, 0.f, 0.f};
        cur = nxt; cA = nA; cB = nB; ++ui;
        if constexpr (ALIGN_EPI) { if (wr == 1) PG8_BAR; }
    }
    PG8_WAIT_V(0);
    if constexpr (!ALIGN_EPI) { if (wr == 0) PG8_BAR; }
    PG8_BAR;
    if constexpr (Epi::AFTER_DRAIN) { E.fused(acc, cur, wr, wc, fr, fq, lds, wid, lane); S.done(cur); }
#undef PG8_SA
#undef PG8_SB
#undef PG8_STAGE
#undef PG8_LDA
#undef PG8_LDB
#undef PG8_MMA
#undef PG8_WAIT_V
#undef PG8_WAIT_L
#undef PG8_BAR
#undef PG8_SCHED
}
}

#define DI __device__ __forceinline__
#define GAS __attribute__((address_space(1)))
#define LAS __attribute__((address_space(3)))
typedef unsigned short bf16;
typedef unsigned v4u __attribute__((ext_vector_type(4)));
typedef unsigned v2u __attribute__((ext_vector_type(2)));
typedef int v4i __attribute__((ext_vector_type(4)));
typedef float f32x4 __attribute__((ext_vector_type(4)));
typedef float f32x2 __attribute__((ext_vector_type(2)));
typedef float f32x16 __attribute__((ext_vector_type(16)));
typedef short bf16x8 __attribute__((ext_vector_type(8)));
typedef short s16x4 __attribute__((ext_vector_type(4)));

constexpr int D = 2048, T = 8192, BS = 128, FF = 5632;
constexpr int NA = 8192;
constexpr int NBR = 5264, NB = 5376;
constexpr int PAST = 2048, PAGE = 128, NPAGES = 16, TOPK = 256;
constexpr int SPAD = 192, DS_ = D + SPAD, FFS_ = FF + SPAD;
constexpr int SCS_LD = 2112;
constexpr float EPS = 1e-6f;
constexpr int NWAVES = 8, NTHR = 512;
constexpr int NPHASE = 15;
#ifndef MK_ONE_LAUNCH
#define MK_ONE_LAUNCH 1
#endif

constexpr size_t MiB = 1u << 20;
constexpr size_t WS_CTL = 0, CTL_ZERO_BYTES = 1 * MiB;
constexpr size_t WS_LB0 = 1 * MiB;
constexpr size_t WS_LUT = 1 * MiB + 65536;
constexpr size_t WS_SSQ = 1 * MiB + 131072;
constexpr size_t WS_WA_IN = 2 * MiB, WS_WA_OUT = 34 * MiB, WS_WGU0 = 42 * MiB, WS_WD0 = 86 * MiB, WS_WB_IN = 108 * MiB, WS_WB_OUT = 130 * MiB, WS_WGU1 = 138 * MiB, WS_WD1 = 182 * MiB;
constexpr size_t WS_HP = 204 * MiB, WS_ZQ = 236 * MiB, WS_ZK = 268 * MiB, WS_ZV = 300 * MiB, WS_ZG = 332 * MiB, WS_LF = 364 * MiB, WS_QG = 428 * MiB, WS_OL = 460 * MiB;
constexpr size_t WS_DS = 524 * MiB, WS_DSC = 540 * MiB, WS_OG = 542 * MiB, WS_Y1 = 574 * MiB, WS_HID = 638 * MiB, WS_Y2 = 726 * MiB, WS_Y3 = 790 * MiB;
constexpr size_t WS_QRAW = 854 * MiB, WS_QIB = 886 * MiB, WS_KRAW = 918 * MiB, WS_KIRAW = 934 * MiB, WS_WI = 938 * MiB, WS_KB = 940 * MiB, WS_VB = 948 * MiB, WS_KIB = 956 * MiB;
constexpr size_t WS_SC = 960 * MiB, WS_IDX = 1216 * MiB, WS_OATT = 1224 * MiB;
constexpr size_t WS_HS = 1256 * MiB, WS_RS1 = 1257 * MiB, WS_OGS = 1261 * MiB, WS_Y1S = 1262 * MiB, WS_HIDS = 1263 * MiB, WS_Y2S = 1265 * MiB, WS_R5S = 1266 * MiB;
constexpr size_t WS_QNS = 1269 * MiB, WS_SCS = 1270 * MiB, WS_IDXS = 1272 * MiB, WS_OATTS = 1273 * MiB, WS_Y3S = 1274 * MiB, WS_K8 = 1276 * MiB, WS_V8 = 1280 * MiB, WS_END = 1284 * MiB;

constexpr size_t O_YP = 0, O_YS = O_YP + (size_t)T * D, O_SP = O_YS + (size_t)BS * D, O_SS = O_SP + 16 * 128 * 128, O_KP = O_SS + (size_t)BS * 16 * 128 * 128;
constexpr size_t O_VP = O_KP + (size_t)T * 512, O_KIP = O_VP + (size_t)T * 512, O_KS = O_KIP + (size_t)T * 128, O_VS = O_KS + BS * 512, O_KIS = O_VS + BS * 512, O_END = O_KIS + BS * 128;

constexpr int CW_TMO = 0, CW_BAR = 4096;

constexpr int RING_BYTES = 131072, WSLAB = 16640  , LUT_OFF = NWAVES * WSLAB  , LUT_BYTES = 129 * 16 * 4  , MISC_OFF = 141440, LDS_BYTES = 147456;
static_assert(LUT_OFF >= RING_BYTES && LUT_OFF + LUT_BYTES <= MISC_OFF && MISC_OFF + 256 <= LDS_BYTES, "LDS map");

struct Args { const void* in[21]; float* out; unsigned char* ws; int ph_lo, ph_hi, li, pad; };

DI float bf2f(unsigned b) { return __uint_as_float(b << 16); }
typedef __bf16 bf16x2_t __attribute__((ext_vector_type(2)));
DI unsigned pk2(float lo, float hi) { const f32x2 v = {lo, hi}; return __builtin_bit_cast(unsigned, __builtin_convertvector(v, bf16x2_t)); }
DI float wave_sum(float v) {
#pragma unroll
    for (int o = 1; o < 64; o <<= 1) v += __shfl_xor(v, o);
    return v;
}
DI float grp16_sum(float v) {
#pragma unroll
    for (int o = 1; o < 16; o <<= 1) v += __shfl_xor(v, o);
    return v;
}
DI float sigm(float x) { return 1.f / (1.f + __expf(-x)); }
DI float silu(float x) { return x / (1.f + __expf(-x)); }
#define LDS_WAIT() asm volatile("s_waitcnt lgkmcnt(0)" ::: "memory")
#define VM_WAIT() asm volatile("s_waitcnt vmcnt(0)" ::: "memory")
#define MFMA16(a, b, c) __builtin_amdgcn_mfma_f32_16x16x32_bf16((a), (b), (c), 0, 0, 0)
#define MFMA32(a, b, c) __builtin_amdgcn_mfma_f32_32x32x16_bf16((a), (b), (c), 0, 0, 0)
DI bf16x8 pack8(const f32x4& a, const f32x4& b) { v4u w; w.x = pk2(a[0], a[1]); w.y = pk2(a[2], a[3]); w.z = pk2(b[0], b[1]); w.w = pk2(b[2], b[3]); return __builtin_bit_cast(bf16x8, w); }
DI bf16x8 pack8f(const float* p) { v4u w; w.x = pk2(p[0], p[1]); w.y = pk2(p[2], p[3]); w.z = pk2(p[4], p[5]); w.w = pk2(p[6], p[7]); return __builtin_bit_cast(bf16x8, w); }
static_assert(WS_ZK - WS_ZQ == (size_t)T * D * 2 && WS_ZV - WS_ZK == (size_t)T * D * 2 && WS_ZG - WS_ZV == (size_t)T * D * 2, "ZQ|ZK|ZV|ZG consecutive");

DI void rmsnorm_row(const float* x, const float* g, bf16* o, int lane) {
    const f32x4* xr = (const f32x4*)x + lane; const f32x4* gr = (const f32x4*)g + lane;
    f32x4 v[8]; float s = 0.f;
#pragma unroll
    for (int j = 0; j < 8; ++j) { v[j] = xr[64 * j]; s += (v[j].x * v[j].x + v[j].y * v[j].y) + (v[j].z * v[j].z + v[j].w * v[j].w); }
    const float rs = rsqrtf(wave_sum(s) * (1.f / D) + EPS);
    v2u* o8 = (v2u*)o + lane;
#pragma unroll
    for (int j = 0; j < 8; ++j) { const f32x4 gg = gr[64 * j]; v2u w; w.x = pk2(v[j].x * rs * gg.x, v[j].y * rs * gg.y); w.y = pk2(v[j].z * rs * gg.z, v[j].w * rs * gg.w); o8[64 * j] = w; }
}

struct TrItem { const float* W; bf16* WT; int K, N, mode, item; };
DI void tr_load(const TrItem& t, int lane, f32x4 (&r)[16]) {
    const int nblk = (t.N + 63) / 64, kb = t.item / nblk, nb = t.item % nblk, k0 = 64 * kb, n0 = 64 * nb, nq = lane & 15;
    const bool ok = n0 + 4 * nq < t.N;
    const float* p = t.W + (size_t)(k0 + (lane >> 4)) * t.N + n0 + 4 * nq;
#pragma unroll
    for (int i = 0; i < 16; ++i) r[i] = ok ? __builtin_nontemporal_load((const f32x4*)(p + (size_t)(4 * i) * t.N)) : (f32x4){0.f, 0.f, 0.f, 0.f};
}
DI void tr_store(const TrItem& t, int lane, const f32x4 (&r)[16], LAS float* scr) {
    const int nblk = (t.N + 63) / 64, kb = t.item / nblk, nb = t.item % nblk, k0 = 64 * kb, n0 = 64 * nb, nq = lane & 15;
#pragma unroll
    for (int i = 0; i < 16; ++i) { LAS float* d = scr + (4 * i + (lane >> 4)) * 65 + 4 * nq; d[0] = r[i][0]; d[1] = r[i][1]; d[2] = r[i][2]; d[3] = r[i][3]; }
    LDS_WAIT(); asm volatile("" ::: "memory");
    int row0 = n0;
    if (t.mode == 1) { row0 = (n0 < FF) ? 256 * (n0 / 128) + (n0 % 128) : 256 * ((n0 - FF) / 128) + 128 + ((n0 - FF) % 128); }
    const int c = lane & 7;
#pragma unroll
    for (int j = 0; j < 8; ++j) { const int n = (lane >> 3) + 8 * j; const LAS float* s = scr + (8 * c) * 65 + n;
        v4u o; o.x = pk2(s[0 * 65], s[1 * 65]); o.y = pk2(s[2 * 65], s[3 * 65]); o.z = pk2(s[4 * 65], s[5 * 65]); o.w = pk2(s[6 * 65], s[7 * 65]);
        *(v4u*)(t.WT + (size_t)(row0 + n) * t.K + k0 + 8 * c) = o; }
    LDS_WAIT(); asm volatile("" ::: "memory");
}

#define EPI_LOOP_BEGIN  _Pragma("unroll") for (int ai = 0; ai < 2; ++ai) _Pragma("unroll") for (int m = 0; m < 4; ++m) { const int row = u.pm * 256 + ai * 128 + wr * 64 + m * 16 + fr;
#define EPI_LOOP_END }

struct EpiA {
    static constexpr bool PERM = true, AFTER_DRAIN = false;
    bf16* zq; float* lf; const float* lb0;
    DI void operator()(const f32x4 (&acc)[2][2][4][2], const pg8::Unit& u, int wr, int wc, int fr, int fq) const {
        const int ty = u.pn >> 3, cbase = (u.pn & 7) * 256 + wc * 32 + 8 * fq;
        if (ty == 1) {
            f32x4 lbv[2][2];
#pragma unroll
            for (int bj = 0; bj < 2; ++bj) { lbv[bj][0] = *(const f32x4*)(lb0 + cbase + bj * 128); lbv[bj][1] = *(const f32x4*)(lb0 + cbase + bj * 128 + 4); }
            EPI_LOOP_BEGIN
#pragma unroll
                for (int bj = 0; bj < 2; ++bj) { const size_t o = (size_t)row * D + cbase + bj * 128; f32x4 lg[2], kk[2];
#pragma unroll
                    for (int n = 0; n < 2; ++n)
#pragma unroll
                        for (int e = 0; e < 4; ++e) { const float f = fminf(fmaxf(acc[ai][bj][m][n][e], -30.f), 30.f), lb = lbv[bj][n][e], ef = __expf(-f), sg = 1.f / (1.f + ef), sgn = ef / (1.f + ef);
                            lg[n][e] = __logf(lb + (1.f - lb) * sg); kk[n][e] = (1.f - lb) * sgn; }
                    *(f32x4*)(lf + o) = lg[0]; *(f32x4*)(lf + o + 4) = lg[1]; *(bf16x8*)(zq + (size_t)T * D + o) = pack8(kk[0], kk[1]); }
            EPI_LOOP_END
        } else {
            bf16* dst = zq + (size_t)ty * T * D;
            EPI_LOOP_BEGIN
#pragma unroll
                for (int bj = 0; bj < 2; ++bj) { const size_t o = (size_t)row * D + cbase + bj * 128; f32x4 a = acc[ai][bj][m][0], b = acc[ai][bj][m][1];
                    if (ty != 2) {
#pragma unroll
                        for (int e = 0; e < 4; ++e) { a[e] = silu(a[e]); b[e] = silu(b[e]); } }
                    *(bf16x8*)(dst + o) = pack8(a, b); }
            EPI_LOOP_END
        }
    }
};
template <bool RESB, bool OUTB>
struct EpiRes {
    static constexpr bool PERM = true, AFTER_DRAIN = false;
    const void* res; void* out; const float* gain; bf16* hp; float* ssq;
    DI void operator()(const f32x4 (&acc)[2][2][4][2], const pg8::Unit& u, int wr, int wc, int fr, int fq) const {
        const int cbase = u.pn * 256 + wc * 32 + 8 * fq;
        f32x4 gv[2][2];
        if (gain) {
#pragma unroll
            for (int bj = 0; bj < 2; ++bj) { gv[bj][0] = *(const f32x4*)(gain + cbase + bj * 128); gv[bj][1] = *(const f32x4*)(gain + cbase + bj * 128 + 4); } }
#pragma unroll
        for (int ai = 0; ai < 2; ++ai) {
            f32x4 rr[4][2][2];
#pragma unroll
            for (int m = 0; m < 4; ++m)
#pragma unroll
                for (int bj = 0; bj < 2; ++bj) { const size_t o = (size_t)(u.pm * 256 + ai * 128 + wr * 64 + m * 16 + fr) * D + cbase + bj * 128;
                    if (RESB) { const v4u w = *(const v4u*)((const bf16*)res + o);
                        rr[m][bj][0] = (f32x4){bf2f(w.x & 0xffffu), bf2f(w.x >> 16), bf2f(w.y & 0xffffu), bf2f(w.y >> 16)}; rr[m][bj][1] = (f32x4){bf2f(w.z & 0xffffu), bf2f(w.z >> 16), bf2f(w.w & 0xffffu), bf2f(w.w >> 16)}; }
                    else { rr[m][bj][0] = *(const f32x4*)((const float*)res + o); rr[m][bj][1] = *(const f32x4*)((const float*)res + o + 4); } }
#pragma unroll
            for (int m = 0; m < 4; ++m) { const int row = u.pm * 256 + ai * 128 + wr * 64 + m * 16 + fr;
                float sq = 0.f;
#pragma unroll
                for (int bj = 0; bj < 2; ++bj) { const size_t o = (size_t)row * D + cbase + bj * 128;
                    const f32x4 y0 = acc[ai][bj][m][0] + rr[m][bj][0], y1 = acc[ai][bj][m][1] + rr[m][bj][1];
                    if (OUTB) *(bf16x8*)((bf16*)out + o) = pack8(y0, y1); else { __builtin_nontemporal_store(y0, (f32x4*)((float*)out + o)); __builtin_nontemporal_store(y1, (f32x4*)((float*)out + o + 4)); }
                    if (gain) { *(bf16x8*)(hp + o) = pack8(y0 * gv[bj][0], y1 * gv[bj][1]);
                        sq += (y0[0] * y0[0] + y0[1] * y0[1]) + (y0[2] * y0[2] + y0[3] * y0[3]) + (y1[0] * y1[0] + y1[1] * y1[1]) + (y1[2] * y1[2] + y1[3] * y1[3]); } }
                if (gain) { sq += __shfl_xor(sq, 16); sq += __shfl_xor(sq, 32); if (fq == 0) atomicAdd(ssq + row, sq); }
            }
        }
    }
};
struct EpiSwiglu {
    static constexpr bool PERM = true, AFTER_DRAIN = false;
    bf16* hid; const float* ssq;
    DI void operator()(const f32x4 (&acc)[2][2][4][2], const pg8::Unit& u, int wr, int wc, int fr, int fq) const {
        const int cbase = u.pn * 128 + wc * 32 + 8 * fq;
        EPI_LOOP_BEGIN
            const float rs = rsqrtf(ssq[row] * (1.f / D) + EPS);
            f32x4 a = acc[ai][0][m][0], b = acc[ai][0][m][1]; const f32x4 ua = acc[ai][1][m][0], ub = acc[ai][1][m][1];
#pragma unroll
            for (int e = 0; e < 4; ++e) { a[e] = silu(a[e] * rs) * (ua[e] * rs); b[e] = silu(b[e] * rs) * (ub[e] * rs); }
            *(bf16x8*)(hid + (size_t)row * FF + cbase) = pack8(a, b);
        EPI_LOOP_END
    }
};
struct EpiB {
    static constexpr bool PERM = true, AFTER_DRAIN = false;
    bf16 *qraw, *qib, *vb; float *kraw, *vout, *kiraw, *wi; const float* ssq;
    DI void operator()(const f32x4 (&acc_)[2][2][4][2], const pg8::Unit& u, int wr, int wc, int fr, int fq) const {
        const int pn = u.pn, ct = wc * 32 + 8 * fq;
        f32x4 acc[2][2][4][2];
#pragma unroll
        for (int ai = 0; ai < 2; ++ai)
#pragma unroll
            for (int m = 0; m < 4; ++m) { const float rs = rsqrtf(ssq[u.pm * 256 + ai * 128 + wr * 64 + m * 16 + fr] * (1.f / D) + EPS);
#pragma unroll
                for (int bj = 0; bj < 2; ++bj) { acc[ai][bj][m][0] = acc_[ai][bj][m][0] * rs; acc[ai][bj][m][1] = acc_[ai][bj][m][1] * rs; } }
        if (pn < 8 || (pn >= 12 && pn < 20)) {
            bf16* dst = pn < 8 ? qraw : qib; const int cbase = (pn < 8 ? pn : pn - 12) * 256 + ct;
            EPI_LOOP_BEGIN
#pragma unroll
                for (int bj = 0; bj < 2; ++bj) *(bf16x8*)(dst + (size_t)row * D + cbase + bj * 128) = pack8(acc[ai][bj][m][0], acc[ai][bj][m][1]);
            EPI_LOOP_END
        } else if (pn < 10) {
            const int cbase = (pn - 8) * 256 + ct;
            EPI_LOOP_BEGIN
#pragma unroll
                for (int bj = 0; bj < 2; ++bj) { float* p = kraw + (size_t)row * 512 + cbase + bj * 128; *(f32x4*)p = acc[ai][bj][m][0]; *(f32x4*)(p + 4) = acc[ai][bj][m][1]; }
            EPI_LOOP_END
        } else if (pn < 12) {
            const int cbase = (pn - 10) * 256 + ct;
            EPI_LOOP_BEGIN
#pragma unroll
                for (int bj = 0; bj < 2; ++bj) { const size_t o = (size_t)row * 512 + cbase + bj * 128; __builtin_nontemporal_store(acc[ai][bj][m][0], (f32x4*)(vout + o)); __builtin_nontemporal_store(acc[ai][bj][m][1], (f32x4*)(vout + o + 4));
                    *(bf16x8*)(vb + o) = pack8(acc[ai][bj][m][0], acc[ai][bj][m][1]); }
            EPI_LOOP_END
        } else {
            const float wsc = 0.25f * 0.08838834764831845f;
            EPI_LOOP_BEGIN
                { float* p = kiraw + (size_t)row * 128 + ct; *(f32x4*)p = acc[ai][0][m][0]; *(f32x4*)(p + 4) = acc[ai][0][m][1]; }
                if (ct < 16) { float* p = wi + (size_t)row * 16 + ct; *(f32x4*)p = acc[ai][1][m][0] * wsc; *(f32x4*)(p + 4) = acc[ai][1][m][1] * wsc; }
            EPI_LOOP_END
        }
    }
};

template <int V> struct IntC { static constexpr int value = V; };
template <int S, int E, class LF> DI void skg_prime(const LF& L) { if constexpr (S < E) { L(IntC<S>{}); skg_prime<S + 1, E>(L); } }
template <int S, int NST, int NS, class LF, class MF>
DI void skg_stages(const LF& L, const MF& M) {
    if constexpr (S == 0) { skg_prime<0, (NS - 1 < NST ? NS - 1 : NST)>(L); }
    if constexpr (S < NST) {
        if constexpr (S + NS - 1 < NST) L(IntC<S + NS - 1>{});
        __builtin_amdgcn_sched_barrier(0);
        M(IntC<S>{});
        __builtin_amdgcn_sched_barrier(0);
        skg_stages<S + 1, NST, NS>(L, M);
    }
}
struct SkNorm { const float* ssq_in; const float* gain; bf16* hs; float* ssq_out; };
template <int MODE, int RT, int CT, int K>
DI void skinny_gemm(LAS unsigned char* lds, const bf16* A, int lda, const bf16* Bt, int ncb, float* out, const float* res, int ldo, bf16* hid, int bid, int G, int tid, int c0 = 0  , const SkNorm nrm = SkNorm{nullptr, nullptr, nullptr, nullptr}) {
    constexpr int R = 32 * RT, NRB = 128 / R, C = 16 * CT, LP = 36;
    constexpr int KSN = 8, RTW = 2 * RT, NPASS = CT / 2;
    static_assert(CT % 2 == 0 && 8 * R * LP * 4 <= 80 * 1024, "skinny_gemm: unit shape");
    const int wave = __builtin_amdgcn_readfirstlane(tid >> 6), lane = tid & 63, ks = wave, rh = 0, g = lane >> 4, lr = lane & 15;
    constexpr int Ks = K / KSN; const int nunits = ncb * NRB;
    LAS float* red = (LAS float*)lds;
    for (int u = bid - c0; u < nunits; u += G - c0) {
        if (u < 0) break;
        const int x8 = u & 7, j8 = u >> 3; const bool xo = (ncb & 7) == 0;
        const int cb = xo ? (j8 / NRB) * 8 + x8 : u / NRB, rb = xo ? j8 % NRB : u % NRB;
        int brow[CT];
#pragma unroll
        for (int ct = 0; ct < CT; ++ct) {
            if (MODE == 0) brow[ct] = C * cb + 16 * ct;
            else { const int h0 = (C / 2) * cb, pn = h0 >> 7, off = h0 & 127; brow[ct] = 256 * pn + off + (ct < CT / 2 ? 16 * ct : 128 + 16 * (ct - CT / 2)); }
        }
        f32x4 acc[RTW][CT];
#pragma unroll
        for (int rt = 0; rt < RTW; ++rt)
#pragma unroll
            for (int ct = 0; ct < CT; ++ct) acc[rt][ct] = (f32x4){0.f, 0.f, 0.f, 0.f};
        const bf16* ap = A + (size_t)(rb * R + rh * 16 * RTW + lr) * lda + 64 * ks + 16 * g;
        const bf16* bp = Bt + (size_t)lr * K + 64 * ks + 16 * g;
        constexpr int SK = 2, NST = Ks / (32 * SK), LPS = (RTW + CT) * SK, NS = (LPS * 4 <= 36) ? 4 : ((LPS * 3 <= 40) ? 3 : 2);
        static_assert(Ks % (32 * SK) == 0, "skinny_gemm: K quarter must be a whole number of stages");
        bf16x8 rga[NS][SK][RTW], rgb[NS][SK][CT];
#define SKG_LOAD(st) do { constexpr int s0_ = (st) * 32 * KSN * SK, sl_ = (st) % NS; _Pragma("unroll") for (int k_ = 0; k_ < SK; ++k_) { \
            _Pragma("unroll") for (int rt = 0; rt < RTW; ++rt) rga[sl_][k_][rt] = *(const bf16x8*)(ap + (size_t)(16 * rt) * lda + s0_ + 64 * KSN * (k_ >> 1) + 8 * (k_ & 1)); \
            _Pragma("unroll") for (int ct = 0; ct < CT; ++ct) rgb[sl_][k_][ct] = *(const bf16x8*)(bp + (size_t)brow[ct] * K + s0_ + 64 * KSN * (k_ >> 1) + 8 * (k_ & 1)); } } while (0)
#define SKG_MMA(st) do { constexpr int sl_ = (st) % NS; _Pragma("unroll") for (int k_ = 0; k_ < SK; ++k_) _Pragma("unroll") for (int rt = 0; rt < RTW; ++rt) _Pragma("unroll") for (int ct = 0; ct < CT; ++ct) \
            acc[rt][ct] = MFMA16(rga[sl_][k_][rt], rgb[sl_][k_][ct], acc[rt][ct]); } while (0)
        skg_stages<0, NST, NS>([&](auto st_) { constexpr int st = decltype(st_)::value; SKG_LOAD(st); }, [&](auto st_) { constexpr int st = decltype(st_)::value; SKG_MMA(st); });
#undef SKG_LOAD
#undef SKG_MMA
#pragma unroll
        for (int ps = 0; ps < NPASS; ++ps) {
            const int t0 = MODE == 0 ? 2 * ps : ps, t1 = MODE == 0 ? 2 * ps + 1 : ps + CT / 2;
#pragma unroll
            for (int rt = 0; rt < RTW; ++rt)
#pragma unroll
                for (int i = 0; i < 4; ++i) { red[(ks * R + 16 * rt + 4 * g + i) * LP + lr] = acc[rt][t0][i]; red[(ks * R + 16 * rt + 4 * g + i) * LP + 16 + lr] = acc[rt][t1][i]; }
            __syncthreads();
            if (MODE == 0) {
                for (int it = tid; it < R * 4; it += NTHR) {
                    const int rl = it >> 2, q = it & 3, row = rb * R + rl;
                    f32x4 s0 = (f32x4){0.f, 0.f, 0.f, 0.f}, s1 = s0;
#pragma unroll
                    for (int k = 0; k < KSN; ++k) { const LAS float* p = red + (k * R + rl) * LP + 8 * q; s0 += *(const LAS f32x4*)p; s1 += *(const LAS f32x4*)(p + 4); }
                    const int col = C * cb + 32 * ps + 8 * q; const size_t o = (size_t)row * ldo + col;
                    if (nrm.ssq_in) { const float rs = rsqrtf(nrm.ssq_in[row] * (1.f / D) + EPS); s0 = s0 * rs; s1 = s1 * rs; }
                    if (res) { s0 += *(const f32x4*)(res + o); s1 += *(const f32x4*)(res + o + 4); }
                    *(f32x4*)(out + o) = s0; *(f32x4*)(out + o + 4) = s1;
                    if (nrm.gain) { const f32x4 g0 = *(const f32x4*)(nrm.gain + col), g1 = *(const f32x4*)(nrm.gain + col + 4);
                        *(bf16x8*)(nrm.hs + (size_t)row * DS_ + col) = pack8(s0 * g0, s1 * g1);
                        float sq = (s0[0] * s0[0] + s0[1] * s0[1]) + (s0[2] * s0[2] + s0[3] * s0[3]) + (s1[0] * s1[0] + s1[1] * s1[1]) + (s1[2] * s1[2] + s1[3] * s1[3]);
                        sq += __shfl_xor(sq, 1); sq += __shfl_xor(sq, 2);
                        if (q == 0) atomicAdd(nrm.ssq_out + row, sq); }
                }
            } else {
                for (int it = tid; it < R * 2; it += NTHR) {
                    const int rl = it >> 1, q = it & 1, row = rb * R + rl;
                    f32x4 g0 = (f32x4){0.f, 0.f, 0.f, 0.f}, g1 = g0, u0 = g0, u1 = g0;
#pragma unroll
                    for (int k = 0; k < KSN; ++k) { const LAS float* p = red + (k * R + rl) * LP + 8 * q; g0 += *(const LAS f32x4*)p; g1 += *(const LAS f32x4*)(p + 4); u0 += *(const LAS f32x4*)(p + 16); u1 += *(const LAS f32x4*)(p + 20); }
                    const float rs = nrm.ssq_in ? rsqrtf(nrm.ssq_in[row] * (1.f / D) + EPS) : 1.f;
#pragma unroll
                    for (int e = 0; e < 4; ++e) { g0[e] = silu(g0[e] * rs) * (u0[e] * rs); g1[e] = silu(g1[e] * rs) * (u1[e] * rs); }
                    *(bf16x8*)(hid + (size_t)row * FFS_ + (C / 2) * cb + 16 * ps + 8 * q) = pack8(g0, g1);
                }
            }
            __syncthreads();
        }
    }
}

constexpr int HA_QS = 0, HA_KS = 16 * 272, HA_KE = 2 * 16 * 272, HA_DEC = HA_KE + 128 * 32, HA_BUF = HA_DEC + 512;
DI void hgrn_passA(LAS unsigned char* lds, const bf16* ZQ, const bf16* ZK, const bf16* ZV, const float* LF, bf16* QG, float* OL, float* DS, float* DSC, int bid, int G, int tid) {
    const int wave = __builtin_amdgcn_readfirstlane(tid >> 6), lane = tid & 63, g = lane >> 4, lr = lane & 15;
    for (int u = bid; u < 256; u += G) {
        const int h = u >> 4, sc = u & 15, t0 = sc * 512, col = h * 128 + 16 * wave + lr;
        float gbase = 0.f;
        f32x4 S[8];
#pragma unroll
        for (int j = 0; j < 8; ++j) S[j] = (f32x4){0.f, 0.f, 0.f, 0.f};
        unsigned short aq[4], ak[4], av[4], bq[4], bk[4], bv[4]; float al[4], bl[4];
#define HA_FETCH(q_, k_, v_, l_, cc) do { _Pragma("unroll") for (int j = 0; j < 4; ++j) { const size_t o_ = (size_t)(t0 + 16 * (cc) + 4 * g + j) * D + col; q_[j] = ZQ[o_]; k_[j] = ZK[o_]; v_[j] = ZV[o_]; l_[j] = LF[o_]; } } while (0)
        HA_FETCH(aq, ak, av, al, 0); HA_FETCH(bq, bk, bv, bl, 1);
#pragma unroll 2
        for (int c = 0; c < 32; ++c) {
            LAS unsigned char* B = lds + (c & 1) * HA_BUF;
            float q[4], k[4], lfv[4]; unsigned short vv[4];
            if ((c & 1) == 0) {
#pragma unroll
                for (int j = 0; j < 4; ++j) { q[j] = bf2f(aq[j]); k[j] = bf2f(ak[j]); lfv[j] = al[j]; vv[j] = av[j]; }
                if (c + 2 < 32) HA_FETCH(aq, ak, av, al, c + 2);
            } else {
#pragma unroll
                for (int j = 0; j < 4; ++j) { q[j] = bf2f(bq[j]); k[j] = bf2f(bk[j]); lfv[j] = bl[j]; vv[j] = bv[j]; }
                if (c + 2 < 32) HA_FETCH(bq, bk, bv, bl, c + 2);
            }
            float cs[4]; cs[0] = lfv[0]; cs[1] = cs[0] + lfv[1]; cs[2] = cs[1] + lfv[2]; cs[3] = cs[2] + lfv[3];
            const float t1 = __shfl(cs[3], (lane + 48) & 63), t2 = __shfl(cs[3], (lane + 32) & 63), t3 = __shfl(cs[3], (lane + 16) & 63);
            const float pre = (g >= 1 ? t1 : 0.f) + (g >= 2 ? t2 : 0.f) + (g >= 3 ? t3 : 0.f);
            const float gend = __shfl(pre + cs[3], lr + 48);
            float ke[4];
#pragma unroll
            for (int j = 0; j < 4; ++j) {
                const float G_ = pre + cs[j], eg = __expf(G_), qs = q[j] * eg;
                const int t = 4 * g + j;
                *(LAS unsigned short*)(B + HA_QS + t * 272 + 2 * (16 * wave + lr)) = (unsigned short)(pk2(qs, 0.f) & 0xffffu);
                *(LAS unsigned short*)(B + HA_KS + t * 272 + 2 * (16 * wave + lr)) = (unsigned short)(pk2(k[j] * __expf(-G_), 0.f) & 0xffffu);
                ke[j] = k[j] * __expf(gend - G_);
                QG[(size_t)(t0 + 16 * c + t) * D + col] = (unsigned short)(pk2(qs * __expf(gbase), 0.f) & 0xffffu);
            }
            { v2u w; w.x = pk2(ke[0], ke[1]); w.y = pk2(ke[2], ke[3]); *(LAS v2u*)(B + HA_KE + (16 * wave + lr) * 32 + 8 * g) = w; }
            if (g == 0) *(LAS float*)(B + HA_DEC + 4 * (16 * wave + lr)) = __expf(gend);
            gbase += gend;
            LDS_WAIT(); __builtin_amdgcn_s_barrier(); asm volatile("" ::: "memory");
            bf16x8 vreg; { v4u w; w.x = (unsigned)vv[0] | ((unsigned)vv[1] << 16); w.y = (unsigned)vv[2] | ((unsigned)vv[3] << 16); w.z = 0u; w.w = 0u; vreg = __builtin_bit_cast(bf16x8, w); }
            f32x4 am = (f32x4){0.f, 0.f, 0.f, 0.f};
#pragma unroll
            for (int s = 0; s < 4; ++s) { const bf16x8 fa = *(const LAS bf16x8*)(B + HA_KS + lr * 272 + 64 * s + 16 * g), fb = *(const LAS bf16x8*)(B + HA_QS + lr * 272 + 64 * s + 16 * g); am = MFMA16(fa, fb, am); }
#pragma unroll
            for (int i = 0; i < 4; ++i) am[i] = (4 * g + i <= lr) ? am[i] : 0.f;
            bf16x8 afrag; { v4u w; w.x = pk2(am[0], am[1]); w.y = pk2(am[2], am[3]); w.z = 0u; w.w = 0u; afrag = __builtin_bit_cast(bf16x8, w); }
            f32x4 o = MFMA16(afrag, vreg, ((f32x4){0.f, 0.f, 0.f, 0.f}));
#pragma unroll
            for (int s = 0; s < 4; ++s) {
                const v2u lo = *(const LAS v2u*)(B + HA_QS + lr * 272 + 2 * (32 * s + 4 * g)), hi = *(const LAS v2u*)(B + HA_QS + lr * 272 + 2 * (32 * s + 16 + 4 * g));
                v4u w; w.x = lo.x; w.y = lo.y; w.z = hi.x; w.w = hi.y;
                o = MFMA16(__builtin_bit_cast(bf16x8, w), pack8(S[2 * s], S[2 * s + 1]), o);
            }
            *(f32x4*)(OL + ((((size_t)(h * 16 + sc) * 32 + c) * 8 + wave) * 64 + lane) * 4) = o;
#pragma unroll
            for (int j = 0; j < 8; ++j) {
                const f32x4 dj = *(const LAS f32x4*)(B + HA_DEC + 4 * (16 * j + 4 * g));
                const v2u kf = *(const LAS v2u*)(B + HA_KE + (16 * j + lr) * 32 + 8 * g);
                v4u w; w.x = kf.x; w.y = kf.y; w.z = 0u; w.w = 0u;
                S[j] = MFMA16(__builtin_bit_cast(bf16x8, w), vreg, S[j] * dj);
            }
        }
#undef HA_FETCH
#pragma unroll
        for (int j = 0; j < 8; ++j)
#pragma unroll
            for (int i = 0; i < 4; ++i) DS[((size_t)(h * 16 + sc) * 128 + 16 * j + 4 * g + i) * 128 + 16 * wave + lr] = S[j][i];
        if (g == 0) DSC[(h * 16 + sc) * 128 + 16 * wave + lr] = __expf(gbase);
        LDS_WAIT(); __builtin_amdgcn_s_barrier(); asm volatile("" ::: "memory");
    }
}

constexpr int HC_SINT = 0, HC_STG = 128 * 272  , HC_STG_W = 16 * 528;
DI void hgrn_passC(LAS unsigned char* lds, const bf16* QG, const float* OL, const float* DS, const float* DSC, const bf16* ZG, const float* gnorm, bf16* OG, float* state_out, int bid, int G, int tid) {
    const int wave = __builtin_amdgcn_readfirstlane(tid >> 6), lane = tid & 63, g = lane >> 4, lr = lane & 15;
    for (int u = bid; u < 256; u += G) {
        const int h = u >> 4, sc = u & 15, t0 = sc * 512, cb = h * 128;
        f32x4 S[8];
#pragma unroll
        for (int j = 0; j < 8; ++j) S[j] = (f32x4){0.f, 0.f, 0.f, 0.f};
        const int nprev = (sc == 15) ? 16 : sc;
        for (int p = 0; p < nprev; ++p) {
#pragma unroll
            for (int j = 0; j < 8; ++j) {
                const f32x4 d = *(const f32x4*)(DSC + (h * 16 + p) * 128 + 16 * j + 4 * g);
#pragma unroll
                for (int i = 0; i < 4; ++i) S[j][i] = S[j][i] * d[i] + DS[((size_t)(h * 16 + p) * 128 + 16 * j + 4 * g + i) * 128 + 16 * wave + lr];
            }
            if (p == 14 && sc == 15) {
#pragma unroll
                for (int j = 0; j < 8; ++j) { v2u w; w.x = pk2(S[j][0], S[j][1]); w.y = pk2(S[j][2], S[j][3]); *(LAS v2u*)(lds + HC_SINT + (16 * wave + lr) * 272 + 2 * (16 * j + 4 * g)) = w; }
            }
        }
        if (sc == 15) {
#pragma unroll
            for (int j = 0; j < 8; ++j)
#pragma unroll
                for (int i = 0; i < 4; ++i) state_out[((size_t)h * 128 + 16 * j + 4 * g + i) * 128 + 16 * wave + lr] = S[j][i];
        } else {
#pragma unroll
            for (int j = 0; j < 8; ++j) { v2u w; w.x = pk2(S[j][0], S[j][1]); w.y = pk2(S[j][2], S[j][3]); *(LAS v2u*)(lds + HC_SINT + (16 * wave + lr) * 272 + 2 * (16 * j + 4 * g)) = w; }
        }
        LDS_WAIT(); __builtin_amdgcn_s_barrier(); asm volatile("" ::: "memory");
        LAS float* stg = (LAS float*)(lds + HC_STG + wave * HC_STG_W);
        for (int c = wave; c < 32; c += 8) {
            bf16x8 a[4];
#pragma unroll
            for (int s = 0; s < 4; ++s) a[s] = *(const bf16x8*)(QG + (size_t)(t0 + 16 * c + lr) * D + cb + 32 * s + 8 * g);
            f32x4 o[8]; float ssq[4] = {0.f, 0.f, 0.f, 0.f};
#pragma unroll
            for (int vt = 0; vt < 8; ++vt) {
                f32x4 acc = *(const f32x4*)(OL + ((((size_t)(h * 16 + sc) * 32 + c) * 8 + vt) * 64 + lane) * 4);
#pragma unroll
                for (int s = 0; s < 4; ++s) acc = MFMA16(a[s], *(const LAS bf16x8*)(lds + HC_SINT + (16 * vt + lr) * 272 + 64 * s + 16 * g), acc);
                o[vt] = acc;
#pragma unroll
                for (int i = 0; i < 4; ++i) ssq[i] += acc[i] * acc[i];
            }
            float rs[4];
#pragma unroll
            for (int i = 0; i < 4; ++i) rs[i] = rsqrtf(grp16_sum(ssq[i]) * (1.f / 128.f) + EPS);
#pragma unroll
            for (int vt = 0; vt < 8; ++vt) { const float gn = gnorm[16 * vt + lr];
#pragma unroll
                for (int i = 0; i < 4; ++i) stg[(4 * g + i) * 132 + 16 * vt + lr] = o[vt][i] * rs[i] * gn; }
            LDS_WAIT(); asm volatile("" ::: "memory");
#pragma unroll
            for (int it = 0; it < 4; ++it) {
                const int ci = lane + 64 * it, r = ci >> 4, ch = ci & 15; const size_t go = (size_t)(t0 + 16 * c + r) * D + cb + 8 * ch;
                const f32x4 x0 = *(const LAS f32x4*)(stg + r * 132 + 8 * ch), x1 = *(const LAS f32x4*)(stg + r * 132 + 8 * ch + 4);
                const v4u gt = *(const v4u*)(ZG + go);
                f32x4 y0, y1; y0[0] = x0[0] * bf2f(gt.x & 0xffffu); y0[1] = x0[1] * bf2f(gt.x >> 16); y0[2] = x0[2] * bf2f(gt.y & 0xffffu); y0[3] = x0[3] * bf2f(gt.y >> 16);
                y1[0] = x1[0] * bf2f(gt.z & 0xffffu); y1[1] = x1[1] * bf2f(gt.z >> 16); y1[2] = x1[2] * bf2f(gt.w & 0xffffu); y1[3] = x1[3] * bf2f(gt.w >> 16);
                *(bf16x8*)(OG + go) = pack8(y0, y1);
            }
            LDS_WAIT(); asm volatile("" ::: "memory");
        }
        LDS_WAIT(); __builtin_amdgcn_s_barrier(); asm volatile("" ::: "memory");
    }
}

DI void hgrn_sample(LAS float* wsc, const float* RS1, const float* LB0, const float* st_in, float* st_out, const float* gnorm, bf16* OGS, int b, int h, int lane) {
    { const float* r = RS1 + (size_t)b * NA + h * 128 + 2 * lane;
      const f32x2 qr = *(const f32x2*)r, fr_ = *(const f32x2*)(r + 2048), lb = *(const f32x2*)(LB0 + h * 128 + 2 * lane);
#pragma unroll
      for (int e = 0; e < 2; ++e) { const float f = fminf(fmaxf(fr_[e], -30.f), 30.f), ef = __expf(-f), sg = 1.f / (1.f + ef), sgn = ef / (1.f + ef);
          wsc[2 * lane + e] = lb[e] + (1.f - lb[e]) * sg; wsc[128 + 2 * lane + e] = (1.f - lb[e]) * sgn; wsc[256 + 2 * lane + e] = silu(qr[e]); } }
    LDS_WAIT(); asm volatile("" ::: "memory");
    const int half = lane >> 5, c4 = lane & 31;
    const f32x4 iv = *(const f32x4*)(RS1 + (size_t)b * NA + 4096 + h * 128 + 4 * c4), gr = *(const f32x4*)(RS1 + (size_t)b * NA + 6144 + h * 128 + 4 * c4);
    const float* S0 = st_in + ((size_t)(b * 16 + h) * 128 + half) * 128 + 4 * c4; float* So = st_out + ((size_t)(b * 16 + h) * 128 + half) * 128 + 4 * c4;
    f32x4 o = (f32x4){0.f, 0.f, 0.f, 0.f};
    f32x4 ra[8], rb[8];
#define HS_LOAD(r_, bt) do { _Pragma("unroll") for (int i_ = 0; i_ < 8; ++i_) r_[i_] = __builtin_nontemporal_load((const f32x4*)(S0 + (size_t)(2 * (8 * (bt) + i_)) * 128)); } while (0)
#define HS_STEP(r_, bt) do { _Pragma("unroll") for (int i_ = 0; i_ < 8; ++i_) { const int k_ = 2 * (8 * (bt) + i_) + half; const float fg = wsc[k_], kk = wsc[128 + k_], qk = wsc[256 + k_]; \
        const f32x4 sn = r_[i_] * fg + iv * kk; o += sn * qk; __builtin_nontemporal_store(sn, (f32x4*)(So + (size_t)(2 * (8 * (bt) + i_)) * 128)); } } while (0)
    HS_LOAD(ra, 0);
#pragma unroll 1
    for (int bt = 0; bt < 8; bt += 2) {
        HS_LOAD(rb, bt + 1);
        __builtin_amdgcn_sched_barrier(0);
        HS_STEP(ra, bt);
        __builtin_amdgcn_sched_barrier(0);
        if (bt + 2 < 8) HS_LOAD(ra, bt + 2);
        __builtin_amdgcn_sched_barrier(0);
        HS_STEP(rb, bt + 1);
        __builtin_amdgcn_sched_barrier(0);
    }
#undef HS_LOAD
#undef HS_STEP
#pragma unroll
    for (int e = 0; e < 4; ++e) o[e] += __shfl_xor(o[e], 32);
    float ss = (o[0] * o[0] + o[1] * o[1]) + (o[2] * o[2] + o[3] * o[3]);
#pragma unroll
    for (int x = 1; x < 32; x <<= 1) ss += __shfl_xor(ss, x);
    const float rs = rsqrtf(ss * (1.f / 128.f) + EPS);
    const f32x4 gn = *(const f32x4*)(gnorm + 4 * c4);
    if (half == 0) { v2u w; w.x = pk2(o[0] * rs * gn[0] * silu(gr[0]), o[1] * rs * gn[1] * silu(gr[1])); w.y = pk2(o[2] * rs * gn[2] * silu(gr[2]), o[3] * rs * gn[3] * silu(gr[3]));
        *(v2u*)(OGS + (size_t)b * DS_ + h * 128 + 4 * c4) = w; }
    LDS_WAIT(); asm volatile("" ::: "memory");
}

DI unsigned pk4_fp8(float a, float b, float c, float d) { int p = __builtin_amdgcn_cvt_pk_fp8_f32(a, b, 0, false); p = __builtin_amdgcn_cvt_pk_fp8_f32(c, d, p, true); return (unsigned)p; }
DI void dsa_post_row(const float* KRAW, const float* KIRAW, const float* knorm, const float* kinorm, float* kout, float* kiout, bf16* KB, bf16* KIB, const bf16* VB, unsigned char* K8, unsigned char* V8, int t, int lane) {
    { const float* p = KRAW + (size_t)t * 512 + 8 * lane; f32x4 a = *(const f32x4*)p, b = *(const f32x4*)(p + 4);
      const float rs = rsqrtf(grp16_sum((a.x * a.x + a.y * a.y) + (a.z * a.z + a.w * a.w) + (b.x * b.x + b.y * b.y) + (b.z * b.z + b.w * b.w)) * (1.f / 128.f) + EPS);
      const float* gp = knorm + ((8 * lane) & 127); const f32x4 g0 = *(const f32x4*)gp, g1 = *(const f32x4*)(gp + 4);
      a = a * rs * g0; b = b * rs * g1; float* o = kout + (size_t)t * 512 + 8 * lane; __builtin_nontemporal_store(a, (f32x4*)o); __builtin_nontemporal_store(b, (f32x4*)(o + 4)); *(bf16x8*)(KB + (size_t)t * 512 + 8 * lane) = pack8(a, b);
      *(v2u*)(K8 + (size_t)t * 512 + 8 * lane) = (v2u){pk4_fp8(a[0], a[1], a[2], a[3]), pk4_fp8(b[0], b[1], b[2], b[3])};
      const v4u vw = *(const v4u*)(VB + (size_t)t * 512 + 8 * lane);
      *(v2u*)(V8 + (size_t)t * 512 + 8 * lane) = (v2u){pk4_fp8(bf2f(vw.x & 0xffffu), bf2f(vw.x >> 16), bf2f(vw.y & 0xffffu), bf2f(vw.y >> 16)), pk4_fp8(bf2f(vw.z & 0xffffu), bf2f(vw.z >> 16), bf2f(vw.w & 0xffffu), bf2f(vw.w >> 16))}; }
    { const f32x2 a = *(const f32x2*)(KIRAW + (size_t)t * 128 + 2 * lane); const float rs = rsqrtf(wave_sum(a.x * a.x + a.y * a.y) * (1.f / 128.f) + EPS);
      const f32x2 gk = *(const f32x2*)(kinorm + 2 * lane); const float x = a.x * rs * gk.x, y = a.y * rs * gk.y;
      *(f32x2*)(kiout + (size_t)t * 128 + 2 * lane) = (f32x2){x, y}; *(unsigned*)(KIB + (size_t)t * 128 + 2 * lane) = pk2(x, y); }
}
DI void dsa_sample_prep(const float* R5S, const float* qnorm, const float* knorm, const float* kinorm, bf16* QNS, float* kout, float* vout, float* kiout, int b, int lane) {
    const float* r = R5S + (size_t)b * NB;
#pragma unroll
    for (int it = 0; it < 4; ++it) {
        const int c = it * 512 + 8 * lane; f32x4 a = *(const f32x4*)(r + c), bb = *(const f32x4*)(r + c + 4);
        const float rs = rsqrtf(grp16_sum((a.x * a.x + a.y * a.y) + (a.z * a.z + a.w * a.w) + (bb.x * bb.x + bb.y * bb.y) + (bb.z * bb.z + bb.w * bb.w)) * (1.f / 128.f) + EPS) * 0.08838834764831845f;
        const float* gp = qnorm + (c & 127); a = a * rs * *(const f32x4*)gp; bb = bb * rs * *(const f32x4*)(gp + 4);
        *(bf16x8*)(QNS + (size_t)b * D + c) = pack8(a, bb);
    }
    { const int c = 8 * lane; f32x4 a = *(const f32x4*)(r + 2048 + c), bb = *(const f32x4*)(r + 2048 + c + 4);
      const float rs = rsqrtf(grp16_sum((a.x * a.x + a.y * a.y) + (a.z * a.z + a.w * a.w) + (bb.x * bb.x + bb.y * bb.y) + (bb.z * bb.z + bb.w * bb.w)) * (1.f / 128.f) + EPS);
      const float* gp = knorm + (c & 127); a = a * rs * *(const f32x4*)gp; bb = bb * rs * *(const f32x4*)(gp + 4);
      float* o = kout + (size_t)b * 512 + c; *(f32x4*)o = a; *(f32x4*)(o + 4) = bb;
      float* ov = vout + (size_t)b * 512 + c; *(f32x4*)ov = *(const f32x4*)(r + 2560 + c); *(f32x4*)(ov + 4) = *(const f32x4*)(r + 2560 + c + 4); }
    { const f32x2 a = *(const f32x2*)(r + 5120 + 2 * lane); const float rs = rsqrtf(wave_sum(a.x * a.x + a.y * a.y) * (1.f / 128.f) + EPS);
      const f32x2 gk = *(const f32x2*)(kinorm + 2 * lane); *(f32x2*)(kiout + (size_t)b * 128 + 2 * lane) = (f32x2){a.x * rs * gk.x, a.y * rs * gk.y}; }
}

constexpr int IX_W = 0, IX_ST0 = 4096, IX_STB = 128 * 272;
__device__ const int IXTAB[257] = {0, 15, 30, 46, 62, 78, 94, 110, 126, 142, 158, 174, 190, 206, 222, 238, 254, 270, 286, 302, 318, 334, 350, 366, 382, 399, 415, 431, 447, 463, 480, 496, 512, 529, 546, 562, 578, 595, 611, 627, 644, 660, 676, 693, 709, 726, 742, 758, 775, 791, 808, 824, 841, 858, 874, 891, 907, 924, 940, 957, 973, 990, 1006, 1023, 1039, 1056, 1073, 1089, 1106, 1122, 1139, 1156, 1173, 1190, 1207, 1224, 1240, 1257, 1273, 1290, 1306, 1323, 1339, 1356, 1372, 1389, 1406, 1423, 1440, 1456, 1473, 1489, 1506, 1522, 1539, 1556, 1572, 1589, 1605, 1622, 1639, 1655, 1672, 1688, 1705, 1722, 1739, 1756, 1772, 1789, 1806, 1823, 1840, 1856, 1873, 1890, 1906, 1923, 1939, 1956, 1973, 1989, 2006, 2023, 2039, 2056, 2072, 2089, 2106, 2122, 2139, 2156, 2172, 2189, 2206, 2222, 2239, 2256, 2273, 2290, 2306, 2323, 2340, 2356, 2373, 2390, 2406, 2423, 2440, 2456, 2473, 2490, 2506, 2523, 2540, 2556, 2573, 2590, 2606, 2623, 2640, 2656, 2673, 2690, 2706, 2723, 2740, 2756, 2773, 2790, 2807, 2823, 2840, 2857, 2873, 2890, 2907, 2923, 2940, 2957, 2973, 2990, 3007, 3024, 3040, 3057, 3074, 3090, 3107, 3124, 3140, 3157, 3174, 3191, 3207, 3224, 3241, 3257, 3274, 3291, 3307, 3324, 3341, 3358, 3374, 3391, 3408, 3424, 3441, 3458, 3475, 3491, 3508, 3525, 3541, 3558, 3575, 3592, 3608, 3625, 3642, 3659, 3675, 3692, 3709, 3725, 3742, 3759, 3776, 3792, 3809, 3826, 3843, 3859, 3876, 3893, 3909, 3926, 3943, 3960, 3976, 3993, 4010, 4027, 4043, 4060, 4077, 4094, 4110, 4127, 4144, 4160, 4160, 4160, 4160, 4160, 4160};
DI void indexer_prompt(LAS unsigned char* lds, const bf16* QIB, const bf16* KIB, const float* WI, float* SC, int bid, int G, int tid_) {
    const int wave = __builtin_amdgcn_readfirstlane(tid_ >> 6);
    constexpr int NITEMS = 4160, IX_W2 = IX_ST0 + 2 * IX_STB;
    const int per = NITEMS / G, extra = NITEMS % G;
    int lo = bid * per + (bid < extra ? bid : extra), hi = lo + per + (bid < extra ? 1 : 0);
    if (G == 256) { lo = IXTAB[bid]; hi = IXTAB[bid + 1]; }
    int p = 0; while ((p + 1) * (p + 2) <= lo) ++p;
    int qb = 2 * p, s = lo - p * (p + 1); if (s > p) { qb += 1; s -= p + 1; }
    int wsel = 0; bool newq = true;
    if (lo < hi) {
        int tid = tid_; asm volatile("" : "+v"(tid));
        *(LAS f32x2*)(lds + IX_W + 8 * tid) = *(const f32x2*)(WI + (size_t)(64 * qb) * 16 + 2 * tid);
        v4u st[4];
#pragma unroll
        for (int it = 0; it < 4; ++it) { const int ci = tid + 512 * it, row = ci >> 4, ch = ci & 15; st[it] = *(const v4u*)(KIB + (size_t)(128 * s + row) * 128 + 8 * ch); }
#pragma unroll
        for (int it = 0; it < 4; ++it) { const int ci = tid + 512 * it, row = ci >> 4, ch = ci & 15; *(LAS v4u*)(lds + IX_ST0 + row * 272 + 16 * ch) = st[it]; }
    }
    __syncthreads();
    bf16x8 af[4][8];
    for (int item = lo; item < hi; ++item) {
        int tid = tid_; asm volatile("" : "+v"(tid));
        const int lane = tid & 63, hh = lane >> 5, m = lane & 31;
        const int q0 = 64 * qb, k0s = 128 * s;
        if (newq) {
#pragma unroll
            for (int a = 0; a < 4; ++a) { const int qq = q0 + 8 * wave + 2 * a + ((m >> 2) & 1), hd = 4 * (m >> 3) + (m & 3);
#pragma unroll
                for (int s_ = 0; s_ < 8; ++s_) af[a][s_] = *(const bf16x8*)(QIB + (size_t)qq * D + hd * 128 + 16 * s_ + 8 * hh); }
        }
        int nqb = qb, ns = s + 1; if (ns > (qb >> 1)) { nqb = qb + 1; ns = 0; }
        const bool more = item + 1 < hi;
        v4u st[2];
        LAS unsigned char* NBUF = lds + IX_ST0 + (((item - lo) & 1) ^ 1) * IX_STB;
#define IX_PF_LOAD(h_) do { if (more) { _Pragma("unroll") for (int it = 0; it < 2; ++it) { const int ci = tid + 512 * (2 * (h_) + it), row = ci >> 4, ch = ci & 15; st[it] = *(const v4u*)(KIB + (size_t)(128 * ns + row) * 128 + 8 * ch); } } } while (0)
#define IX_PF_STORE(h_) do { if (more) { _Pragma("unroll") for (int it = 0; it < 2; ++it) { const int ci = tid + 512 * (2 * (h_) + it), row = ci >> 4, ch = ci & 15; *(LAS v4u*)(NBUF + row * 272 + 16 * ch) = st[it]; } } } while (0)
        IX_PF_LOAD(0);
        f32x2 wn = (f32x2){0.f, 0.f};
        if (more && nqb != qb) wn = *(const f32x2*)(WI + (size_t)(64 * nqb) * 16 + 2 * tid);
        const int qlast_w = q0 + 8 * wave + 7;
        const int par = (item - lo) & 1;
        LAS unsigned char* SB = lds + IX_ST0 + par * IX_STB;
        LAS unsigned char* WBUF = lds + (wsel ? IX_W2 : IX_W);
#pragma unroll
        for (int bt = 0; bt < 4; ++bt) {
            const int key0 = k0s + 32 * bt;
            if (bt == 2) { IX_PF_STORE(0); IX_PF_LOAD(1); }
            if (key0 <= qlast_w) {
            bf16x8 bfr[8];
#pragma unroll
            for (int s_ = 0; s_ < 8; ++s_) bfr[s_] = *(const LAS bf16x8*)(SB + (32 * bt + m) * 272 + 32 * s_ + 16 * hh);
            f32x16 accA;
#define IX_CHAIN(acc_, a_) do { _Pragma("unroll") for (int i_ = 0; i_ < 16; ++i_) acc_[i_] = 0.f; __builtin_amdgcn_s_setprio(1); _Pragma("unroll") for (int s_ = 0; s_ < 8; ++s_) acc_ = MFMA32(af[a_][s_], bfr[s_], acc_); __builtin_amdgcn_s_setprio(0); } while (0)
#define IX_EPI(acc_, a_) do { const LAS f32x4* wp = (const LAS f32x4*)(WBUF + 64 * (8 * wave + 2 * (a_) + hh)); float s2[2] = {0.f, 0.f}; \
                const float big = __builtin_bit_cast(float, __builtin_amdgcn_readfirstlane(0x7f7fffff)); \
                _Pragma("unroll") for (int i4 = 0; i4 < 4; ++i4) { const f32x4 w4 = wp[i4]; _Pragma("unroll") for (int e = 0; e < 4; ++e) s2[e & 1] += w4[e] * __builtin_amdgcn_fmed3f(acc_[4 * i4 + e], 0.f, big); } \
                SC[(size_t)(q0 + 8 * wave + 2 * (a_) + hh) * T + key0 + m] = s2[0] + s2[1]; } while (0)
            IX_CHAIN(accA, 0); IX_EPI(accA, 0);
            IX_CHAIN(accA, 1); IX_EPI(accA, 1);
            IX_CHAIN(accA, 2); IX_EPI(accA, 2);
            IX_CHAIN(accA, 3); IX_EPI(accA, 3);
#undef IX_CHAIN
#undef IX_EPI
            }
        }
        IX_PF_STORE(1);
#undef IX_PF_LOAD
#undef IX_PF_STORE
        if (more) {
            if (nqb != qb) *(LAS f32x2*)(lds + (wsel ? IX_W : IX_W2) + 8 * tid) = wn;
        }
        __syncthreads();
        newq = nqb != qb; if (newq) wsel ^= 1;
        qb = nqb; s = ns;
    }
}

DI unsigned mono_key(float v) { const unsigned u = __float_as_uint(v); return (u & 0x80000000u) ? ~u : (u | 0x80000000u); }
DI int wave_sum_i(int v) {
#pragma unroll
    for (int o = 1; o < 64; o <<= 1) v += __shfl_xor(v, o);
    return v;
}
template <int NPL>
DI void topk_row(const float* sc, int n, int* idx_out, int lane_) {
    int lane = lane_; asm volatile("" : "+v"(lane));
    unsigned key[NPL];
    { const float* p = sc + lane;
#pragma unroll
    for (int j = 0; j < NPL; ++j) key[j] = __float_as_uint(p[64 * j]);
#pragma unroll
    for (int j = 0; j + 8 <= NPL; j += 8) asm volatile("" : "+v"(key[j]), "+v"(key[j + 1]), "+v"(key[j + 2]), "+v"(key[j + 3]), "+v"(key[j + 4]), "+v"(key[j + 5]), "+v"(key[j + 6]), "+v"(key[j + 7]));
#pragma unroll
    for (int j = NPL & ~7; j < NPL; ++j) asm volatile("" : "+v"(key[j]));
    const int ns = __builtin_amdgcn_readfirstlane(n);
#pragma unroll
    for (int j = 0; j < NPL; ++j) key[j] = (lane < ns - 64 * j) ? mono_key(__uint_as_float(key[j])) : 0u; }
    unsigned Tk = 0u;
#pragma unroll 1
    for (int bit = 31; bit >= 0; --bit) {
        const unsigned cand = __builtin_amdgcn_readfirstlane(Tk | (1u << bit)); int cnt = 0;
#pragma unroll
        for (int j = 0; j < NPL; ++j) asm volatile("v_cmp_le_u32 vcc, %2, %1\n\tv_addc_co_u32 %0, vcc, 0, %0, vcc" : "+v"(cnt) : "v"(key[j]), "s"(cand) : "vcc");
        cnt = wave_sum_i(cnt);
        if (cnt >= TOPK) Tk = cand;
    }
    int cgt = 0;
    { const unsigned tks = __builtin_amdgcn_readfirstlane(Tk);
#pragma unroll
    for (int j = 0; j < NPL; ++j) asm volatile("v_cmp_lt_u32 vcc, %2, %1\n\tv_addc_co_u32 %0, vcc, 0, %0, vcc" : "+v"(cgt) : "v"(key[j]), "s"(tks) : "vcc"); }
    cgt = wave_sum_i(cgt);
    const int need_eq = TOPK - cgt; int base = 0, eqb = 0;
    int lane2 = lane_; asm volatile("" : "+v"(lane2));
    const unsigned long long below = (1ull << lane2) - 1ull;
#pragma unroll
    for (int j = 0; j < NPL; ++j) {
        const bool ge = key[j] >= Tk;
        if (__ballot(ge) != 0ull) {
            const bool gt = key[j] > Tk, eq = key[j] == Tk;
            const unsigned long long mg = __ballot(gt), me = __ballot(eq);
            if (gt) idx_out[base + __builtin_popcountll(mg & below)] = lane2 + 64 * j;
            const int re = eqb + __builtin_popcountll(me & below);
            if (eq && re < need_eq) idx_out[cgt + re] = lane2 + 64 * j;
            base += __builtin_popcountll(mg); eqb += __builtin_popcountll(me);
        }
        __builtin_amdgcn_sched_barrier(0);
    }
}
constexpr int TK_CAP = 1024, TK_CPL = TK_CAP / 64;
template <int NPL>
DI void topk_row2(const float* sc, int n, int* idx_out, LAS unsigned* cbuf  , int lane_) {
    int lane = lane_; asm volatile("" : "+v"(lane));
    unsigned key[NPL];
    { const float* p = sc + lane;
#pragma unroll
    for (int j = 0; j < NPL; ++j) key[j] = __float_as_uint(p[64 * j]);
#pragma unroll
    for (int j = 0; j + 8 <= NPL; j += 8) asm volatile("" : "+v"(key[j]), "+v"(key[j + 1]), "+v"(key[j + 2]), "+v"(key[j + 3]), "+v"(key[j + 4]), "+v"(key[j + 5]), "+v"(key[j + 6]), "+v"(key[j + 7]));
#pragma unroll
    for (int j = NPL & ~7; j < NPL; ++j) asm volatile("" : "+v"(key[j]));
    const int ns = __builtin_amdgcn_readfirstlane(n);
#pragma unroll
    for (int j = 0; j < NPL; ++j) key[j] = (lane < ns - 64 * j) ? mono_key(__uint_as_float(key[j])) : 0u; }
    unsigned a0 = 0u, a1 = 0u, a2 = 0u, a3 = 0u;
#pragma unroll
    for (int j = 0; j < NPL; ++j) { unsigned x = key[j]; const unsigned n0 = a0 > x ? a0 : x; x = a0 < x ? a0 : x; a0 = n0; const unsigned n1 = a1 > x ? a1 : x; x = a1 < x ? a1 : x; a1 = n1;
        const unsigned n2 = a2 > x ? a2 : x; x = a2 < x ? a2 : x; a2 = n2; a3 = a3 > x ? a3 : x; }
    unsigned t0 = a3;
#pragma unroll
    for (int o = 1; o < 64; o <<= 1) { const unsigned y = (unsigned)__shfl_xor((int)t0, o); t0 = y < t0 ? y : t0; }
    const unsigned T0 = __builtin_amdgcn_readfirstlane(t0);
    int base = 0;
    int lane2 = lane_; asm volatile("" : "+v"(lane2));
    const unsigned long long below = (1ull << lane2) - 1ull;
#pragma unroll
    for (int j = 0; j < NPL; ++j) {
        const bool c = key[j] >= T0; const unsigned long long mk = __ballot(c);
        if (mk != 0ull) { const int pos = base + __builtin_popcountll(mk & below); if (c && pos < TK_CAP) { cbuf[pos] = key[j]; cbuf[TK_CAP + pos] = (unsigned)(lane2 + 64 * j); } base += __builtin_popcountll(mk); }
        __builtin_amdgcn_sched_barrier(0);
    }
    const int ncand = __builtin_amdgcn_readfirstlane(base);
    if (ncand > TK_CAP) { topk_row<NPL>(sc, n, idx_out, lane_); return; }
    LDS_WAIT(); asm volatile("" ::: "memory");
    unsigned ck[TK_CPL], ci[TK_CPL];
#pragma unroll
    for (int c = 0; c < TK_CPL; ++c) { const int q = lane2 + 64 * c; const bool v = q < ncand; ck[c] = v ? cbuf[q] : 0u; ci[c] = v ? cbuf[TK_CAP + q] : 0u; }
    unsigned Tk = 0u;
#pragma unroll 1
    for (int bit = 31; bit >= 0; --bit) {
        const unsigned cand = __builtin_amdgcn_readfirstlane(Tk | (1u << bit)); int cnt = 0;
#pragma unroll
        for (int c = 0; c < TK_CPL; ++c) asm volatile("v_cmp_le_u32 vcc, %2, %1\n\tv_addc_co_u32 %0, vcc, 0, %0, vcc" : "+v"(cnt) : "v"(ck[c]), "s"(cand) : "vcc");
        cnt = wave_sum_i(cnt);
        if (cnt >= TOPK) Tk = cand;
    }
    int cgt = 0;
    { const unsigned tks = __builtin_amdgcn_readfirstlane(Tk);
#pragma unroll
    for (int c = 0; c < TK_CPL; ++c) asm volatile("v_cmp_lt_u32 vcc, %2, %1\n\tv_addc_co_u32 %0, vcc, 0, %0, vcc" : "+v"(cgt) : "v"(ck[c]), "s"(tks) : "vcc"); }
    cgt = wave_sum_i(cgt);
    const int need_eq = TOPK - cgt; int ob = 0, eqb = 0;
#pragma unroll
    for (int c = 0; c < TK_CPL; ++c) {
        const bool gt = ck[c] > Tk, eq = ck[c] == Tk && ck[c] != 0u;
        const unsigned long long mg = __ballot(gt), me = __ballot(eq);
        if (gt) idx_out[ob + __builtin_popcountll(mg & below)] = (int)ci[c];
        const int re = eqb + __builtin_popcountll(me & below);
        if (eq && re < need_eq) idx_out[cgt + re] = (int)ci[c];
        ob += __builtin_popcountll(mg); eqb += __builtin_popcountll(me);
        __builtin_amdgcn_sched_barrier(0);
    }
    LDS_WAIT(); asm volatile("" ::: "memory");
}
DI void topk_dispatch(const float* sc, int n, int* idx_out, LAS unsigned* cbuf, int lane) {
    if (n <= TOPK) { for (int i = lane; i < TOPK; i += 64) idx_out[i] = i < n ? i : 0; return; }
    if (n <= 2112) topk_row2<33>(sc, n, idx_out, cbuf, lane);
    else if (n <= 4096) topk_row2<64>(sc, n, idx_out, cbuf, lane);
    else if (n <= 6144) topk_row2<96>(sc, n, idx_out, cbuf, lane);
    else topk_row2<128>(sc, n, idx_out, cbuf, lane);
}

template <bool F32SRC, class SRC>
DI void attn_unit(LAS unsigned char* vbuf  , const LAS float* lut, const bf16x8 (&qf)[4], const int* idx, int cnt_, int qpos_, int kvh, const SRC& src, bf16* orow, int lane_) {
    constexpr int NL = F32SRC ? 8 : 4, DEPTH = F32SRC ? 2 : 4;
    int lane = lane_; asm volatile("" : "+v"(lane));
    const int cnt = __builtin_amdgcn_readfirstlane(cnt_), qpos = __builtin_amdgcn_readfirstlane(qpos_);
    const int g = lane >> 4, lr = lane & 15;
    const unsigned vb_addr = (unsigned)(size_t)vbuf;
    const unsigned q_ = (unsigned)lr >> 2, p_ = (unsigned)lr & 3u;
    const unsigned wbase = 512u * ((unsigned)lr >> 2) + 64u * (unsigned)g;
    const unsigned rbase = vb_addr + 2048u * (unsigned)g + 64u * q_ + 8u * (p_ & 1u);
    v4u ring[DEPTH][NL];
    int R[16], RP[16];
#pragma unroll
    for (int kt = 0; kt < 16; ++kt) R[kt] = idx[16 * kt + lr];
#pragma unroll
    for (int kt = 0; kt < 16; ++kt) RP[kt] = src.rowid(R[kt]);
#define AT_ISSUE_K(slot, kt) do { const char* kr_ = src.kptr(RP[kt], kvh); _Pragma("unroll") for (int s_ = 0; s_ < 4; ++s_) { \
        if (F32SRC) { ring[slot][2 * s_] = __builtin_nontemporal_load((const v4u*)(kr_ + 4 * (32 * s_ + 8 * g))); ring[slot][2 * s_ + 1] = __builtin_nontemporal_load((const v4u*)(kr_ + 4 * (32 * s_ + 8 * g) + 16)); } \
        else ring[slot][s_] = *(const v4u*)(kr_ + 2 * (32 * s_ + 8 * g)); } } while (0)
#define AT_ISSUE_V(slot, hc) do { _Pragma("unroll") for (int q2_ = 0; q2_ < 4; ++q2_) { const int rid_ = __shfl(RP[hc], 4 * q2_ + g); const char* vr_ = src.vptr(rid_, kvh); \
        if (F32SRC) { ring[slot][2 * q2_] = __builtin_nontemporal_load((const v4u*)(vr_ + 32 * lr)); ring[slot][2 * q2_ + 1] = __builtin_nontemporal_load((const v4u*)(vr_ + 32 * lr + 16)); } \
        else ring[slot][q2_] = *(const v4u*)(vr_ + 16 * lr); } } while (0)
#pragma unroll
    for (int i = 0; i < DEPTH; ++i) AT_ISSUE_K(i, i);
    f32x4 lg[16]; f32x4 o[8]; bf16x8 pf[8]; float inv = 0.f;
#pragma unroll
    for (int i = 0; i < 16; ++i) {
        asm volatile("" ::: "memory");
        const int slot = i % DEPTH;
        {
            f32x4 acc = (f32x4){0.f, 0.f, 0.f, 0.f};
#pragma unroll
            for (int s = 0; s < 4; ++s) { bf16x8 kf; if (F32SRC) kf = pack8(__builtin_bit_cast(f32x4, ring[slot][2 * s]), __builtin_bit_cast(f32x4, ring[slot][2 * s + 1])); else kf = __builtin_bit_cast(bf16x8, ring[slot][s]);
                acc = MFMA16(kf, qf[s], acc); }
#pragma unroll
            for (int e = 0; e < 4; ++e) { const int kp = __shfl(R[i], 4 * g + e), rel = qpos - kp; const bool ok = (4 * g + e < cnt - 16 * i) && rel >= 0; const int rc = rel < 0 ? 0 : (rel > 128 ? 128 : rel);
                acc[e] = ok ? acc[e] + lut[rc * 16 + 4 * kvh + (lr & 3)] : -3.0e38f; }
            lg[i] = acc;
        }
        { const int ni = i + DEPTH;
          if (ni < 16) AT_ISSUE_K(slot, ni);
          else AT_ISSUE_V(slot, ni - 16); }
    }
    {
        {
            float mx = -3.0e38f;
#pragma unroll
            for (int kt = 0; kt < 16; ++kt) mx = fmaxf(fmaxf(fmaxf(lg[kt][0], lg[kt][1]), fmaxf(lg[kt][2], lg[kt][3])), mx);
            mx = fmaxf(mx, __shfl_xor(mx, 16)); mx = fmaxf(mx, __shfl_xor(mx, 32));
            float sum = 0.f;
#pragma unroll
            for (int kt = 0; kt < 16; ++kt)
#pragma unroll
                for (int e = 0; e < 4; ++e) { const float p = lg[kt][e] > -1.0e38f ? __expf(lg[kt][e] - mx) : 0.f; lg[kt][e] = p; sum += p; }
            sum += __shfl_xor(sum, 16); sum += __shfl_xor(sum, 32);
            inv = 1.f / sum;
#pragma unroll
            for (int ks = 0; ks < 8; ++ks) pf[ks] = pack8(lg[2 * ks], lg[2 * ks + 1]);
        }
    }
#pragma unroll
    for (int dt = 0; dt < 8; ++dt) o[dt] = (f32x4){0.f, 0.f, 0.f, 0.f};
#pragma unroll
    for (int i = 16; i < 32; ++i) {
        asm volatile("" ::: "memory");
        const int slot = i % DEPTH;
        {
            const int hc = i - 16, ks = hc >> 1, par = hc & 1;
            unsigned wb = wbase; asm volatile("" : "+v"(wb));
#pragma unroll
            for (int q2 = 0; q2 < 4; ++q2) { const unsigned off = wb + (unsigned)((ks & 1) * 8192 + 2048 * q2 + 256 * par) + 16u * (((unsigned)lr & 3u) ^ (unsigned)((par + 2 * q2) & 3));
                if (F32SRC) *(LAS bf16x8*)(vbuf + off) = pack8(__builtin_bit_cast(f32x4, ring[slot][2 * q2]), __builtin_bit_cast(f32x4, ring[slot][2 * q2 + 1]));
                else *(LAS v4u*)(vbuf + off) = ring[slot][q2]; }
            if (par == 1) {
                LDS_WAIT(); asm volatile("" ::: "memory");
#pragma unroll
                for (int dt = 0; dt < 8; dt += 2) {
                    s16x4 r0, r1, r2, r3;
                    unsigned rb = rbase; asm volatile("" : "+v"(rb));
                    const unsigned kso = (unsigned)((ks & 1) * 8192 + 512 * (dt >> 1));
                    const unsigned x0 = (unsigned)(2 * g) & 3u, x1 = (unsigned)(2 * g + 1) & 3u, c0 = 2u * (unsigned)(dt & 1) + (p_ >> 1), c2 = 2u * (unsigned)((dt + 1) & 1) + (p_ >> 1);
                    const unsigned a0 = rb + kso + 16u * (c0 ^ x0), a1 = rb + kso + 256u + 16u * (c0 ^ x1);
                    const unsigned a2 = rb + (unsigned)((ks & 1) * 8192 + 512 * ((dt + 1) >> 1)) + 16u * (c2 ^ x0), a3 = rb + (unsigned)((ks & 1) * 8192 + 512 * ((dt + 1) >> 1)) + 256u + 16u * (c2 ^ x1);
                    asm volatile("ds_read_b64_tr_b16 %0, %4\n\tds_read_b64_tr_b16 %1, %5\n\tds_read_b64_tr_b16 %2, %6\n\tds_read_b64_tr_b16 %3, %7\n\ts_waitcnt lgkmcnt(0)"
                                 : "=&v"(r0), "=&v"(r1), "=&v"(r2), "=&v"(r3) : "v"(a0), "v"(a1), "v"(a2), "v"(a3) : "memory");
                    bf16x8 va, vb2;
                    va[0] = r0[0]; va[1] = r0[1]; va[2] = r0[2]; va[3] = r0[3]; va[4] = r1[0]; va[5] = r1[1]; va[6] = r1[2]; va[7] = r1[3];
                    vb2[0] = r2[0]; vb2[1] = r2[1]; vb2[2] = r2[2]; vb2[3] = r2[3]; vb2[4] = r3[0]; vb2[5] = r3[1]; vb2[6] = r3[2]; vb2[7] = r3[3];
                    o[dt] = MFMA16(va, pf[ks], o[dt]); o[dt + 1] = MFMA16(vb2, pf[ks], o[dt + 1]);
                }
            }
        }
        { const int ni = i + DEPTH;
          if (ni < 32) AT_ISSUE_V(slot, ni - 16); }
    }
    if (lr < 4) {
#pragma unroll
        for (int dt = 0; dt < 8; ++dt) { v2u w; w.x = pk2(o[dt][0] * inv, o[dt][1] * inv); w.y = pk2(o[dt][2] * inv, o[dt][3] * inv); *(v2u*)(orow + (4 * kvh + lr) * 128 + 16 * dt + 4 * g) = w; } }
#undef AT_ISSUE_K
#undef AT_ISSUE_V
}

#define A8_TR4(ADDR0, ADDR1, OFF) asm volatile("ds_read_b64_tr_b16 %0, %4 offset:" #OFF "\n\tds_read_b64_tr_b16 %1, %5 offset:" #OFF "\n\tds_read_b64_tr_b16 %2, %6 offset:" #OFF "\n\tds_read_b64_tr_b16 %3, %7 offset:" #OFF "\n\ts_waitcnt lgkmcnt(0)" \
        : "=&v"(r0), "=&v"(r1), "=&v"(r2), "=&v"(r3) : "v"(ADDR0), "v"(ADDR1), "v"(ADDR0##b), "v"(ADDR1##b) : "memory")
DI void attn_unit_f8(LAS unsigned char* vbuf  , const LAS float* lut2  , const long (&qf)[4], const int* idx, int cnt_, int qpos_, int kvh, const unsigned char* K8, const bf16* VB, bf16* orow, int lane_) {
    int lane = lane_; asm volatile("" : "+v"(lane));
    const int cnt = __builtin_amdgcn_readfirstlane(cnt_), qpos = __builtin_amdgcn_readfirstlane(qpos_);
    const int g = lane >> 4, lr = lane & 15;
    const unsigned vb_addr = (unsigned)(size_t)vbuf;
    const unsigned q_ = (unsigned)lr >> 2, p_ = (unsigned)lr & 3u;
    const unsigned rb0 = vb_addr + 2048u * (unsigned)g + 64u * q_ + 8u * (p_ & 1u);
    const unsigned x0 = (unsigned)(2 * g) & 3u, x1 = (unsigned)(2 * g + 1) & 3u;
    const unsigned te = rb0 + 16u * ((p_ >> 1) ^ x0), teb = rb0 + 256u + 16u * ((p_ >> 1) ^ x1), to = rb0 + 16u * ((2u + (p_ >> 1)) ^ x0), tob = rb0 + 256u + 16u * ((2u + (p_ >> 1)) ^ x1);
    const unsigned wb = 512u * ((unsigned)lr >> 2) + 64u * (unsigned)g;
    const unsigned wx0 = wb + 16u * (((unsigned)lr & 3u) ^ 0u), wx1 = wb + 16u * (((unsigned)lr & 3u) ^ 1u), wx2 = wb + 16u * (((unsigned)lr & 3u) ^ 2u), wx3 = wb + 16u * (((unsigned)lr & 3u) ^ 3u);
    v4u ring[16];
    int R[16];
#pragma unroll
    for (int kt = 0; kt < 16; ++kt) R[kt] = idx[16 * kt + lr];
#define A8_ISSUE_K(kt) do { const char* kr_ = (const char*)K8 + (unsigned)(R[kt] * 512 + kvh * 128 + 32 * g); ring[(2 * (kt)) & 15] = *(const v4u*)kr_; ring[(2 * (kt) + 1) & 15] = *(const v4u*)(kr_ + 16); } while (0)
#define A8_ISSUE_V(hc) do { _Pragma("unroll") for (int q2_ = 0; q2_ < 4; ++q2_) { const int rid_ = __shfl(R[hc], 4 * q2_ + g); \
        ring[(4 * (hc) + q2_) & 15] = *(const v4u*)((const char*)VB + (unsigned)(rid_ * 1024 + kvh * 256 + 16 * lr)); } } while (0)
#pragma unroll
    for (int i = 0; i < 8; ++i) A8_ISSUE_K(i);
    f32x4 lg[16]; f32x4 o[8]; bf16x8 pf[8]; float inv = 0.f;
    const int hcol = 4 * kvh + (lr & 3);
#pragma unroll
    for (int i = 0; i < 16; ++i) {
        asm volatile("" ::: "memory");
        {
            int kp4[4];
#pragma unroll
            for (int e = 0; e < 4; ++e) kp4[e] = __shfl(R[i], 4 * g + e);
            f32x4 acc = (f32x4){0.f, 0.f, 0.f, 0.f};
#pragma unroll
            for (int s = 0; s < 4; ++s) { const v4u w = ring[(2 * i + (s >> 1)) & 15]; const unsigned long long ka = (s & 1) ? ((unsigned long long)w.w << 32 | w.z) : ((unsigned long long)w.y << 32 | w.x);
                acc = __builtin_amdgcn_mfma_f32_16x16x32_fp8_fp8((long)ka, qf[s], acc, 0, 0, 0); }
            float bs[4]; bool okv[4];
#pragma unroll
            for (int e = 0; e < 4; ++e) { const int rel = qpos - kp4[e]; okv[e] = (4 * g + e < cnt - 16 * i) && rel >= 0; const int rc = rel > 128 ? 128 : (rel < 0 ? 0 : rel); bs[e] = lut2[rc * 16 + hcol]; }
            asm volatile("" : "+v"(bs[0]), "+v"(bs[1]), "+v"(bs[2]), "+v"(bs[3]));
#pragma unroll
            for (int e = 0; e < 4; ++e) acc[e] = okv[e] ? acc[e] * (0.08838834764831845f * 1.4426950408889634f) + bs[e] : -3.0e38f;
            lg[i] = acc;
        }
        if (i + 8 < 16) A8_ISSUE_K(i + 8);
        else if ((i & 1) == 1) A8_ISSUE_V((i - 9) / 2);
    }
    {
        float mx = -3.0e38f;
#pragma unroll
        for (int kt = 0; kt < 16; ++kt) mx = fmaxf(fmaxf(fmaxf(lg[kt][0], lg[kt][1]), fmaxf(lg[kt][2], lg[kt][3])), mx);
        mx = fmaxf(mx, __shfl_xor(mx, 16)); mx = fmaxf(mx, __shfl_xor(mx, 32));
        float sum = 0.f;
#pragma unroll
        for (int kt = 0; kt < 16; ++kt)
#pragma unroll
            for (int e = 0; e < 4; ++e) { const float p = __builtin_amdgcn_exp2f(lg[kt][e] - mx); lg[kt][e] = p; sum += p; }
        sum += __shfl_xor(sum, 16); sum += __shfl_xor(sum, 32);
        inv = 1.f / sum;
#pragma unroll
        for (int ks = 0; ks < 8; ++ks) pf[ks] = pack8(lg[2 * ks], lg[2 * ks + 1]);
    }
#pragma unroll
    for (int dt = 0; dt < 8; ++dt) o[dt] = (f32x4){0.f, 0.f, 0.f, 0.f};
#pragma unroll
    for (int hc = 0; hc < 16; ++hc) {
        asm volatile("" ::: "memory");
        const int ks = hc >> 1, par = hc & 1;
        {
            unsigned w0 = wx0, w1 = wx1, w2 = wx2, w3 = wx3; asm volatile("" : "+v"(w0), "+v"(w1), "+v"(w2), "+v"(w3));
#pragma unroll
            for (int q2 = 0; q2 < 4; ++q2) { const int xr = (par + 2 * q2) & 3; const unsigned bs = xr == 0 ? w0 : (xr == 1 ? w1 : (xr == 2 ? w2 : w3));
                *(LAS v4u*)(vbuf + bs + (unsigned)((ks & 1) * 8192 + 2048 * q2 + 256 * par)) = ring[(4 * hc + q2) & 15]; }
        }
        if (par == 1) {
            LDS_WAIT(); asm volatile("" ::: "memory");
            s16x4 r0, r1, r2, r3; bf16x8 va, vb2;
#define A8_PV(dt) do { va[0] = r0[0]; va[1] = r0[1]; va[2] = r0[2]; va[3] = r0[3]; va[4] = r1[0]; va[5] = r1[1]; va[6] = r1[2]; va[7] = r1[3]; \
                vb2[0] = r2[0]; vb2[1] = r2[1]; vb2[2] = r2[2]; vb2[3] = r2[3]; vb2[4] = r3[0]; vb2[5] = r3[1]; vb2[6] = r3[2]; vb2[7] = r3[3]; \
                o[dt] = MFMA16(va, pf[ks], o[dt]); o[(dt) + 1] = MFMA16(vb2, pf[ks], o[(dt) + 1]); } while (0)
            unsigned tE = te, tEb = teb, tO = to, tOb = tob; asm volatile("" : "+v"(tE), "+v"(tEb), "+v"(tO), "+v"(tOb));
#define A8_TRP(OFF) asm volatile("ds_read_b64_tr_b16 %0, %4 offset:" #OFF "\n\tds_read_b64_tr_b16 %1, %5 offset:" #OFF "\n\tds_read_b64_tr_b16 %2, %6 offset:" #OFF "\n\tds_read_b64_tr_b16 %3, %7 offset:" #OFF "\n\ts_waitcnt lgkmcnt(0)" \
                : "=&v"(r0), "=&v"(r1), "=&v"(r2), "=&v"(r3) : "v"(tE), "v"(tEb), "v"(tO), "v"(tOb) : "memory")
            if ((ks & 1) == 0) { A8_TRP(0); A8_PV(0); A8_TRP(512); A8_PV(2); A8_TRP(1024); A8_PV(4); A8_TRP(1536); A8_PV(6); }
            else { A8_TRP(8192); A8_PV(0); A8_TRP(8704); A8_PV(2); A8_TRP(9216); A8_PV(4); A8_TRP(9728); A8_PV(6); }
#undef A8_TRP
#undef A8_PV
        }
        if (hc + 4 < 16) A8_ISSUE_V(hc + 4);
    }
    if (lr < 4) {
#pragma unroll
        for (int dt = 0; dt < 8; ++dt) { v2u w; w.x = pk2(o[dt][0] * inv, o[dt][1] * inv); w.y = pk2(o[dt][2] * inv, o[dt][3] * inv); *(v2u*)(orow + (4 * kvh + lr) * 128 + 16 * dt + 4 * g) = w; } }
#undef A8_ISSUE_K
#undef A8_ISSUE_V
}
#undef A8_TR4

DI void indexer_sample(const float* R5S, const float* cache_kidx, const int* page_table, const float* kinorm, float* SCS, int u, int tid) {
    const int wave = __builtin_amdgcn_readfirstlane(tid >> 6), lane = tid & 63, g = lane >> 4, lr = lane & 15, b = u >> 1, half = u & 1;
    const float wsc = 0.25f * 0.08838834764831845f;
    const float* qi = R5S + (size_t)b * NB + 3072 + lr * 128;
    bf16x8 qf[4];
#pragma unroll
    for (int s = 0; s < 4; ++s) qf[s] = pack8(*(const f32x4*)(qi + 32 * s + 8 * g), *(const f32x4*)(qi + 32 * s + 8 * g + 4));
    const float w = R5S[(size_t)b * NB + 5248 + lr] * wsc;
    const int phys = page_table[b * NPAGES + ((half * 1024 + wave * 128) >> 7)];
    const float* rbase = cache_kidx + ((size_t)phys * PAGE + ((wave * 128) & 127) + lr) * 128 + 8 * g;
    f32x4 rg[3][8];
#define IS_LOAD(kt_) do { const float* row_ = rbase + (size_t)(16 * (kt_)) * 128; _Pragma("unroll") for (int s_ = 0; s_ < 4; ++s_) { \
        rg[(kt_) % 3][2 * s_] = __builtin_nontemporal_load((const f32x4*)(row_ + 32 * s_)); rg[(kt_) % 3][2 * s_ + 1] = __builtin_nontemporal_load((const f32x4*)(row_ + 32 * s_ + 4)); } } while (0)
    IS_LOAD(0); IS_LOAD(1);
#pragma unroll
    for (int kt = 0; kt < 8; ++kt) {
        if (kt + 2 < 8) IS_LOAD(kt + 2);
        __builtin_amdgcn_sched_barrier(0);
        const int key0 = half * 1024 + wave * 128 + 16 * kt;
        f32x4 acc = (f32x4){0.f, 0.f, 0.f, 0.f};
#pragma unroll
        for (int s = 0; s < 4; ++s) acc = MFMA16(pack8(rg[kt % 3][2 * s], rg[kt % 3][2 * s + 1]), qf[s], acc);
        f32x4 v;
#pragma unroll
        for (int i = 0; i < 4; ++i) v[i] = grp16_sum(w * fmaxf(acc[i], 0.f));
        if (lr == 0) *(f32x4*)(SCS + (size_t)b * SCS_LD + key0 + 4 * g) = v;
        __builtin_amdgcn_sched_barrier(0);
    }
#undef IS_LOAD
    if (half == 1 && wave == 7) {
        const float* kr = R5S + (size_t)b * NB + 5120; const f32x2 a = *(const f32x2*)(kr + 2 * lane);
        const float rs = rsqrtf(wave_sum(a.x * a.x + a.y * a.y) * (1.f / 128.f) + EPS);
        const int hd = lane >> 2, part = lane & 3; const float* qh = R5S + (size_t)b * NB + 3072 + hd * 128 + 32 * part;
        float dot = 0.f;
#pragma unroll 8
        for (int d = 0; d < 32; ++d) dot += qh[d] * (kr[32 * part + d] * rs * kinorm[32 * part + d]);
        dot += __shfl_xor(dot, 1); dot += __shfl_xor(dot, 2);
        float sc = (R5S[(size_t)b * NB + 5248 + hd] * wsc) * fmaxf(dot, 0.f);
        sc += __shfl_xor(sc, 4); sc += __shfl_xor(sc, 8); sc += __shfl_xor(sc, 16); sc += __shfl_xor(sc, 32);
        if (lane == 0) SCS[(size_t)b * SCS_LD + 2048] = sc;
    }
}

struct SrcPrompt { const bf16* KB; const bf16* VB;
    DI int rowid(int pos) const { return pos; }
    DI const char* kptr(int rid, int kvh) const { return (const char*)KB + (unsigned)(rid * 1024 + kvh * 256); }
    DI const char* vptr(int rid, int kvh) const { return (const char*)VB + (unsigned)(rid * 1024 + kvh * 256); } };
struct SrcSample { const float* ck; const float* cv; const float* knew; const float* vnew; const int* pt;
    DI int rowid(int pos) const { return pos < PAST ? pt[pos >> 7] * PAGE + (pos & 127) : -1; }
    DI const char* kptr(int rid, int kvh) const { return rid >= 0 ? (const char*)ck + (unsigned)(rid * 2048 + kvh * 512) : (const char*)knew + kvh * 512; }
    DI const char* vptr(int rid, int kvh) const { return rid >= 0 ? (const char*)cv + (unsigned)(rid * 2048 + kvh * 512) : (const char*)vnew + kvh * 512; } };
struct UnitsPrompt { const int* IDX; const bf16* QRAW; const float* qnorm; bf16* OATT; int t0, stride, kvh, lane;
    DI int n() const { return t0 < T ? (T - t0 + stride - 1) / stride : 0; }
    DI const int* idx(int u) const { return IDX + (size_t)(t0 + u * stride) * TOPK; }
    DI int cnt(int u) const { const int t = t0 + u * stride; return t + 1 < TOPK ? t + 1 : TOPK; }
    DI int qpos(int u) const { return t0 + u * stride; }
    DI bf16* orow(int u) const { return OATT + (size_t)(t0 + u * stride) * D; }
    DI void qfrag(int u, bf16x8 (&qf)[4]) const {
        const int g = lane >> 4, lr = lane & 15; const bf16* qr = QRAW + (size_t)(t0 + u * stride) * D + (4 * kvh + (lr & 3)) * 128;
        float qv[4][8]; float ss = 0.f;
#pragma unroll
        for (int s = 0; s < 4; ++s) { const v4u w = *(const v4u*)(qr + 32 * s + 8 * g);
            qv[s][0] = bf2f(w.x & 0xffffu); qv[s][1] = bf2f(w.x >> 16); qv[s][2] = bf2f(w.y & 0xffffu); qv[s][3] = bf2f(w.y >> 16);
            qv[s][4] = bf2f(w.z & 0xffffu); qv[s][5] = bf2f(w.z >> 16); qv[s][6] = bf2f(w.w & 0xffffu); qv[s][7] = bf2f(w.w >> 16);
#pragma unroll
            for (int e = 0; e < 8; ++e) ss += qv[s][e] * qv[s][e]; }
        ss += __shfl_xor(ss, 16); ss += __shfl_xor(ss, 32);
        const float rs = (lr < 4) ? rsqrtf(ss * (1.f / 128.f) + EPS) * 0.08838834764831845f : 0.f;
#pragma unroll
        for (int s = 0; s < 4; ++s) { const f32x4 g0 = *(const f32x4*)(qnorm + 32 * s + 8 * g), g1 = *(const f32x4*)(qnorm + 32 * s + 8 * g + 4);
            f32x4 a, b; a[0] = qv[s][0] * rs * g0[0]; a[1] = qv[s][1] * rs * g0[1]; a[2] = qv[s][2] * rs * g0[2]; a[3] = qv[s][3] * rs * g0[3];
            b[0] = qv[s][4] * rs * g1[0]; b[1] = qv[s][5] * rs * g1[1]; b[2] = qv[s][6] * rs * g1[2]; b[3] = qv[s][7] * rs * g1[3]; qf[s] = pack8(a, b); }
    } };
struct UnitsSample { const int* idxs; const bf16* qns; bf16* orow_; int valid, kvh, lane;
    DI int n() const { return valid; }
    DI const int* idx(int) const { return idxs; }
    DI int cnt(int) const { return TOPK; }
    DI int qpos(int) const { return PAST; }
    DI bf16* orow(int) const { return orow_; }
    DI void qfrag(int, bf16x8 (&qf)[4]) const { const int g = lane >> 4, lr = lane & 15;
#pragma unroll
        for (int s = 0; s < 4; ++s) { qf[s] = *(const bf16x8*)(qns + (4 * kvh + (lr & 3)) * 128 + 32 * s + 8 * g); if (lr >= 4) qf[s] = (bf16x8){0, 0, 0, 0, 0, 0, 0, 0}; } } };

DI void build_lut(LAS float* lut, const float* rel_bias, int tid) {
    for (int i = tid; i < 129 * 16; i += NTHR) { const int r = i >> 4, hd = i & 15; int bk = r;
        if (r >= 16) { bk = 16 + (int)(__logf((float)r / 16.f) / 2.0794415f * 16.f); bk = bk > 31 ? 31 : bk; }
        lut[i] = rel_bias[bk * 16 + hd]; }
}
#define XB_TMO      128
#define XB_XCNT(j)  (256  + 64 * (j))
#define XB_XSUB(j)  (1280 + 64 * (j))
#define XB_XGEN(j)  (2304 + 64 * (j))
#define XB_TOP      3328
#define XB_TOPGEN   3392
#define XCD_BAR_WORDS 3456
#define XB_SPIN_CAP (1u << 18)

__device__ __forceinline__ unsigned xb_ld(unsigned* p)              { return __hip_atomic_load(p, __ATOMIC_RELAXED, __HIP_MEMORY_SCOPE_AGENT); }
__device__ __forceinline__ unsigned xb_add(unsigned* p, unsigned v) { return __hip_atomic_fetch_add(p, v, __ATOMIC_RELAXED, __HIP_MEMORY_SCOPE_AGENT); }
__device__ __forceinline__ unsigned xb_xcc_id() { return (unsigned)__builtin_amdgcn_s_getreg((3 << 11) | 20) & 0xFu; }
#define XB_SPIN(cond, bar) do { unsigned _sp = 0; while (cond) { __builtin_amdgcn_s_sleep(1); \
    if ((++_sp & 255u) == 0u) { if (xb_ld(&(bar)[XB_TMO])) break; if (_sp > XB_SPIN_CAP) { atomicAdd(&(bar)[XB_TMO], 1u); break; } } } } while (0)

struct XcdBarrier {
    unsigned* bar; unsigned x;
    volatile LAS unsigned* st;
};

__device__ __forceinline__ XcdBarrier xcd_barrier_post(unsigned* bar, volatile LAS unsigned* st, const bool t0  ) {
    XcdBarrier b; b.bar = bar; b.x = xb_xcc_id(); b.st = st;
    if (t0) (void)xb_add(&bar[XB_XCNT(b.x)], 1u);
    return b;
}
__device__ __forceinline__ void xcd_barrier_complete(unsigned* bar, unsigned x, unsigned& nloc, unsigned& nx) {
    const unsigned G = gridDim.x * gridDim.y * gridDim.z;
    unsigned sum, cnt, mine, sp = 0u;
    for (;;) {
        sum = 0u; cnt = 0u; mine = 0u;
#pragma unroll
        for (unsigned j = 0; j < 16; ++j) { const unsigned c = xb_ld(&bar[XB_XCNT(j)]); sum += c; cnt += (c > 0u) ? 1u : 0u; mine = (j == x) ? c : mine; }
        if (sum == G) break;
        __builtin_amdgcn_s_sleep(1);
        if ((++sp & 255u) == 0u) { if (xb_ld(&bar[XB_TMO])) break; if (sp > XB_SPIN_CAP) { atomicAdd(&bar[XB_TMO], 1u); break; } }
    }
    nloc = mine > 0u ? mine : 1u; nx = cnt > 0u ? cnt : 1u;
}

__device__ __forceinline__ void xcd_barrier(const XcdBarrier& b, const bool t0  ) {
    asm volatile("s_waitcnt vmcnt(0)" ::: "memory");
    __syncthreads();
    if (t0) {
        unsigned* bar = b.bar;
        __builtin_amdgcn_s_waitcnt(0);
        unsigned nloc = b.st[0], nx = b.st[1];
        if (nloc == 0u) { xcd_barrier_complete(bar, b.x, nloc, nx); b.st[0] = nloc; b.st[1] = nx; }
        const unsigned old = xb_add(&bar[XB_XSUB(b.x)], 1u);
        const unsigned gen = old / nloc;
        if (old + 1u == (gen + 1u) * nloc) {
            __builtin_amdgcn_fence(__ATOMIC_RELEASE, "agent");
            asm volatile("s_waitcnt vmcnt(0)" ::: "memory");
            const unsigned og = xb_add(&bar[XB_TOP], 1u);
            const unsigned tg = og / nx;
            if (og + 1u == (tg + 1u) * nx) xb_add(&bar[XB_TOPGEN], 1u);
            else XB_SPIN(xb_ld(&bar[XB_TOPGEN]) == tg, bar);
            __builtin_amdgcn_fence(__ATOMIC_ACQUIRE, "agent");
            xb_add(&bar[XB_XGEN(b.x)], 1u);
            asm volatile("s_waitcnt vmcnt(0)" ::: "memory");
        } else {
            XB_SPIN(xb_ld(&bar[XB_XGEN(b.x)]) == gen, bar);
            __builtin_amdgcn_fence(__ATOMIC_ACQUIRE, "agent");
            asm volatile("s_waitcnt vmcnt(0)" ::: "memory");
        }
    }
    __syncthreads();
}

typedef const __attribute__((address_space(4))) Args ArgsK;
DI ArgsK* launder_args() { ArgsK* p = (ArgsK*)__builtin_amdgcn_kernarg_segment_ptr(); asm volatile("" : "+s"(p)); return p; }
__global__ void __launch_bounds__(NTHR, 2) mk_fwd(Args args) {
    extern __shared__ __attribute__((aligned(16))) unsigned char lds_raw[];
    LAS unsigned char* lds = (LAS unsigned char*)lds_raw;
    const int tid0 = threadIdx.x, wave = __builtin_amdgcn_readfirstlane(tid0 >> 6), G = gridDim.x, bid = blockIdx.x;
    const int gw = bid * NWAVES + wave, NGW = G * NWAVES;
    unsigned* ctl = (unsigned*)(args.ws + WS_CTL);
    for (int u = tid0; u < (LDS_BYTES - MISC_OFF) / 4; u += NTHR) ((LAS unsigned*)(lds + MISC_OFF))[u] = 0u;
    __syncthreads();
#if MK_ONE_LAUNCH
    XcdBarrier bar = xcd_barrier_post(ctl + CW_BAR, (volatile LAS unsigned*)(lds + MISC_OFF + 32), tid0 == 0);
#define GRID_BAR() do { int l_; asm volatile("v_mbcnt_lo_u32_b32 %0, -1, 0\n\tv_mbcnt_hi_u32_b32 %0, -1, %0" : "=v"(l_)); xcd_barrier(bar, wave == 0 && l_ == 0); } while (0)
#else
#define GRID_BAR() do {} while (0)
#endif

#define LATE_N (32 * 32 + 32 * 176 + 88 * 32)
#define LATE_TR(L_) do { int r_ = (L_); TrItem t_{}; \
        if (r_ < 32 * 32) t_ = TrItem{b_w_out, WB_OUT, D, D, 0, r_}; \
        else if (r_ < 32 * 32 + 32 * 176) t_ = TrItem{w_gu + (size_t)D * 2 * FF, WGU1, D, 2 * FF, 1, r_ - 32 * 32}; \
        else t_ = TrItem{w_down + (size_t)FF * D, WD1, FF, D, 0, r_ - 32 * 32 - 32 * 176}; \
        f32x4 rr_[16]; tr_load(t_, lane, rr_); tr_store(t_, lane, rr_, (LAS float*)(lds + wave * WSLAB)); } while (0)
    const int lo = args.ph_lo, hi = args.ph_hi;
#ifndef PH_MASK
#define PH_MASK 0x3ffff
#endif
#define IN(k) (((PH_MASK >> (k)) & 1) && lo <= (k) && (k) < hi)
#define BOTH(k) (IN(k) && IN((k) + 1))
#define x_p ((const float*)AP->in[0])
#define x_s ((const float*)AP->in[1])
#define state_in ((const float*)AP->in[2])
#define cache_k ((const float*)AP->in[3])
#define cache_v ((const float*)AP->in[4])
#define cache_ki ((const float*)AP->in[5])
#define page_table ((const int*)AP->in[6])
#define norm_mix ((const float*)AP->in[7])
#define norm_ffn ((const float*)AP->in[8])
#define lb_logits ((const float*)AP->in[9])
#define a_w_in ((const float*)AP->in[10])
#define a_w_out ((const float*)AP->in[11])
#define a_gnorm ((const float*)AP->in[12])
#define b_w_in ((const float*)AP->in[13])
#define b_w_out ((const float*)AP->in[14])
#define b_q_norm ((const float*)AP->in[15])
#define b_k_norm ((const float*)AP->in[16])
#define b_ki_norm ((const float*)AP->in[17])
#define rel_bias ((const float*)AP->in[18])
#define w_gu ((const float*)AP->in[19])
#define w_down ((const float*)AP->in[20])
#define LB0 ((float*)(AP->ws + WS_LB0))
#define LUTG ((float*)(AP->ws + WS_LUT))
#define WA_IN ((bf16*)(AP->ws + WS_WA_IN))
#define WA_OUT ((bf16*)(AP->ws + WS_WA_OUT))
#define WGU0 ((bf16*)(AP->ws + WS_WGU0))
#define WD0 ((bf16*)(AP->ws + WS_WD0))
#define WB_IN ((bf16*)(AP->ws + WS_WB_IN))
#define WB_OUT ((bf16*)(AP->ws + WS_WB_OUT))
#define WGU1 ((bf16*)(AP->ws + WS_WGU1))
#define WD1 ((bf16*)(AP->ws + WS_WD1))
#define HP ((bf16*)(AP->ws + WS_HP))
#define ZQ ((bf16*)(AP->ws + WS_ZQ))
#define ZK ((bf16*)(AP->ws + WS_ZK))
#define ZV ((bf16*)(AP->ws + WS_ZV))
#define ZG ((bf16*)(AP->ws + WS_ZG))
#define LF ((float*)(AP->ws + WS_LF))
#define QG ((bf16*)(AP->ws + WS_QG))
#define OL ((float*)(AP->ws + WS_OL))
#define DS ((float*)(AP->ws + WS_DS))
#define DSC ((float*)(AP->ws + WS_DSC))
#define OG ((bf16*)(AP->ws + WS_OG))
#define Y1 ((bf16*)(AP->ws + WS_Y1))
#define HID ((bf16*)(AP->ws + WS_HID))
#define Y2 ((bf16*)(AP->ws + WS_Y2))
#define Y3 ((bf16*)(AP->ws + WS_Y3))
#define QRAW ((bf16*)(AP->ws + WS_QRAW))
#define QIB ((bf16*)(AP->ws + WS_QIB))
#define KRAW ((float*)(AP->ws + WS_KRAW))
#define KIRAW ((float*)(AP->ws + WS_KIRAW))
#define WI ((float*)(AP->ws + WS_WI))
#define KB ((bf16*)(AP->ws + WS_KB))
#define VB ((bf16*)(AP->ws + WS_VB))
#define KIB ((bf16*)(AP->ws + WS_KIB))
#define SC ((float*)(AP->ws + WS_SC))
#define IDX ((int*)(AP->ws + WS_IDX))
#define OATT ((bf16*)(AP->ws + WS_OATT))
#define HS ((bf16*)(AP->ws + WS_HS))
#define RS1 ((float*)(AP->ws + WS_RS1))
#define OGS ((bf16*)(AP->ws + WS_OGS))
#define Y1S ((float*)(AP->ws + WS_Y1S))
#define HIDS ((bf16*)(AP->ws + WS_HIDS))
#define Y2S ((float*)(AP->ws + WS_Y2S))
#define R5S ((float*)(AP->ws + WS_R5S))
#define QNS ((bf16*)(AP->ws + WS_QNS))
#define SCS ((float*)(AP->ws + WS_SCS))
#define IDXS ((int*)(AP->ws + WS_IDXS))
#define OATTS ((bf16*)(AP->ws + WS_OATTS))
#define Y3S ((float*)(AP->ws + WS_Y3S))
#define out (AP->out)
#define SSQ ((float*)(AP->ws + WS_SSQ))
#define SSQS (SSQ + 3 * T)
    if (IN(0)) {
        const ArgsK* AP = launder_args();
        int lane; asm volatile("v_mbcnt_lo_u32_b32 %0, -1, 0\n\tv_mbcnt_hi_u32_b32 %0, -1, %0" : "=v"(lane)); const int tid = wave * 64 + lane;
        LAS float* scr = (LAS float*)(lds + wave * 16640);
        constexpr int I0 = 32 * 128, I1 = 32 * 32, I2 = 32 * 176, I3 = 88 * 32, I4 = 32 * 83, NIT = I0 + I1 + I2 + I3 + I4;
#define TR_PICK(it_, t_) do { int r_ = (it_); \
            if (r_ < I0) { t_ = TrItem{a_w_in, WA_IN, D, NA, 0, r_}; break; } r_ -= I0; \
            if (r_ < I1) { t_ = TrItem{a_w_out, WA_OUT, D, D, 0, r_}; break; } r_ -= I1; \
            if (r_ < I2) { t_ = TrItem{w_gu, WGU0, D, 2 * FF, 1, r_}; break; } r_ -= I2; \
            if (r_ < I3) { t_ = TrItem{w_down, WD0, FF, D, 0, r_}; break; } r_ -= I3; \
            t_ = TrItem{b_w_in, WB_IN, D, NBR, 0, r_}; } while (0)
        {
            f32x4 ra[16], rb[16]; TrItem ta{}, tb{};
            int it = gw;
            if (it < NIT) { TR_PICK(it, ta); tr_load(ta, lane, ra); }
            while (it < NIT) {
                const int it2 = it + NGW, it3 = it2 + NGW;
                if (it2 < NIT) { TR_PICK(it2, tb); tr_load(tb, lane, rb); }
                tr_store(ta, lane, ra, scr);
                if (it2 >= NIT) break;
                if (it3 < NIT) { TR_PICK(it3, ta); tr_load(ta, lane, ra); }
                tr_store(tb, lane, rb, scr);
                it = it3;
            }
        }
#undef TR_PICK
        for (int m = gw; m < T + BS; m += NGW) { if (m < T) rmsnorm_row(x_p + (size_t)m * D, norm_mix, HP + (size_t)m * D, lane); else rmsnorm_row(x_s + (size_t)(m - T) * D, norm_mix, HS + (size_t)(m - T) * DS_, lane); }
        const int gt = bid * NTHR + tid, NGT = G * NTHR;
        for (int i = gt; i < 2048; i += NGT) { const float a = lb_logits[i], b = lb_logits[2048 + i], c = lb_logits[4096 + i], mx = fmaxf(a, fmaxf(b, c)); const float ea = __expf(a - mx), eb = __expf(b - mx), ec = __expf(c - mx); LB0[i] = ea / (ea + eb + ec); }
        for (int i = gt; i < (NB - 5312) * D / 8; i += NGT) ((v4u*)(WB_IN + (size_t)5312 * D))[i] = (v4u){0u, 0u, 0u, 0u};
        for (int i = gt; i < 3 * T + 3 * BS; i += NGT) SSQ[i] = 0.f;
        if (BOTH(0)) GRID_BAR();
    }
    if (IN(1)) {
        const ArgsK* AP = launder_args();
        int lane; asm volatile("v_mbcnt_lo_u32_b32 %0, -1, 0\n\tv_mbcnt_hi_u32_b32 %0, -1, %0" : "=v"(lane)); const int tid = wave * 64 + lane;
        pg8::Gemm g{HP, WA_IN, T, NA, D}; pg8::StaticOrder S; S.init(T, NA, G, bid);
        EpiA E{ZQ, LF, LB0};
        pg8::gemm_phase<EpiA, pg8::StaticOrder, true, true>(lds, g, S, E, wave);
        skinny_gemm<0, 2, 4, D>(lds, HS, DS_, WA_IN, NA / 64, RS1, nullptr, NA, nullptr, bid, G, tid);
        if (BOTH(1)) GRID_BAR();
    }
    if (IN(2)) {
        const ArgsK* AP = launder_args();
        int lane; asm volatile("v_mbcnt_lo_u32_b32 %0, -1, 0\n\tv_mbcnt_hi_u32_b32 %0, -1, %0" : "=v"(lane)); const int tid = wave * 64 + lane;
        if ((bid >> 3) & 1) {
            for (int su = gw; su < BS * 16; su += NGW) hgrn_sample((LAS float*)(lds + wave * 2048), RS1, LB0, state_in, out + O_SS, a_gnorm, OGS, su >> 4, su & 15, lane);
            __syncthreads();
            hgrn_passA(lds, ZQ, ZK, ZV, LF, QG, OL, DS, DSC, bid, G, tid);
        } else {
            hgrn_passA(lds, ZQ, ZK, ZV, LF, QG, OL, DS, DSC, bid, G, tid);
            __syncthreads();
            for (int su = gw; su < BS * 16; su += NGW) hgrn_sample((LAS float*)(lds + wave * 2048), RS1, LB0, state_in, out + O_SS, a_gnorm, OGS, su >> 4, su & 15, lane);
        }
        if (BOTH(2)) GRID_BAR();
    }
    if (IN(3)) {
        const ArgsK* AP = launder_args();
        int lane; asm volatile("v_mbcnt_lo_u32_b32 %0, -1, 0\n\tv_mbcnt_hi_u32_b32 %0, -1, %0" : "=v"(lane)); const int tid = wave * 64 + lane;
        hgrn_passC(lds, QG, OL, DS, DSC, ZG, a_gnorm, OG, out + O_SP, bid, G, tid);
        skinny_gemm<0, 1, 2, D>(lds, OGS, DS_, WA_OUT, D / 32, Y1S, x_s, D, nullptr, bid, G, tid, 0, SkNorm{nullptr, norm_ffn, HS, SSQS});
        if (BOTH(3)) GRID_BAR();
    }
    if (IN(4)) {
        const ArgsK* AP = launder_args();
        int lane; asm volatile("v_mbcnt_lo_u32_b32 %0, -1, 0\n\tv_mbcnt_hi_u32_b32 %0, -1, %0" : "=v"(lane)); const int tid = wave * 64 + lane;
        pg8::Gemm g{OG, WA_OUT, T, D, D}; pg8::StaticOrder S; S.init(T, D, G, bid);
        EpiRes<false, true> E{x_p, Y1, norm_ffn, HP, SSQ};
        pg8::gemm_phase<EpiRes<false, true>, pg8::StaticOrder, true, true>(lds, g, S, E, wave);
        skinny_gemm<1, 2, 4, D>(lds, HS, DS_, WGU0, FF / 32, nullptr, nullptr, 0, HIDS, bid, G, tid, 0, SkNorm{SSQS, nullptr, nullptr, nullptr});
        if (BOTH(4)) GRID_BAR();
    }
    if (IN(5)) {
        const ArgsK* AP = launder_args();
        int lane; asm volatile("v_mbcnt_lo_u32_b32 %0, -1, 0\n\tv_mbcnt_hi_u32_b32 %0, -1, %0" : "=v"(lane)); const int tid = wave * 64 + lane;
        pg8::Gemm g{HP, WGU0, T, 2 * FF, D}; pg8::StaticOrder S; S.init(T, 2 * FF, G, bid);
        EpiSwiglu E{HID, SSQ};
        pg8::gemm_phase<EpiSwiglu, pg8::StaticOrder, true, true>(lds, g, S, E, wave);
        skinny_gemm<0, 1, 2, FF>(lds, HIDS, FFS_, WD0, D / 32, Y2S, Y1S, D, nullptr, bid, G, tid, (T / 256 * (2 * FF / 256)) % G, SkNorm{nullptr, norm_mix + D, HS, SSQS + BS});
        if (BOTH(5)) GRID_BAR();
    }
    if (IN(6)) {
        const ArgsK* AP = launder_args();
        int lane; asm volatile("v_mbcnt_lo_u32_b32 %0, -1, 0\n\tv_mbcnt_hi_u32_b32 %0, -1, %0" : "=v"(lane)); const int tid = wave * 64 + lane;
        pg8::Gemm g{HID, WD0, T, D, FF}; pg8::StaticOrder S; S.init(T, D, G, bid);
        EpiRes<true, true> E{Y1, Y2, norm_mix + D, HP, SSQ + T};
        pg8::gemm_phase<EpiRes<true, true>, pg8::StaticOrder, true, true>(lds, g, S, E, wave);
        skinny_gemm<0, 2, 4, D>(lds, HS, DS_, WB_IN, NB / 64, R5S, nullptr, NB, nullptr, bid, G, tid, 0, SkNorm{SSQS + BS, nullptr, nullptr, nullptr});
        if (BOTH(6)) GRID_BAR();
    }
    if (IN(7)) {
        const ArgsK* AP = launder_args();
        int lane; asm volatile("v_mbcnt_lo_u32_b32 %0, -1, 0\n\tv_mbcnt_hi_u32_b32 %0, -1, %0" : "=v"(lane)); const int tid = wave * 64 + lane;
        pg8::Gemm g{HP, WB_IN, T, NB, D}; pg8::StaticOrder S; S.init(T, NB, G, bid);
        EpiB E{QRAW, QIB, VB, KRAW, out + O_VP, KIRAW, WI, SSQ + T};
        pg8::gemm_phase<EpiB, pg8::StaticOrder, true, true>(lds, g, S, E, wave);
        for (int b = NGW - 1 - gw; b < BS; b += NGW) dsa_sample_prep(R5S, b_q_norm, b_k_norm, b_ki_norm, QNS, out + O_KS, out + O_VS, out + O_KIS, b, lane);
        { const int c0 = (T / 256 * (NB / 256)) % G;
          for (int u = bid - c0; u >= 0 && u < 2 * BS; u += G - c0) indexer_sample(R5S, cache_ki, page_table, b_ki_norm, SCS, u, tid); }
        if (BOTH(7)) GRID_BAR();
    }
    if (IN(8)) {
        const ArgsK* AP = launder_args();
        int lane; asm volatile("v_mbcnt_lo_u32_b32 %0, -1, 0\n\tv_mbcnt_hi_u32_b32 %0, -1, %0" : "=v"(lane)); const int tid = wave * 64 + lane;
        if (gw < NGW - BS) for (int t = gw; t < T; t += NGW - BS) dsa_post_row(KRAW, KIRAW, b_k_norm, b_ki_norm, out + O_KP, out + O_KIP, KB, KIB, VB, (unsigned char*)(AP->ws + WS_K8), (unsigned char*)(AP->ws + WS_V8), t, lane);
        for (int b = NGW - 1 - gw; b < BS; b += NGW) topk_dispatch(SCS + (size_t)b * SCS_LD, PAST + 1, IDXS + b * TOPK, (LAS unsigned*)(lds + wave * 8192), lane);
        if (gw == 0) { for (int i = lane; i < 129 * 16; i += 64) { const int r = i >> 4, hd = i & 15; int bk = r; if (r >= 16) { bk = 16 + (int)(__logf((float)r / 16.f) / 2.0794415f * 16.f); bk = bk > 31 ? 31 : bk; } LUTG[i] = rel_bias[bk * 16 + hd]; } }
        if (BOTH(8)) GRID_BAR();
    }
    if (IN(9)) {
        const ArgsK* AP = launder_args();
        int lane; asm volatile("v_mbcnt_lo_u32_b32 %0, -1, 0\n\tv_mbcnt_hi_u32_b32 %0, -1, %0" : "=v"(lane)); const int tid = wave * 64 + lane;
        indexer_prompt(lds, QIB, KIB, WI, SC, bid, G, tid);
        if (BOTH(9)) GRID_BAR();
    }
    if (IN(10)) {
        const ArgsK* AP = launder_args();
        int lane; asm volatile("v_mbcnt_lo_u32_b32 %0, -1, 0\n\tv_mbcnt_hi_u32_b32 %0, -1, %0" : "=v"(lane)); const int tid = wave * 64 + lane;
        { int lt = tid; asm volatile("" : "+v"(lt)); for (int i = lt; i < 129 * 16; i += NTHR) ((LAS float*)(lds + LUT_OFF))[i] = LUTG[i]; }
        if (tid == 0) ((volatile LAS int*)(lds + MISC_OFF))[12] = 0;
        __syncthreads();
        for (;;) {
            int it = 0;
            if (lane == 0) it = __hip_atomic_fetch_add((LAS int*)(lds + MISC_OFF) + 12, 1, __ATOMIC_RELAXED, __HIP_MEMORY_SCOPE_WORKGROUP);
            it = __builtin_amdgcn_readfirstlane(it);
            if (it >= 34 + 12) break;
            if (it >= 34) { const int L = bid + G * (it - 34); if (L < LATE_N) LATE_TR(L); continue; }
            if (it < 2) {
                const int su = 2 * bid + it;
                if (su < BS * 4) {
                    const int b = su >> 2, kvh = su & 3, g = lane >> 4, lr = lane & 15;
                    bf16x8 qf[4];
#pragma unroll
                    for (int s = 0; s < 4; ++s) { qf[s] = *(const bf16x8*)(QNS + (size_t)b * D + (4 * kvh + (lr & 3)) * 128 + 32 * s + 8 * g); if (lr >= 4) qf[s] = (bf16x8){0, 0, 0, 0, 0, 0, 0, 0}; }
                    SrcSample src{cache_k, cache_v, out + O_KS + (size_t)b * 512, out + O_VS + (size_t)b * 512, page_table + b * NPAGES};
                    attn_unit<true, SrcSample>(lds + wave * WSLAB, (const LAS float*)(lds + LUT_OFF), qf, IDXS + b * TOPK, TOPK, PAST, kvh, src, OATTS + (size_t)b * DS_, lane);
                }
            } else {
                const int r = it - 2, kq = 3 - (r >> 3), j0 = bid * NWAVES + (r & 7), t = NGW * kq + ((kq & 1) ? NGW - 1 - j0 : j0);
                if (t >= 0 && t < T) topk_dispatch(SC + (size_t)t * T, t + 1, IDX + (size_t)t * TOPK, (LAS unsigned*)(lds + wave * WSLAB), lane);
            }
        }
        if (BOTH(10)) GRID_BAR();
    }
    if (IN(11)) {
        const ArgsK* AP = launder_args();
        int lane; asm volatile("v_mbcnt_lo_u32_b32 %0, -1, 0\n\tv_mbcnt_hi_u32_b32 %0, -1, %0" : "=v"(lane)); const int tid = wave * 64 + lane;
        const bool g6_first = ((bid >> 3) & 1) != 0;
        if (g6_first) { skinny_gemm<0, 1, 2, D>(lds, OATTS, DS_, WB_OUT, D / 32, Y3S, Y2S, D, nullptr, bid, G, tid, 0, SkNorm{nullptr, norm_ffn + D, HS, SSQS + 2 * BS}); __syncthreads(); }
        { int lt = tid; asm volatile("" : "+v"(lt)); for (int i = lt; i < 129 * 16; i += NTHR) ((LAS float*)(lds + LUT_OFF))[i] = LUTG[i] * 1.4426950408889634f; }
        __syncthreads();
        {
            const int kvh = bid & 3, g = lane >> 4, lr = lane & 15, nslots = (G >> 2) * NWAVES;
            const unsigned char* K8 = (const unsigned char*)(AP->ws + WS_K8);
            if (tid == 0) ((volatile LAS int*)(lds + MISC_OFF))[12] = 0;
            __syncthreads();
            constexpr int NATT = 128, NLATE = 26;
            for (;;) {
            int it = 0;
            if (lane == 0) it = __hip_atomic_fetch_add((LAS int*)(lds + MISC_OFF) + 12, 1, __ATOMIC_RELAXED, __HIP_MEMORY_SCOPE_WORKGROUP);
            it = __builtin_amdgcn_readfirstlane(it);
            if (it >= NATT + NLATE) break;
            const int grp = it / 6, pos = it % 6;
            const bool is_tr = (pos == 5 && grp < NLATE) ;
            if (is_tr) { const int L = bid + G * (12 + grp); if (L < LATE_N) LATE_TR(L); continue; }
            const int u = it - (grp < NLATE ? grp : NLATE);
            if (u >= NATT) continue;
            {
                const int t = (bid >> 2) * NWAVES + (u & 7) + nslots * (u >> 3);
                if (t >= T) continue;

                const bf16* qr = QRAW + (size_t)t * D + (4 * kvh + (lr & 3)) * 128;
                float qv[4][8]; float ss = 0.f;
#pragma unroll
                for (int s = 0; s < 4; ++s) { const v4u w = *(const v4u*)(qr + 32 * g + 8 * s);
                    qv[s][0] = bf2f(w.x & 0xffffu); qv[s][1] = bf2f(w.x >> 16); qv[s][2] = bf2f(w.y & 0xffffu); qv[s][3] = bf2f(w.y >> 16);
                    qv[s][4] = bf2f(w.z & 0xffffu); qv[s][5] = bf2f(w.z >> 16); qv[s][6] = bf2f(w.w & 0xffffu); qv[s][7] = bf2f(w.w >> 16);
#pragma unroll
                    for (int e = 0; e < 8; ++e) ss += qv[s][e] * qv[s][e]; }
                ss += __shfl_xor(ss, 16); ss += __shfl_xor(ss, 32);
                const float rs = (lr < 4) ? rsqrtf(ss * (1.f / 128.f) + EPS) : 0.f;
                long qf[4];
#pragma unroll
                for (int s = 0; s < 4; ++s) { const f32x4 g0 = *(const f32x4*)(b_q_norm + 32 * g + 8 * s), g1 = *(const f32x4*)(b_q_norm + 32 * g + 8 * s + 4);
                    const unsigned lo = pk4_fp8(qv[s][0] * rs * g0[0], qv[s][1] * rs * g0[1], qv[s][2] * rs * g0[2], qv[s][3] * rs * g0[3]);
                    const unsigned hi = pk4_fp8(qv[s][4] * rs * g1[0], qv[s][5] * rs * g1[1], qv[s][6] * rs * g1[2], qv[s][7] * rs * g1[3]);
                    qf[s] = (long)(((unsigned long long)hi << 32) | lo); }
                const int cnt = t + 1 < TOPK ? t + 1 : TOPK;
                attn_unit_f8(lds + wave * WSLAB, (const LAS float*)(lds + LUT_OFF), qf, IDX + (size_t)t * TOPK, cnt, t, kvh, K8, VB, OATT + (size_t)t * D, lane);
            }
            }
        }
        __syncthreads();
        if (!g6_first) skinny_gemm<0, 1, 2, D>(lds, OATTS, DS_, WB_OUT, D / 32, Y3S, Y2S, D, nullptr, bid, G, tid, 0, SkNorm{nullptr, norm_ffn + D, HS, SSQS + 2 * BS});
        if (BOTH(11)) GRID_BAR();
    }
    if (IN(12)) {
        const ArgsK* AP = launder_args();
        int lane; asm volatile("v_mbcnt_lo_u32_b32 %0, -1, 0\n\tv_mbcnt_hi_u32_b32 %0, -1, %0" : "=v"(lane)); const int tid = wave * 64 + lane;
        pg8::Gemm g{OATT, WB_OUT, T, D, D}; pg8::StaticOrder S; S.init(T, D, G, bid);
        EpiRes<true, true> E{Y2, Y3, norm_ffn + D, HP, SSQ + 2 * T};
        pg8::gemm_phase<EpiRes<true, true>, pg8::StaticOrder, true, true>(lds, g, S, E, wave);
        skinny_gemm<1, 2, 4, D>(lds, HS, DS_, WGU1, FF / 32, nullptr, nullptr, 0, HIDS, bid, G, tid, 0, SkNorm{SSQS + 2 * BS, nullptr, nullptr, nullptr});
        if (BOTH(12)) GRID_BAR();
    }
    if (IN(13)) {
        const ArgsK* AP = launder_args();
        int lane; asm volatile("v_mbcnt_lo_u32_b32 %0, -1, 0\n\tv_mbcnt_hi_u32_b32 %0, -1, %0" : "=v"(lane)); const int tid = wave * 64 + lane;
        pg8::Gemm g{HP, WGU1, T, 2 * FF, D}; pg8::StaticOrder S; S.init(T, 2 * FF, G, bid);
        EpiSwiglu E{HID, SSQ + 2 * T};
        pg8::gemm_phase<EpiSwiglu, pg8::StaticOrder, true, true>(lds, g, S, E, wave);
        skinny_gemm<0, 1, 2, FF>(lds, HIDS, FFS_, WD1, D / 32, out + O_YS, Y3S, D, nullptr, bid, G, tid, (T / 256 * (2 * FF / 256)) % G);
        if (BOTH(13)) GRID_BAR();
    }
    if (IN(14)) {
        const ArgsK* AP = launder_args();
        int lane; asm volatile("v_mbcnt_lo_u32_b32 %0, -1, 0\n\tv_mbcnt_hi_u32_b32 %0, -1, %0" : "=v"(lane)); const int tid = wave * 64 + lane;
        pg8::Gemm g{HID, WD1, T, D, FF}; pg8::StaticOrder S; S.init(T, D, G, bid);
        EpiRes<true, false> E{Y3, out + O_YP, nullptr, nullptr, nullptr};
        pg8::gemm_phase<EpiRes<true, false>, pg8::StaticOrder, true, true>(lds, g, S, E, wave);
    }
#undef LATE_TR
#undef LATE_N
#undef IN
#undef BOTH
}
#undef x_p
#undef x_s
#undef state_in
#undef cache_k
#undef cache_v
#undef cache_ki
#undef page_table
#undef norm_mix
#undef norm_ffn
#undef lb_logits
#undef a_w_in
#undef a_w_out
#undef a_gnorm
#undef b_w_in
#undef b_w_out
#undef b_q_norm
#undef b_k_norm
#undef b_ki_norm
#undef rel_bias
#undef w_gu
#undef w_down
#undef LB0
#undef LUTG
#undef WA_IN
#undef WA_OUT
#undef WGU0
#undef WD0
#undef WB_IN
#undef WB_OUT
#undef WGU1
#undef WD1
#undef HP
#undef ZQ
#undef ZK
#undef ZV
#undef ZG
#undef LF
#undef QG
#undef OL
#undef DS
#undef DSC
#undef OG
#undef Y1
#undef HID
#undef Y2
#undef Y3
#undef QRAW
#undef QIB
#undef KRAW
#undef KIRAW
#undef WI
#undef KB
#undef VB
#undef KIB
#undef SC
#undef IDX
#undef OATT
#undef HS
#undef RS1
#undef OGS
#undef Y1S
#undef HIDS
#undef Y2S
#undef R5S
#undef QNS
#undef SCS
#undef IDXS
#undef OATTS
#undef Y3S
#undef out
#undef SSQ
#undef SSQS

extern "C" void kernel_launch(void* const* d_in, const int* in_sizes, int n_in, void* d_out, int out_size, void* d_ws, size_t ws_size, hipStream_t stream) {
    static int grid = 0;
    if (grid == 0) {
        if (n_in != 21 || ws_size < WS_END) { fprintf(stderr, "kernel_launch: unexpected problem (n_in %d, out %d, ws %zu); nothing launched\n", n_in, out_size, ws_size); grid = -1; return; }
        int dev = 0, cus = 0, per_cu = 0;
        if (hipGetDevice(&dev) != hipSuccess || hipDeviceGetAttribute(&cus, hipDeviceAttributeMultiprocessorCount, dev) != hipSuccess) { grid = -1; return; }
        if (hipFuncSetAttribute((const void*)mk_fwd, hipFuncAttributeMaxDynamicSharedMemorySize, LDS_BYTES) != hipSuccess) { fprintf(stderr, "kernel_launch: hipFuncSetAttribute failed\n"); grid = -1; return; }
        if (hipOccupancyMaxActiveBlocksPerMultiprocessor(&per_cu, (const void*)mk_fwd, NTHR, LDS_BYTES) != hipSuccess || per_cu < 1) { fprintf(stderr, "kernel_launch: occupancy query says %d blocks per CU\n", per_cu); }
        (void)hipGetLastError();
        grid = cus;
    }
    if (grid < 0) return;
    (void)hipMemsetAsync((char*)d_ws + WS_CTL, 0, CTL_ZERO_BYTES, stream);
    Args a{};
    for (int i = 0; i < 21; ++i) a.in[i] = d_in[i];
    a.out = (float*)d_out; a.ws = (unsigned char*)d_ws;
#if MK_ONE_LAUNCH
    a.ph_lo = 0; a.ph_hi = NPHASE; a.li = 0;
    hipLaunchKernelGGL(mk_fwd, dim3(grid), dim3(NTHR), LDS_BYTES, stream, a);
#else
    for (int p = 0; p < NPHASE; ++p) { a.ph_lo = p; a.ph_hi = p + 1; a.li = p; hipLaunchKernelGGL(mk_fwd, dim3(grid), dim3(NTHR), LDS_BYTES, stream, a); }
#endif
}
```
